# Optimizing an MI355X kernel written in HIP

```python
import numpy as np
import jax
import jax.numpy as jnp
from jax import lax

D_MODEL = 1024
BATCH = 16
SEQ = 2048
DEPTH = 2

BRANCH_WIDTH = D_MODEL // 2
N_BRANCH = 3
FOX_HEAD_DIM = 64
FOX_HEADS = BRANCH_WIDTH // FOX_HEAD_DIM
FOX_BLOCK = 128
FOX_FORGET_BIAS = 2.0
ML_HEADS = 4
ML_DV = BRANCH_WIDTH // ML_HEADS
ML_DQK = ML_DV // 2
ML_CONV = 4
ML_CHUNK = 128
HG_HEADS = 4
HG_DV = BRANCH_WIDTH // HG_HEADS
HG_DK = 128
HG_CHUNK = 64
N_EXPERTS = 64
N_GROUPS = 8
TOPK_GROUPS = 4
TOP_K = 8
D_FF_EXPERT = D_MODEL // 4
D_FF_SHARED = D_MODEL // 4
ROUTE_SCALE = 2.5
MOE_BLOCK = 256
EPS = 1e-6

IN_SPLITS = (
    FOX_HEADS * FOX_HEAD_DIM, FOX_HEADS * FOX_HEAD_DIM, FOX_HEADS * FOX_HEAD_DIM, FOX_HEADS,
    2 * ML_HEADS * ML_DQK, ML_HEADS * ML_DV, ML_HEADS, ML_HEADS, ML_HEADS * ML_DV,
    HG_HEADS * HG_DK, HG_HEADS * HG_DK, HG_HEADS * HG_DV, HG_HEADS * HG_DV,
    N_BRANCH * D_MODEL,
)
D_IN = 3 * FOX_HEADS * FOX_HEAD_DIM + FOX_HEADS + 2 * ML_HEADS * ML_DQK + 2 * ML_HEADS * ML_DV + 2 * ML_HEADS + 2 * HG_HEADS * HG_DK + 2 * HG_HEADS * HG_DV + N_BRANCH * D_MODEL

kernel_name = "hybrid_fox_mlstm_hgrn2_moe_adaln"


def _rms(x):
    xf = x.astype(jnp.float32)
    return xf * lax.rsqrt(jnp.mean(xf * xf, axis=-1, keepdims=True) + EPS)


def _heads(a, n_heads):
    b, s, _ = a.shape
    return a.reshape(b, s, n_heads, -1).transpose(0, 2, 1, 3)


def _merge_heads(a):
    b, h, s, d = a.shape
    return a.transpose(0, 2, 1, 3).reshape(b, s, h * d)


def _to_chunks(a, chunk):
    b, h, s = a.shape[:3]
    return jnp.moveaxis(a.reshape(b, h, s // chunk, chunk, *a.shape[3:]), 2, 0)


def _from_chunks(a):
    nc, b, h, chunk = a.shape[:4]
    return jnp.moveaxis(a, 0, 2).reshape(b, h, nc * chunk, *a.shape[4:])


def _causal_depthwise_conv(x, w):
    width, ch = w.shape
    return lax.conv_general_dilated(
        x, w.astype(x.dtype)[:, None, :], window_strides=(1,), padding=[(width - 1, 0)],
        dimension_numbers=("NWC", "WIO", "NWC"), feature_group_count=ch)


def _forgetting_attention(q, k, v, logf):
    b, h, s, dh = q.shape
    cum = jnp.cumsum(logf, axis=-1)
    k_pos = jnp.arange(s)
    scale = dh ** -0.5

    def block(i):
        start = i * FOX_BLOCK
        qb = lax.dynamic_slice_in_dim(q, start, FOX_BLOCK, axis=2)
        fq = lax.dynamic_slice_in_dim(cum, start, FOX_BLOCK, axis=2)
        logits = jnp.einsum("bhtd,bhsd->bhts", qb, k).astype(jnp.float32) * scale
        logits = logits + fq[..., :, None] - cum[..., None, :]
        q_pos = start + jnp.arange(FOX_BLOCK)
        logits = jnp.where(k_pos[None, :] <= q_pos[:, None], logits, -jnp.inf)
        p = jax.nn.softmax(logits, axis=-1)
        return jnp.einsum("bhts,bhsd->bhtd", p.astype(v.dtype), v)

    out = lax.map(block, jnp.arange(s // FOX_BLOCK))
    return jnp.moveaxis(out, 0, 2).reshape(b, h, s, dh)


def _mlstm_chunkwise(q, k, v, i_pre, logf):
    b, h, s, dqk = q.shape
    dv = v.shape[-1]
    causal = jnp.tril(jnp.ones((ML_CHUNK, ML_CHUNK), dtype=bool))
    xs = tuple(_to_chunks(a, ML_CHUNK) for a in (q, k, v, i_pre, logf))

    def step(carry, xs_c):
        c_mat, n_vec, m_prev = carry
        qb, kb, vb, ib, fb = xs_c
        bcum = jnp.cumsum(fb, axis=-1)
        log_d = bcum[..., :, None] - bcum[..., None, :] + ib[..., None, :]
        log_d = jnp.where(causal, log_d, -jnp.inf)
        log_inter = bcum + m_prev[..., None]
        m_t = jnp.maximum(jnp.max(log_d, axis=-1), log_inter)
        w_intra = jnp.exp(log_d - m_t[..., None])
        w_inter = jnp.exp(log_inter - m_t)
        sc = jnp.einsum("bhtd,bhsd->bhts", qb, kb) * w_intra
        num = jnp.einsum("bhts,bhsv->bhtv", sc, vb) + w_inter[..., None] * jnp.einsum("bhtd,bhdv->bhtv", qb, c_mat)
        den = jnp.sum(sc, axis=-1) + w_inter * jnp.einsum("bhtd,bhd->bht", qb, n_vec)
        h_out = num / jnp.maximum(jnp.abs(den), jnp.exp(-m_t))[..., None]
        b_last = bcum[..., -1]
        log_w_in = b_last[..., None] - bcum + ib
        m_new = jnp.maximum(b_last + m_prev, jnp.max(log_w_in, axis=-1))
        w_in = jnp.exp(log_w_in - m_new[..., None])
        decay = jnp.exp(b_last + m_prev - m_new)
        c_mat = decay[..., None, None] * c_mat + jnp.einsum("bhs,bhsd,bhsv->bhdv", w_in, kb, vb)
        n_vec = decay[..., None] * n_vec + jnp.einsum("bhs,bhsd->bhd", w_in, kb)
        return (c_mat, n_vec, m_new), h_out

    init = (jnp.zeros((b, h, dqk, dv), jnp.float32), jnp.zeros((b, h, dqk), jnp.float32), jnp.zeros((b, h), jnp.float32))
    _, hs = lax.scan(step, init, xs)
    return _from_chunks(hs)


def _hgrn2_chunkwise(q, k, v, logf):
    b, h, s, dk = q.shape
    dv = v.shape[-1]
    causal = jnp.tril(jnp.ones((HG_CHUNK, HG_CHUNK), dtype=bool))
    xs = tuple(_to_chunks(a, HG_CHUNK) for a in (q, k, v, logf))

    def step(state, xs_c):
        qb, kb, vb, gb = xs_c
        a = jnp.cumsum(gb, axis=2)
        rel = a[:, :, :, None, :] - a[:, :, None, :, :]
        decay = jnp.exp(jnp.where(causal[:, :, None], rel, -jnp.inf))
        sc = jnp.einsum("bhtd,bhsd,bhtsd->bhts", qb, kb, decay)
        out = jnp.einsum("bhts,bhsv->bhtv", sc, vb) + jnp.einsum("bhtd,bhdv->bhtv", qb * jnp.exp(a), state)
        a_last = a[:, :, -1]
        state = jnp.exp(a_last)[..., None] * state + jnp.einsum("bhsd,bhsv->bhdv", kb * jnp.exp(a_last[:, :, None] - a), vb)
        return state, out

    _, outs = lax.scan(step, jnp.zeros((b, h, dk, dv), jnp.float32), xs)
    return _from_chunks(outs)


def _hybrid_mixer(h, w_in, fox_bf, fox_q_g, fox_k_g, mlstm_conv, mlstm_bi, mlstm_bf, mlstm_norm_g,
                  hgrn_lb, hgrn_norm_g, w_branch, w_out):
    dt = h.dtype
    b, s, _ = h.shape
    proj = h @ w_in
    split_idx = np.cumsum(IN_SPLITS)[:-1].tolist()
    (fq, fk, fv, ff, mqk, mv, mi, mf, mo, hf, hq, hi, hg, gates) = jnp.split(proj, split_idx, axis=-1)

    qh = (_rms(_heads(fq, FOX_HEADS)) * fox_q_g).astype(dt)
    kh = (_rms(_heads(fk, FOX_HEADS)) * fox_k_g).astype(dt)
    logf_fox = jax.nn.log_sigmoid(ff.astype(jnp.float32) + fox_bf).transpose(0, 2, 1)
    y_fox = _merge_heads(_forgetting_attention(qh, kh, _heads(fv, FOX_HEADS), logf_fox))

    qk = jax.nn.silu(_causal_depthwise_conv(mqk, mlstm_conv))
    mq, mk = jnp.split(qk, 2, axis=-1)
    i_pre = (mi.astype(jnp.float32) + mlstm_bi).transpose(0, 2, 1)
    logf_ml = jax.nn.log_sigmoid(mf.astype(jnp.float32) + mlstm_bf).transpose(0, 2, 1)
    hm = _mlstm_chunkwise(_heads(mq, ML_HEADS), _heads(mk, ML_HEADS) * (ML_DQK ** -0.5), _heads(mv, ML_HEADS), i_pre, logf_ml)
    y_ml = (jax.nn.sigmoid(mo.astype(jnp.float32)) * _merge_heads(_rms(hm)) * mlstm_norm_g).astype(dt)

    fz = _heads(hf, HG_HEADS).astype(jnp.float32)
    lb = hgrn_lb.reshape(HG_HEADS, HG_DK)[None, :, None, :]
    logf_hg = jnp.logaddexp(jnp.log(lb), jnp.log1p(-lb) + jax.nn.log_sigmoid(fz))
    k_hg = (1.0 - lb) * jax.nn.sigmoid(-fz)
    q_hg = jax.nn.silu(_heads(hq, HG_HEADS))
    oh = _hgrn2_chunkwise(q_hg, k_hg, _heads(hi, HG_HEADS), logf_hg)
    y_hg = (_merge_heads(_rms(oh)) * hgrn_norm_g * jax.nn.silu(hg.astype(jnp.float32))).astype(dt)

    g = jax.nn.sigmoid(gates).reshape(b, s, N_BRANCH, D_MODEL)
    merged = g[:, :, 0] * (y_fox @ w_branch[0]) + g[:, :, 1] * (y_ml @ w_branch[1]) + g[:, :, 2] * (y_hg @ w_branch[2])
    return merged @ w_out


def _moe_ffn(h, router_w, router_bias, w1, w3, w2, ws1, ws3, ws2):
    t, d = h.shape
    scores = jax.nn.sigmoid((h @ router_w).astype(jnp.float32))
    choice = scores + router_bias
    grp_score = lax.top_k(choice.reshape(t, N_GROUPS, N_EXPERTS // N_GROUPS), 2)[0].sum(-1)
    _, grp_idx = lax.top_k(grp_score, TOPK_GROUPS)
    grp_mask = jnp.any(grp_idx[:, :, None] == jnp.arange(N_GROUPS)[None, None, :], axis=1)
    masked = jnp.where(jnp.repeat(grp_mask, N_EXPERTS // N_GROUPS, axis=1), choice, -jnp.inf)
    _, idx = lax.top_k(masked, TOP_K)
    wts = jnp.take_along_axis(scores, idx, axis=-1)
    wts = wts / jnp.sum(wts, axis=-1, keepdims=True) * ROUTE_SCALE

    n_assign = t * TOP_K
    flat_e = idx.reshape(n_assign)
    order = jnp.argsort(flat_e)
    sorted_e = flat_e[order]
    tok = (order // TOP_K).astype(jnp.int32)
    counts = jax.ops.segment_sum(jnp.ones((n_assign,), jnp.int32), flat_e, num_segments=N_EXPERTS)
    padded = (counts + MOE_BLOCK - 1) // MOE_BLOCK * MOE_BLOCK
    pad_end = jnp.cumsum(padded)
    pad_start = pad_end - padded
    start = jnp.cumsum(counts) - counts
    dest = pad_start[sorted_e] + jnp.arange(n_assign) - start[sorted_e]
    n_blocks = -(-n_assign // MOE_BLOCK) + N_EXPERTS
    n_rows = n_blocks * MOE_BLOCK
    row_tok = jnp.full((n_rows,), t, jnp.int32).at[dest].set(tok)
    row_w = jnp.zeros((n_rows,), jnp.float32).at[dest].set(wts.reshape(n_assign)[order])
    blk_exp = jnp.minimum(jnp.searchsorted(pad_end, jnp.arange(n_blocks) * MOE_BLOCK, side="right"), N_EXPERTS - 1)
    h_pad = jnp.concatenate([h, jnp.zeros((1, d), h.dtype)], axis=0)

    def body(y, xs_b):
        rt, rw, e = xs_b
        xb = h_pad[rt]
        hid = jax.nn.silu(xb @ w1[e]) * (xb @ w3[e])
        ob = (hid @ w2[e]) * rw[:, None]
        return y.at[rt].add(ob.astype(y.dtype)), None

    y, _ = lax.scan(body, jnp.zeros((t + 1, d), h.dtype),
                    (row_tok.reshape(n_blocks, MOE_BLOCK), row_w.reshape(n_blocks, MOE_BLOCK), blk_exp))
    shared = (jax.nn.silu(h @ ws1) * (h @ ws3)) @ ws2
    return y[:t] + shared


def setup_inputs(seed: int = 0) -> dict:
    key = jax.random.key(seed)
    ks = jax.random.split(key, 32)
    f32 = jnp.float32
    D = D_MODEL

    def nrm(k, shape, scale):
        return jax.random.normal(k, shape, f32) * scale

    return {
        "x": nrm(ks[0], (BATCH, SEQ, D), 1.0),
        "c": nrm(ks[1], (BATCH, D), 1.0),
        "ada_w": nrm(ks[2], (DEPTH, D, 6 * D), 0.5 * D ** -0.5),
        "ada_b": nrm(ks[3], (DEPTH, 6 * D), 0.02),
        "norm1_g": 1.0 + nrm(ks[4], (DEPTH, D), 0.05),
        "norm2_g": 1.0 + nrm(ks[5], (DEPTH, D), 0.05),
        "w_in": nrm(ks[6], (DEPTH, D, D_IN), D ** -0.5),
        "fox_bf": FOX_FORGET_BIAS + nrm(ks[7], (DEPTH, FOX_HEADS), 0.5),
        "fox_q_g": 1.0 + nrm(ks[8], (DEPTH, FOX_HEAD_DIM), 0.05),
        "fox_k_g": 1.0 + nrm(ks[9], (DEPTH, FOX_HEAD_DIM), 0.05),
        "mlstm_conv": nrm(ks[10], (DEPTH, ML_CONV, 2 * ML_HEADS * ML_DQK), ML_CONV ** -0.5),
        "mlstm_bi": nrm(ks[11], (DEPTH, ML_HEADS), 0.1),
        "mlstm_bf": jnp.linspace(3.0, 6.0, ML_HEADS, dtype=f32)[None, :] + nrm(ks[12], (DEPTH, ML_HEADS), 0.1),
        "mlstm_norm_g": 1.0 + nrm(ks[13], (DEPTH, ML_HEADS * ML_DV), 0.05),
        "hgrn_lower_bounds": nrm(ks[14], (DEPTH, HG_HEADS * HG_DK), 0.1),
        "hgrn_norm_g": 1.0 + nrm(ks[15], (DEPTH, HG_HEADS * HG_DV), 0.05),
        "w_branch": nrm(ks[16], (DEPTH, N_BRANCH, BRANCH_WIDTH, D), BRANCH_WIDTH ** -0.5),
        "w_out": nrm(ks[17], (DEPTH, D, D), D ** -0.5),
        "router_w": nrm(ks[18], (DEPTH, D, N_EXPERTS), D ** -0.5),
        "router_bias": nrm(ks[19], (DEPTH, N_EXPERTS), 0.01),
        "exp_w1": nrm(ks[20], (DEPTH, N_EXPERTS, D, D_FF_EXPERT), D ** -0.5),
        "exp_w3": nrm(ks[21], (DEPTH, N_EXPERTS, D, D_FF_EXPERT), D ** -0.5),
        "exp_w2": nrm(ks[22], (DEPTH, N_EXPERTS, D_FF_EXPERT, D), D_FF_EXPERT ** -0.5),
        "sh_w1": nrm(ks[23], (DEPTH, D, D_FF_SHARED), D ** -0.5),
        "sh_w3": nrm(ks[24], (DEPTH, D, D_FF_SHARED), D ** -0.5),
        "sh_w2": nrm(ks[25], (DEPTH, D_FF_SHARED, D), D_FF_SHARED ** -0.5),
    }


def reference(x, c, ada_w, ada_b, norm1_g, norm2_g, w_in, fox_bf, fox_q_g, fox_k_g, mlstm_conv, mlstm_bi,
              mlstm_bf, mlstm_norm_g, hgrn_lower_bounds, hgrn_norm_g, w_branch, w_out, router_w, router_bias,
              exp_w1, exp_w3, exp_w2, sh_w1, sh_w3, sh_w2):
    b, s, d = x.shape
    dt = x.dtype
    cond = jax.nn.silu(c)
    lb_all = jnp.cumsum(jax.nn.softmax(hgrn_lower_bounds.astype(jnp.float32), axis=0), axis=0)
    lb_all = lb_all - lb_all[0]
    for l in range(DEPTH):
        mod = (cond @ ada_w[l] + ada_b[l])[:, None, :]
        sh1, sc1, g1, sh2, sc2, g2 = jnp.split(mod, 6, axis=-1)
        h = (_rms(x) * norm1_g[l] * (1.0 + sc1) + sh1).astype(dt)
        mixed = _hybrid_mixer(h, w_in[l], fox_bf[l], fox_q_g[l], fox_k_g[l], mlstm_conv[l], mlstm_bi[l],
                              mlstm_bf[l], mlstm_norm_g[l], lb_all[l], hgrn_norm_g[l], w_branch[l], w_out[l])
        x = x + g1 * mixed
        h = (_rms(x) * norm2_g[l] * (1.0 + sc2) + sh2).astype(dt)
        y = _moe_ffn(h.reshape(b * s, d), router_w[l], router_bias[l], exp_w1[l], exp_w3[l], exp_w2[l],
                     sh_w1[l], sh_w3[l], sh_w2[l]).reshape(b, s, d)
        x = x + g2 * y
    return x
```

```cpp
#include <hip/hip_runtime.h>
#include <stdint.h>
#include <stddef.h>

#define DEV __device__ __forceinline__
typedef unsigned short bf16_t;
typedef short bf16x8 __attribute__((ext_vector_type(8)));
typedef float f32x4 __attribute__((ext_vector_type(4)));
typedef float f32x2 __attribute__((ext_vector_type(2)));
typedef __bf16 bf16x2_t __attribute__((ext_vector_type(2)));

constexpr int T = 32768, DM = 1024, NB = 16, SEQ = 2048, DIN = 8208;
constexpr int C_FQ = 0, C_FK = 512, C_FV = 1024, C_FF = 1536, C_MQK = 1544, C_MV = 2056, C_MI = 2568, C_MF = 2572, C_MO = 2576,
              C_HF = 3088, C_HQ = 3600, C_HI = 4112, C_HG = 4624, C_GATES = 5136;
constexpr int C_MERGED = 512;
constexpr int NEXP = 64, TOPK = 8, NLIST = 65, NHALF = 1, HALF_T = T / NHALF, NSLOT = 9;
constexpr int ROWCAP = 311296;
constexpr int TILECAP = ROWCAP / 256;
constexpr int TL_PAD = (TILECAP + 63) / 64 * 64;

constexpr size_t AL(size_t x) { return (x + 255) & ~(size_t)255; }
constexpr size_t OFF_CTL = 0;
constexpr size_t OFF_CNT = 32768;
constexpr int CNT_STRIDE = 32;
constexpr size_t OFF_QCTR = 65536;
constexpr size_t CTL_BYTES = 131072;
constexpr size_t OFF_MOD = CTL_BYTES;
constexpr size_t OFF_GS = AL(OFF_MOD + (size_t)2 * 16 * 6144 * 4);
constexpr size_t OFF_IDX = AL(OFF_GS + (size_t)T * 16 * 4);
constexpr size_t OFF_WTS = AL(OFF_IDX + (size_t)T * 8 * 4);
constexpr size_t OFF_RANK = AL(OFF_WTS + (size_t)T * 8 * 4);
constexpr size_t OFF_ROWTOK = AL(OFF_RANK + (size_t)T * 8 * 4);
constexpr size_t OFF_POS = AL(OFF_ROWTOK + (size_t)NHALF * ROWCAP * 4);
constexpr size_t OFF_TILEL = AL(OFF_POS + (size_t)T * NSLOT * 4);
constexpr size_t OFF_WIN = AL(OFF_TILEL + (size_t)NHALF * (TILECAP + 16) * 4);
constexpr size_t OFF_WG8 = AL(OFF_WIN + (size_t)5376 * 1024 * 2);
constexpr size_t OFF_WBR = AL(OFF_WG8 + (size_t)5632 * 1024);
constexpr size_t OFF_WOUT = AL(OFF_WBR + (size_t)3 * 1024 * 512 * 2);
constexpr size_t OFF_WRT = AL(OFF_WOUT + (size_t)1024 * 1024 * 2);
constexpr size_t OFF_H = AL(OFF_WRT + (size_t)256 * 1024 * 2);
constexpr size_t OFF_H2F8 = OFF_H + (size_t)T * 1024;
constexpr size_t OFF_PROJ = AL(OFF_H + (size_t)T * 1024 * 2);
constexpr size_t OFF_END = AL(OFF_PROJ + (size_t)T * DIN * 2);
constexpr size_t OFF_W13 = OFF_PROJ;
constexpr size_t OFF_HID = AL(OFF_W13 + (size_t)NLIST * 512 * 1024);
constexpr size_t OFF_OUTA = AL(OFF_HID + (size_t)ROWCAP * 256);
constexpr size_t OFF_MOE_END = AL(OFF_OUTA + (size_t)ROWCAP * 1024);
constexpr size_t OFF_XB = OFF_MOE_END;
constexpr size_t OFF_W2 = OFF_MOE_END + (size_t)T * 2048;
static_assert(OFF_XB + (size_t)T * 2048 + (size_t)NEXP * 1024 * 256 <= OFF_END, "x1 rows and the routed down weights must fit behind the MoE overlay");
constexpr size_t OFF_FBUF = OFF_END;
constexpr size_t OFF_GBUF = AL(OFF_FBUF + (size_t)128 * SEQ * 4);
constexpr size_t OFF_ECBUF = AL(OFF_GBUF + (size_t)64 * SEQ * 16);
constexpr size_t OFF_EVBUF = AL(OFF_ECBUF + (size_t)64 * 32 * 4);
constexpr size_t OFF_H8 = AL(OFF_EVBUF + (size_t)64 * 32 * 384 * 4);
constexpr size_t OFF_W2S = AL(OFF_H8 + (size_t)T * 1024);
constexpr size_t OFF_END2 = AL(OFF_W2S + (size_t)1024 * 256 * 2);
static_assert((size_t)NEXP * 1024 * 256 * 2 <= (size_t)T * 1024, "routed W2 fits the lower half of H");
static_assert(OFF_MOE_END <= OFF_END, "MoE overlay must fit inside proj region");
static_assert(OFF_END2 <= (size_t)682 * 1000 * 1000, "workspace too large");
static_assert((size_t)64 * 32 * 4 * 64 * 64 * 2 <= (size_t)T * 1024 * 2, "mLSTM operand blocks fit the H region");

struct Params {
    const float* in[26];
    float* out;
    unsigned char* ws;
};
enum { I_X = 0, I_C, I_ADAW, I_ADAB, I_N1G, I_N2G, I_WIN, I_FOXBF, I_FOXQG, I_FOXKG, I_MCONV, I_MBI, I_MBF, I_MNG, I_HLB, I_HNG,
       I_WBR, I_WOUT, I_RW, I_RB, I_EW1, I_EW3, I_EW2, I_SW1, I_SW3, I_SW2 };

DEV int tid_op() { int t = threadIdx.x; asm volatile("" : "+v"(t)); return t; }
DEV int bid_op() { int b = blockIdx.x; asm volatile("" : "+s"(b)); return b; }
DEV float bf2f(bf16_t v) { return __uint_as_float((unsigned)v << 16); }
DEV unsigned pack2(float lo, float hi) { f32x2 v = {lo, hi}; bf16x2_t b = __builtin_convertvector(v, bf16x2_t); return __builtin_bit_cast(unsigned, b); }
DEV bf16_t f2bf(float f) { return (bf16_t)(pack2(f, 0.f) & 0xffffu); }
DEV float sigmoid_f(float x) { return 1.f / (1.f + __expf(-x)); }
DEV float silu_f(float x) { return x / (1.f + __expf(-x)); }
DEV float fsigmoid(float x) { return __builtin_amdgcn_rcpf(1.f + __expf(-x)); }
DEV float fsilu(float x) { return x * __builtin_amdgcn_rcpf(1.f + __expf(-x)); }
DEV unsigned pack4_fp8(float a, float b, float c, float d) {
    a = __builtin_amdgcn_fmed3f(a, -448.f, 448.f); b = __builtin_amdgcn_fmed3f(b, -448.f, 448.f); c = __builtin_amdgcn_fmed3f(c, -448.f, 448.f); d = __builtin_amdgcn_fmed3f(d, -448.f, 448.f);
    int v = __builtin_amdgcn_cvt_pk_fp8_f32(a, b, 0, false); v = __builtin_amdgcn_cvt_pk_fp8_f32(c, d, v, true); return (unsigned)v;
}
constexpr float F8_ACT_SCALE = 8.f, F8_W_SCALE = 64.f;
DEV float logsigmoid_f(float x) { return fminf(x, 0.f) - log1pf(__expf(-fabsf(x))); }
DEV int lane_op() { int l = (int)__builtin_amdgcn_mbcnt_hi(~0u, __builtin_amdgcn_mbcnt_lo(~0u, 0u)); asm volatile("" : "+v"(l)); return l; }
DEV float sx(float v, int o) { return __builtin_bit_cast(float, __builtin_amdgcn_ds_bpermute((lane_op() ^ o) << 2, __builtin_bit_cast(int, v))); }
DEV float sfrom(float v, int src) { return __builtin_bit_cast(float, __builtin_amdgcn_ds_bpermute(src << 2, __builtin_bit_cast(int, v))); }
DEV float sup(float v, int o) { const int l = lane_op(); return __builtin_bit_cast(float, __builtin_amdgcn_ds_bpermute(((l >= o) ? l - o : l) << 2, __builtin_bit_cast(int, v))); }
DEV float wave_sum(float v) {
#pragma unroll
    for (int o = 32; o > 0; o >>= 1) v += sx(v, o);
    return v;
}
DEV void unpack8(uint4 u, float* f) {
    f[0] = __uint_as_float(u.x << 16); f[1] = __uint_as_float(u.x & 0xffff0000u);
    f[2] = __uint_as_float(u.y << 16); f[3] = __uint_as_float(u.y & 0xffff0000u);
    f[4] = __uint_as_float(u.z << 16); f[5] = __uint_as_float(u.z & 0xffff0000u);
    f[6] = __uint_as_float(u.w << 16); f[7] = __uint_as_float(u.w & 0xffff0000u);
}


constexpr int VB_COLS = 2576, VF_VALS = 2560, VF_COLS = 5632;
DEV int vb_to_proj(int vc) { const int blk = vc >> 9; return ((blk == 0) ? C_FQ : (blk == 1) ? C_FK : (blk == 2) ? C_MQK : (blk == 3) ? C_HF : C_HQ) + (vc & 511); }
DEV int vf_to_proj(int vc) { if (vc >= VF_VALS) return C_GATES + (vc - VF_VALS); const int blk = vc >> 9; return ((blk == 0) ? C_FV : (blk == 1) ? C_MV : (blk == 2) ? C_MO : (blk == 3) ? C_HI : C_HG) + (vc & 511); }
DEV int inproj_vrow(int n, bool& f8) {
    f8 = false;
    if (n < C_FV) return n;
    if (n < C_FF) { f8 = true; return n - C_FV; }
    if (n < C_MQK) return 2560 + (n - C_FF);
    if (n < C_MV) return 1024 + (n - C_MQK);
    if (n < C_MI) { f8 = true; return 512 + (n - C_MV); }
    if (n < C_MO) return 2568 + (n - C_MI);
    if (n < C_HF) { f8 = true; return 1024 + (n - C_MO); }
    if (n < C_HQ) return 1536 + (n - C_HF);
    if (n < C_HI) return 2048 + (n - C_HQ);
    if (n < C_HG) { f8 = true; return 1536 + (n - C_HI); }
    if (n < C_GATES) { f8 = true; return 2048 + (n - C_HG); }
    f8 = true; return VF_VALS + (n - C_GATES);
}
DEV void lds_barrier() { asm volatile("s_waitcnt lgkmcnt(0)\n\ts_barrier" ::: "memory"); }
DEV const float* arg_in(int idx) {
    typedef const float* fptr_t;
    const __attribute__((address_space(4))) char* ka = (const __attribute__((address_space(4))) char*)__builtin_amdgcn_kernarg_segment_ptr();
    return *(const __attribute__((address_space(4))) fptr_t*)(ka + idx * 8);
}
struct MB { const float* src; unsigned char* dst; int ld; bool ok, f8; };
DEV MB mix_cb(const Params& p, int layer, int u, int lane, int wid) {
    MB c;
    int job, kb, nb, b = 0;
    if (u < 1032) { job = 0; kb = u & 7; nb = u >> 3; }
    else if (u < 1224) { const int r = (u - 1032) & 63; job = 1; b = (u - 1032) >> 6; kb = r & 3; nb = r >> 2; }
    else if (u < 1352) { job = 2; kb = (u - 1224) & 7; nb = (u - 1224) >> 3; }
    else { job = 3; kb = u - 1352; nb = 0; }
    const int N = (job == 0) ? DIN : (job == 3) ? 64 : 1024, K = (job == 1) ? 512 : 1024;
    const float* base = arg_in((job == 0) ? (int)I_WIN : (int)I_WBR + job - 1);
    const int n = nb * 64 + lane, k0 = kb * 128 + 16 * wid;
    c.ok = n < N; c.ld = N;
    c.src = base + ((size_t)layer * (job == 1 ? 3 : 1) + b) * (size_t)K * N + (size_t)k0 * N + (c.ok ? n : 0);
    bool f8 = false; int nm = n;
    if (job == 0) nm = inproj_vrow(c.ok ? n : 0, f8);
    c.f8 = f8;
    const size_t doff = (job == 0) ? (f8 ? OFF_WG8 : OFF_WIN) : (job == 1) ? OFF_WBR + (size_t)b * 1024 * 512 * 2 : (job == 2) ? OFF_WOUT : OFF_WRT;
    c.dst = p.ws + doff + (f8 ? (size_t)nm * 1024 + k0 : ((size_t)nm * K + k0) * 2);
    return c;
}
constexpr int MIX_CBLOCKS = 1032 + 192 + 128 + 8;
DEV void phase_convert_mix(const Params& p, int layer, char* lds) {
    const int t = tid_op(), lane = t & 63, wid = t >> 6, G = gridDim.x;
    int u = bid_op();
    if (u >= MIX_CBLOCKS) return;
    MB c = mix_cb(p, layer, u, lane, wid);
    float v[16];
#pragma unroll
    for (int i = 0; i < 16; ++i) v[i] = c.src[(size_t)i * c.ld];
#pragma unroll 1
    for (; u < MIX_CBLOCKS; u += G) {
        const bool more = u + G < MIX_CBLOCKS;
        const MB cn = mix_cb(p, layer, more ? u + G : u, lane, wid);
        float nx[16];
#pragma unroll
        for (int i = 0; i < 16; ++i) nx[i] = cn.src[(size_t)i * cn.ld];
        if (c.ok) {
            if (c.f8) { const float sc = F8_W_SCALE;
                *(uint4*)c.dst = make_uint4(pack4_fp8(v[0] * sc, v[1] * sc, v[2] * sc, v[3] * sc), pack4_fp8(v[4] * sc, v[5] * sc, v[6] * sc, v[7] * sc),
                                            pack4_fp8(v[8] * sc, v[9] * sc, v[10] * sc, v[11] * sc), pack4_fp8(v[12] * sc, v[13] * sc, v[14] * sc, v[15] * sc)); }
            else { *(uint4*)c.dst = make_uint4(pack2(v[0], v[1]), pack2(v[2], v[3]), pack2(v[4], v[5]), pack2(v[6], v[7]));
                   *(uint4*)(c.dst + 16) = make_uint4(pack2(v[8], v[9]), pack2(v[10], v[11]), pack2(v[12], v[13]), pack2(v[14], v[15])); }
        }
        c = cn;
#pragma unroll
        for (int i = 0; i < 16; ++i) v[i] = nx[i];
    }
}
struct CB { const float* src; unsigned char* dst; int ld; };
DEV CB moe_cb(const Params& p, int layer, int u, int lane, int wid) {
    CB c;
    const int e = u / 96, r = u % 96, which = r >> 5, t = r & 31;
    const float* base = arg_in((int)I_EW1 + (e < NEXP ? 0 : 3) + which);
    const float* w = base + (size_t)(e < NEXP ? layer * NEXP + e : layer) * 262144;
    if (which < 2) { const int kb = t & 7, nb = t >> 3, hc = nb * 64 + lane, nm = (hc >> 3) * 16 + ((hc >> 2) & 1) * 8 + (hc & 3) + (which ? 4 : 0);
        c.src = w + (size_t)(kb * 128 + 16 * wid) * 256 + hc; c.ld = 256; c.dst = p.ws + OFF_W13 + (size_t)e * 512 * 1024 + (size_t)nm * 1024 + kb * 128 + 16 * wid; }
    else { const int kb = t & 1, nb = t >> 1, n = nb * 64 + lane;
        c.src = w + (size_t)(kb * 128 + 16 * wid) * 1024 + n; c.ld = 1024; c.dst = p.ws + (e < NEXP ? OFF_W2 + (size_t)e * 1024 * 256 : OFF_W2S) + (size_t)n * 256 + kb * 128 + 16 * wid; }
    return c;
}
constexpr int MOE_CBLOCKS = NLIST * 96;
DEV void conv_moe_slice(const Params& p, int layer, int j0, int j1) {
    const int t = tid_op(), lane = t & 63, wid = t >> 6, G = gridDim.x, b = bid_op();
    if (j0 >= j1 || b + G * j0 >= MOE_CBLOCKS) return;
    CB c = moe_cb(p, layer, b + G * j0, lane, wid);
    float v[16];
#pragma unroll
    for (int i = 0; i < 16; ++i) v[i] = c.src[(size_t)i * c.ld];
#pragma unroll 1
    for (int j = j0; j < j1; ++j) {
        const int un = b + G * (j + 1);
        const bool more = (j + 1 < j1) && un < MOE_CBLOCKS;
        const CB cn = moe_cb(p, layer, more ? un : b + G * j, lane, wid);
        float nx[16];
#pragma unroll
        for (int i = 0; i < 16; ++i) nx[i] = cn.src[(size_t)i * cn.ld];
        const float sc = F8_W_SCALE;
        *(uint4*)c.dst = make_uint4(pack4_fp8(v[0] * sc, v[1] * sc, v[2] * sc, v[3] * sc), pack4_fp8(v[4] * sc, v[5] * sc, v[6] * sc, v[7] * sc),
                                    pack4_fp8(v[8] * sc, v[9] * sc, v[10] * sc, v[11] * sc), pack4_fp8(v[12] * sc, v[13] * sc, v[14] * sc, v[15] * sc));
        if (!more) break;
        c = cn;
#pragma unroll
        for (int i = 0; i < 16; ++i) v[i] = nx[i];
    }
}

DEV void phase_ada(const Params& p, char* lds) {
    float* condT = (float*)lds;
    float* red = condT + 1024 * 16;
    const int t = tid_op();
    for (int i = t; i < 16 * 1024; i += 512) { const int b = i >> 10, k = i & 1023; condT[k * 16 + b] = silu_f(p.in[I_C][i]); }
    __syncthreads();
    float* mod = (float*)(p.ws + OFF_MOD);
    for (int u = bid_op(); u < 2 * 96; u += gridDim.x) {
        const int l = u / 96, j0 = (u % 96) * 64, col = t & 63, kg = t >> 6;
        const float* w = p.in[I_ADAW] + (size_t)l * 1024 * 6144 + j0 + col;
        float acc[16];
#pragma unroll
        for (int b = 0; b < 16; ++b) acc[b] = 0.f;
        for (int k0 = kg * 128; k0 < kg * 128 + 128; k0 += 8) {
            float wv8[8];
#pragma unroll
            for (int uu = 0; uu < 8; ++uu) wv8[uu] = w[(size_t)(k0 + uu) * 6144];
#pragma unroll
            for (int uu = 0; uu < 8; ++uu) {
                const float wv = wv8[uu];
                const f32x4* cp = (const f32x4*)(condT + (k0 + uu) * 16);
#pragma unroll
                for (int q = 0; q < 4; ++q) { const f32x4 c4 = cp[q]; acc[q * 4 + 0] += c4[0] * wv; acc[q * 4 + 1] += c4[1] * wv; acc[q * 4 + 2] += c4[2] * wv; acc[q * 4 + 3] += c4[3] * wv; }
            }
        }
        __syncthreads();
#pragma unroll
        for (int b = 0; b < 16; ++b) red[(kg * 16 + b) * 64 + col] = acc[b];
        __syncthreads();
        for (int i = t; i < 16 * 64; i += 512) {
            const int b = i >> 6, c = i & 63;
            float s = p.in[I_ADAB][l * 6144 + j0 + c];
#pragma unroll
            for (int g = 0; g < 8; ++g) s += red[(g * 16 + b) * 64 + c];
            mod[((size_t)l * 16 + b) * 6144 + j0 + c] = s;
        }
    }
}

DEV void phase_norm(const Params& p, const float* xin, int layer, int which, bf16_t* hout) {
    const int lane = tid_op() & 63, wid = tid_op() >> 6;
    const float* g = p.in[which ? I_N2G : I_N1G] + layer * 1024;
    const float* mod = (const float*)(p.ws + OFF_MOD) + (size_t)layer * 16 * 6144;
    for (int row = bid_op() * 8 + wid; row < T; row += gridDim.x * 8) {
        const float* xr = xin + (size_t)row * 1024;
        f32x4 v[4]; float ss = 0.f;
#pragma unroll
        for (int i = 0; i < 4; ++i) { v[i] = *(const f32x4*)(xr + i * 256 + lane * 4); ss += v[i][0] * v[i][0] + v[i][1] * v[i][1] + v[i][2] * v[i][2] + v[i][3] * v[i][3]; }
        ss = wave_sum(ss);
        const float rstd = rsqrtf(ss * (1.f / 1024.f) + 1e-6f);
        const int b = row >> 11;
        const float* sh = mod + (size_t)b * 6144 + (which ? 3 : 0) * 1024;
        const float* sc = sh + 1024;
#pragma unroll
        for (int i = 0; i < 4; ++i) {
            const int c = i * 256 + lane * 4;
            const f32x4 g4 = *(const f32x4*)(g + c), sc4 = *(const f32x4*)(sc + c), sh4 = *(const f32x4*)(sh + c);
            float h0 = v[i][0] * rstd * g4[0] * (1.f + sc4[0]) + sh4[0];
            float h1 = v[i][1] * rstd * g4[1] * (1.f + sc4[1]) + sh4[1];
            float h2 = v[i][2] * rstd * g4[2] * (1.f + sc4[2]) + sh4[2];
            float h3 = v[i][3] * rstd * g4[3] * (1.f + sc4[3]) + sh4[3];
            uint2 o; o.x = pack2(h0, h1); o.y = pack2(h2, h3);
            *(uint2*)(hout + (size_t)row * 1024 + c) = o;
            if (which == 0) *(unsigned*)(p.ws + OFF_H8 + (size_t)row * 1024 + c) = pack4_fp8(h0 * F8_ACT_SCALE, h1 * F8_ACT_SCALE, h2 * F8_ACT_SCALE, h3 * F8_ACT_SCALE);
        }
    }
}

#define LAS __attribute__((address_space(3)))
namespace g8 {
typedef unsigned u32x4 __attribute__((ext_vector_type(4)));
constexpr int BM = 256, BK = 64, HALF = 128, HTB = HALF * BK * 2, STAGE_BYTES = 8 * HTB;
DEV int lds_byte(int r, int c) { const int st = (r >> 4) * 2 + (c >> 5), rr = r & 15, cc = c & 31, ob = rr * 64 + cc * 2; return st * 1024 + (ob ^ (((ob >> 9) & 1) << 5)); }
DEV void stage_rc(int b, int& R, int& C) { const int st = b / 1024, sb = b % 1024, swz = sb ^ (((sb >> 9) & 1) << 5); R = (st >> 1) * 16 + swz / 64; C = (st & 1) * 32 + (swz % 64) / 2; }
DEV int perm32(int rho) { const int n = rho >> 4, i = rho & 15; return 8 * (i >> 2) + 4 * n + (i & 3); }

struct GUnit { const char* A; const char* B; const int* rows; int pm, pn, aux; };

typedef int v8i_t __attribute__((ext_vector_type(8)));
typedef int v4i_t __attribute__((ext_vector_type(4)));
DEV v8i_t cat8(bf16x8 a, bf16x8 b) { const v4i_t x = __builtin_bit_cast(v4i_t, a), y = __builtin_bit_cast(v4i_t, b); return (v8i_t){x[0], x[1], x[2], x[3], y[0], y[1], y[2], y[3]}; }
template <bool PERM, bool GATHER, bool F8, int SEXP = 0, class Gen, class Epi>
DEV void gemm8(LAS unsigned char* lds, const int lda_b, const int ldb_b, const int K, const Gen& S, const Epi& E) {
    int tid_ = tid_op();
    const int tid = tid_, wid = __builtin_amdgcn_readfirstlane(tid >> 6), lane = tid & 63, wr = wid >> 2, wc = wid & 3, fr = lane & 15, fq = lane >> 4;
    const int nt = K / BK;
    int Rs[2], Cb[2];
    unsigned voffB[2];
#pragma unroll
    for (int i = 0; i < 2; ++i) { int R, C; stage_rc(tid * 16 + i * 8192, R, C); const int Rb = PERM ? (64 * (R >> 5) + 16 * ((R & 15) >> 2) + 4 * ((R >> 4) & 1) + (R & 3)) : R;
        Rs[i] = R; Cb[i] = C * 2; voffB[i] = (unsigned)Rb * (unsigned)ldb_b + (unsigned)C * 2u; }
    const size_t kstep = (size_t)(BK * 2);
    const size_t hstepB = (size_t)(PERM ? 8 : HALF) * ldb_b;
    const unsigned ldsw = (unsigned)wid * 1024u;
    const int aoff = lds_byte(wr * 64 + fr, fq * 8), boff = lds_byte(wc * 32 + fr, fq * 8);
#define PG8_SA(b, h) (((b) * 2 + (h)) * HTB)
#define PG8_SB(b, h) ((4 + (b) * 2 + (h)) * HTB)
#define PG8_STAGE(bufoff, gbase, voff) do { _Pragma("unroll") for (int _i = 0; _i < 2; ++_i) \
        __builtin_amdgcn_global_load_lds((const unsigned*)((const char*)(gbase) + (voff)[_i]), (LAS unsigned*)(lds + (bufoff) + ldsw + _i * 8192), 16, 0, 0); } while (0)
#define PG8_LDA(dst, b, h) do { _Pragma("unroll") for (int m = 0; m < 4; ++m) { if constexpr (F8) dst##8[m] = cat8(*(const LAS bf16x8*)(lds + PG8_SA(b, h) + aoff + m * 2048), *(const LAS bf16x8*)(lds + PG8_SA(b, h) + aoff + m * 2048 + 1024)); \
        else { _Pragma("unroll") for (int k = 0; k < 2; ++k) dst[m][k] = *(const LAS bf16x8*)(lds + PG8_SA(b, h) + aoff + m * 2048 + k * 1024); } } } while (0)
#define PG8_LDB(dst, b, h) do { _Pragma("unroll") for (int n = 0; n < 2; ++n) { if constexpr (F8) dst##8[n] = cat8(*(const LAS bf16x8*)(lds + PG8_SB(b, h) + boff + n * 2048), *(const LAS bf16x8*)(lds + PG8_SB(b, h) + boff + n * 2048 + 1024)); \
        else { _Pragma("unroll") for (int k = 0; k < 2; ++k) dst[n][k] = *(const LAS bf16x8*)(lds + PG8_SB(b, h) + boff + n * 2048 + k * 1024); } } } while (0)
#define PG8_MMA(ai, bj, At, Bt) do { __builtin_amdgcn_s_setprio(1); _Pragma("unroll") for (int m = 0; m < 4; ++m) _Pragma("unroll") for (int n = 0; n < 2; ++n) { \
        if constexpr (F8) asm volatile("v_mfma_scale_f32_16x16x128_f8f6f4 %0, %1, %2, %0, %3, %4 op_sel_hi:[0,0,0]" : "+v"(acc[ai][bj][m][n]) : "v"(Bt##8[n]), "v"(At##8[m]), "v"(0x7f7f7f7f), "v"(0x01010101 * (127 + SEXP))); \
        else { _Pragma("unroll") for (int k = 0; k < 2; ++k) acc[ai][bj][m][n] = __builtin_amdgcn_mfma_f32_16x16x32_bf16(Bt[n][k], At[m][k], acc[ai][bj][m][n], 0, 0, 0); } } \
        __builtin_amdgcn_s_setprio(0); } while (0)
#define PG8_WAIT_V(n) asm volatile("s_waitcnt vmcnt(" #n ")" ::: "memory")
#define PG8_WAIT_L(n) asm volatile("s_waitcnt lgkmcnt(" #n ")" ::: "memory")
#define PG8_BAR __builtin_amdgcn_s_barrier()
#define PG8_SCHED __builtin_amdgcn_sched_barrier(0)
    GUnit cur, nxt; int ui = 0;
    if (!S.next(0, cur)) return;
    unsigned cOff[2][2], nOff[2][2];
    auto mkoff = [&](unsigned (&o)[2][2], int buf) {
#pragma unroll
        for (int h = 0; h < 2; ++h)
#pragma unroll
            for (int i = 0; i < 2; ++i) {
                if constexpr (GATHER) o[h][i] = (unsigned)S.rb[buf * 256 + h * HALF + Rs[i]] * (unsigned)lda_b + (unsigned)Cb[i];
                else o[h][i] = (unsigned)(h * HALF + Rs[i]) * (unsigned)lda_b + (unsigned)Cb[i];
            }
    };
    auto rows_dma = [&](const int* rows, int buf) {
        if constexpr (GATHER) __builtin_amdgcn_global_load_lds((const unsigned*)(rows + lane * 4), (LAS unsigned*)(S.rb + buf * 256), 16, 0, 0);
    };
    if constexpr (GATHER) {
        if (wid == 0) { rows_dma(cur.rows, 0); GUnit t1; if (S.next(1, t1)) rows_dma(t1.rows, 1); }
        asm volatile("s_waitcnt vmcnt(0)" ::: "memory");
        __builtin_amdgcn_s_barrier();
    }
    mkoff(cOff, 0);
    f32x4 acc[2][2][4][2];
#pragma unroll
    for (int a = 0; a < 2; ++a)
#pragma unroll
        for (int b = 0; b < 2; ++b)
#pragma unroll
            for (int m = 0; m < 4; ++m)
#pragma unroll
                for (int n = 0; n < 2; ++n) acc[a][b][m][n] = (f32x4){0.f, 0.f, 0.f, 0.f};
    bf16x8 At[4][2], B0[2][2], B1[2][2];
    v8i_t At8[4], B08[2], B18[2];
    const char* cA = cur.A; const char* cB = cur.B;
    PG8_STAGE(PG8_SB(0, 0), cB, voffB); PG8_STAGE(PG8_SB(0, 1), cB + hstepB, voffB); PG8_STAGE(PG8_SA(0, 0), cA, cOff[0]); PG8_STAGE(PG8_SA(0, 1), cA, cOff[1]);
    if (wr == 1) PG8_BAR;
    PG8_WAIT_V(2); PG8_BAR;
    PG8_STAGE(PG8_SB(1, 0), cB + kstep, voffB); PG8_STAGE(PG8_SA(1, 0), cA + kstep, cOff[0]); PG8_STAGE(PG8_SB(1, 1), cB + hstepB + kstep, voffB);
    PG8_WAIT_V(6); PG8_BAR;
    for (;;) {
        const bool has_next = S.next(ui + 1, nxt);
        if constexpr (GATHER) {
            { GUnit t2; if (S.next(ui + 2, t2) && wid == 0) rows_dma(t2.rows, ui & 1); }
            if (has_next) mkoff(nOff, (ui + 1) & 1);
            else {
#pragma unroll
                for (int h = 0; h < 2; ++h)
#pragma unroll
                    for (int i = 0; i < 2; ++i) nOff[h][i] = cOff[h][i];
            }
        }
        const char* nA = has_next ? nxt.A : cA; const char* nB = has_next ? nxt.B : cB;
#pragma unroll 1
        for (int t = 0; t < nt; t += 2) {
            const bool last = (t == nt - 2);
            const char* a1 = cA + (size_t)(t + 1) * kstep;
            const char* a2 = last ? nA : cA + (size_t)(t + 2) * kstep; const char* b2 = last ? nB : cB + (size_t)(t + 2) * kstep;
            const char* a3 = a2 + kstep; const char* b3 = b2 + kstep;
            unsigned o2[2][2];
#pragma unroll
            for (int h = 0; h < 2; ++h)
#pragma unroll
                for (int i = 0; i < 2; ++i) { if constexpr (GATHER) o2[h][i] = last ? nOff[h][i] : cOff[h][i]; else o2[h][i] = cOff[h][i]; }
            PG8_LDB(B0, 0, 0); PG8_LDB(B1, 0, 1); PG8_SCHED; PG8_LDA(At, 0, 0); PG8_STAGE(PG8_SA(1, 1), a1, cOff[1]);
            PG8_WAIT_V(8); PG8_WAIT_L(0); PG8_BAR; PG8_MMA(0, 0, At, B0); PG8_MMA(0, 1, At, B1); PG8_BAR; PG8_SCHED;
            PG8_LDA(At, 0, 1); PG8_STAGE(PG8_SB(0, 0), b2, voffB); PG8_STAGE(PG8_SB(0, 1), b2 + hstepB, voffB); PG8_STAGE(PG8_SA(0, 0), a2, o2[0]);
            PG8_WAIT_V(8); PG8_WAIT_L(0); PG8_BAR; PG8_MMA(1, 0, At, B0); PG8_MMA(1, 1, At, B1); PG8_BAR; PG8_SCHED;
            PG8_LDB(B0, 1, 0); PG8_LDB(B1, 1, 1); PG8_SCHED; PG8_LDA(At, 1, 0); PG8_STAGE(PG8_SA(0, 1), a2, o2[1]);
            PG8_WAIT_V(8); PG8_WAIT_L(0); PG8_BAR; PG8_MMA(0, 0, At, B0); PG8_MMA(0, 1, At, B1); PG8_BAR; PG8_SCHED;
            PG8_LDA(At, 1, 1); PG8_STAGE(PG8_SB(1, 0), b3, voffB); PG8_STAGE(PG8_SB(1, 1), b3 + hstepB, voffB); PG8_STAGE(PG8_SA(1, 0), a3, o2[0]);
            PG8_WAIT_V(8); PG8_WAIT_L(0); PG8_BAR; PG8_MMA(1, 0, At, B0); PG8_MMA(1, 1, At, B1); PG8_BAR; PG8_SCHED;
        }
        if (wr == 0) PG8_BAR;
        if constexpr (F8) asm volatile("s_nop 15\n\ts_nop 15" ::: "memory");
        { int pm_ = cur.pm, pn_ = cur.pn; asm volatile("" : "+s"(pm_), "+s"(pn_)); cur.pm = pm_; cur.pn = pn_; }
        E(acc, cur, wr, wc, fr, fq);
        if (!has_next) break;
        if (!(nxt.aux & 256)) {
#pragma unroll
            for (int a = 0; a < 2; ++a)
#pragma unroll
                for (int b = 0; b < 2; ++b)
#pragma unroll
                    for (int m = 0; m < 4; ++m)
#pragma unroll
                        for (int n = 0; n < 2; ++n) acc[a][b][m][n] = (f32x4){0.f, 0.f, 0.f, 0.f};
        }
        cur = nxt; cA = nA; cB = nB; ++ui;
        if constexpr (GATHER) {
#pragma unroll
            for (int h = 0; h < 2; ++h)
#pragma unroll
                for (int i = 0; i < 2; ++i) cOff[h][i] = nOff[h][i];
        }
        if (wr == 1) PG8_BAR;
    }
    PG8_WAIT_V(0);
    PG8_BAR;
#undef PG8_SA
#undef PG8_SB
#undef PG8_STAGE
#undef PG8_LDA
#undef PG8_LDB
#undef PG8_MMA
#undef PG8_WAIT_V
#undef PG8_WAIT_L
#undef PG8_BAR
#undef PG8_SCHED
}

struct TileOrder {
    int nM, nN, nwg;
    DEV void init(int nM_, int nN_) { nM = nM_; nN = nN_; nwg = nM * nN; }
    DEV bool get(int L, int& pm, int& pn) const {
        if (L >= nwg) return false;
        constexpr int NXCD = 8, WGM = 8;
        int wgid = L; { const int q = nwg / NXCD, r = nwg % NXCD, xcd = wgid % NXCD, off = wgid / NXCD; wgid = (xcd < r ? xcd * (q + 1) : r * (q + 1) + (xcd - r) * q) + off; }
        const int nig = WGM * nN, gid = wgid / nig, fm = gid * WGM, gsz = (nM - fm) < WGM ? (nM - fm) : WGM;
        pm = fm + ((wgid % nig) % gsz); pn = (wgid % nig) / gsz; return true;
    }
};
}

DEV unsigned ldsaddr_dummy() { return 0; }


DEV uint4 dpp_swap1(uint4 v) {
    uint4 r;
    r.x = (unsigned)__builtin_amdgcn_update_dpp(0, (int)v.x, 0xB1, 0xF, 0xF, true); r.y = (unsigned)__builtin_amdgcn_update_dpp(0, (int)v.y, 0xB1, 0xF, 0xF, true);
    r.z = (unsigned)__builtin_amdgcn_update_dpp(0, (int)v.z, 0xB1, 0xF, 0xF, true); r.w = (unsigned)__builtin_amdgcn_update_dpp(0, (int)v.w, 0xB1, 0xF, 0xF, true);
    return r;
}
DEV uint4 sel4(bool c, uint4 a, uint4 b) { uint4 r; r.x = c ? a.x : b.x; r.y = c ? a.y : b.y; r.z = c ? a.z : b.z; r.w = c ? a.w : b.w; return r; }
DEV void store_wide32(char* base, unsigned off, unsigned pitch, int fr, uint4 p0, uint4 p1) {
    const bool odd = fr & 1;
    const uint4 got = dpp_swap1(sel4(odd, p0, p1));
    *(uint4*)(base + (odd ? off - pitch + 16u : off)) = sel4(odd, got, p0);
    *(uint4*)(base + (odd ? off + 16u : off + pitch)) = sel4(odd, p1, got);
}

DEV void phase_inproj(const Params& p, char* lds) {
    bf16_t* P = (bf16_t*)(p.ws + OFF_PROJ);
    float* GS = (float*)(p.ws + OFF_GS);
    {
        struct Gen { g8::TileOrder o; const char* H; const char* W; int G, c;
            DEV bool next(int i, g8::GUnit& u) const { int pm, pn; if (!o.get(i * G + c, pm, pn)) return false; u.pm = pm; u.pn = pn; u.aux = 0; u.rows = nullptr;
                u.A = H + (size_t)pm * 256 * 2048; u.B = W + (size_t)pn * 256 * 2048; return true; } } gen;
        gen.o.init(T / 256, 11); gen.H = (const char*)(p.ws + OFF_H); gen.W = (const char*)(p.ws + OFF_WIN); gen.G = gridDim.x; gen.c = bid_op();
        auto epi = [&](const f32x4 (&acc)[2][2][4][2], const g8::GUnit& u, int wr, int wc, int fr, int fq) {
            const int vc0 = u.pn * 256 + 64 * wc + 16 * fq;
            if (vc0 < 2560) {
                const unsigned pc0 = (unsigned)vb_to_proj(vc0);
#pragma unroll
                for (int ai = 0; ai < 2; ++ai)
#pragma unroll
                    for (int m = 0; m < 4; ++m) {
                        const int row = u.pm * 256 + ai * 128 + wr * 64 + m * 16 + fr;
                        const f32x4 a0 = acc[ai][0][m][0], a1 = acc[ai][0][m][1], b0 = acc[ai][1][m][0], b1 = acc[ai][1][m][1];
                        uint4 p0, p1;
                        p0.x = pack2(a0[0], a0[1]); p0.y = pack2(a0[2], a0[3]); p0.z = pack2(a1[0], a1[1]); p0.w = pack2(a1[2], a1[3]);
                        p1.x = pack2(b0[0], b0[1]); p1.y = pack2(b0[2], b0[3]); p1.z = pack2(b1[0], b1[1]); p1.w = pack2(b1[2], b1[3]);
                        store_wide32((char*)P, ((unsigned)row * DIN + pc0) * 2u, (unsigned)DIN * 2u, fr, p0, p1);
                    }
            } else if (vc0 == 2560) {
#pragma unroll
                for (int ai = 0; ai < 2; ++ai)
#pragma unroll
                    for (int m = 0; m < 4; ++m) {
                        const int row = u.pm * 256 + ai * 128 + wr * 64 + m * 16 + fr;
                        const f32x4 a0 = acc[ai][0][m][0], a1 = acc[ai][0][m][1], b0 = acc[ai][1][m][0], b1 = acc[ai][1][m][1];
                        uint4 p0, p1;
                        p0.x = pack2(a0[0], a0[1]); p0.y = pack2(a0[2], a0[3]); p0.z = pack2(a1[0], a1[1]); p0.w = pack2(a1[2], a1[3]);
                        p1.x = pack2(b0[0], b0[1]); p1.y = pack2(b0[2], b0[3]); p1.z = pack2(b1[0], b1[1]); p1.w = pack2(b1[2], b1[3]);
                        *(uint4*)(P + (size_t)row * DIN + C_FF) = p0; *(uint4*)(P + (size_t)row * DIN + C_MI) = p1;
                        *(f32x4*)(GS + (size_t)row * 16) = a0; *(f32x4*)(GS + (size_t)row * 16 + 4) = a1;
                        *(f32x4*)(GS + (size_t)row * 16 + 8) = b0; *(f32x4*)(GS + (size_t)row * 16 + 12) = b1;
                    }
            }
        };
        g8::gemm8<true, false, false>((LAS unsigned char*)lds, 2048, 2048, 1024, gen, epi);
    }
    {
        struct Gen { g8::TileOrder o; const char* H; const char* W; int G, c;
            DEV bool next(int i, g8::GUnit& u) const { int pm, pn;
                int L = i * G + c;
                if (G == 256) { if (i >= 10) { if (c < 128 || i >= 12) return false; L = 2560 + (i - 10) * 128 + (c - 128); } }
                if (!o.get(L, pm, pn)) return false; u.pm = pm; u.pn = pn; u.aux = 0; u.rows = nullptr;
                u.A = H + (size_t)pm * 256 * 1024; u.B = W + (size_t)pn * 256 * 1024; return true; } } gen;
        gen.o.init(T / 256, 22); gen.H = (const char*)(p.ws + OFF_H8); gen.W = (const char*)(p.ws + OFF_WG8); gen.G = gridDim.x; gen.c = bid_op();
        auto epi = [&](const f32x4 (&acc)[2][2][4][2], const g8::GUnit& u, int wr, int wc, int fr, int fq) {
            const int vc0 = u.pn * 256 + 64 * wc + 16 * fq;
            const unsigned pc0 = (unsigned)vf_to_proj(vc0);
            const bool gate = u.pn >= 10;
#pragma unroll
            for (int ai = 0; ai < 2; ++ai)
#pragma unroll
                for (int m = 0; m < 4; ++m) {
                    const int row = u.pm * 256 + ai * 128 + wr * 64 + m * 16 + fr;
                    f32x4 a0 = acc[ai][0][m][0], a1 = acc[ai][0][m][1], b0 = acc[ai][1][m][0], b1 = acc[ai][1][m][1];
                    if (gate) {
#pragma unroll
                        for (int j = 0; j < 4; ++j) { a0[j] = fsigmoid(a0[j]); a1[j] = fsigmoid(a1[j]); b0[j] = fsigmoid(b0[j]); b1[j] = fsigmoid(b1[j]); }
                    }
                    uint4 p0, p1;
                    p0.x = pack2(a0[0], a0[1]); p0.y = pack2(a0[2], a0[3]); p0.z = pack2(a1[0], a1[1]); p0.w = pack2(a1[2], a1[3]);
                    p1.x = pack2(b0[0], b0[1]); p1.y = pack2(b0[2], b0[3]); p1.z = pack2(b1[0], b1[1]); p1.w = pack2(b1[2], b1[3]);
                    store_wide32((char*)P, ((unsigned)row * DIN + pc0) * 2u, (unsigned)DIN * 2u, fr, p0, p1);
                }
        };
        g8::gemm8<true, false, true, -9>((LAS unsigned char*)lds, 1024, 1024, 512, gen, epi);
    }
}

DEV void phase_merge(const Params& p, char* lds) {
    bf16_t* P = (bf16_t*)(p.ws + OFF_PROJ);
    const char* W = (const char*)(p.ws + OFF_WBR);
    struct Gen { g8::TileOrder o; const char* P; const char* W; int G, c;
        DEV bool next(int i, g8::GUnit& u) const { int pm, pn; const int ti = i / 3, b = i - ti * 3; if (!o.get(ti * G + c, pm, pn)) return false; u.pm = pm; u.pn = pn; u.aux = b | (b > 0 ? 256 : 0); u.rows = nullptr;
            const int ycol = (b == 0) ? C_FQ : (b == 1) ? C_MO : C_HG;
            u.A = P + ((size_t)pm * 256 * DIN + ycol) * 2; u.B = W + ((size_t)b * 1024 + pn * 256) * 512 * 2; return true; } } gen;
    gen.o.init(T / 256, 4); gen.P = (const char*)P; gen.W = W; gen.G = gridDim.x; gen.c = bid_op();
    auto epi = [&](f32x4 (&acc)[2][2][4][2], const g8::GUnit& u, int wr, int wc, int fr, int fq) {
        const int b = u.aux & 3;
#pragma unroll
        for (int ai = 0; ai < 2; ++ai) {
            uint4 gq[8], hq[8];
            bf16_t* rp = P + (size_t)(u.pm * 256 + ai * 128 + wr * 64 + fr) * DIN + u.pn * 256 + 64 * wc + 16 * fq;
#pragma unroll
            for (int m = 0; m < 4; ++m)
#pragma unroll
                for (int hf = 0; hf < 2; ++hf) {
                    const bf16_t* q = rp + (size_t)(m * 16) * DIN + hf * 8 + C_GATES + b * 1024;
                    gq[m * 2 + hf] = *(const uint4*)q;
                    if (b < 2) hq[m * 2 + hf] = *(const uint4*)(q + 1024);
                }
#pragma unroll
            for (int m = 0; m < 4; ++m) {
#pragma unroll
                for (int bj = 0; bj < 2; ++bj) {
                    float g[8]; unpack8(gq[m * 2 + bj], g);
                    if (b > 0) {
#pragma unroll
                        for (int j = 0; j < 8; ++j) g[j] = fmaxf(g[j], 1e-6f);
                    }
                    if (b < 2) { float gn[8]; unpack8(hq[m * 2 + bj], gn);
#pragma unroll
                        for (int j = 0; j < 8; ++j) g[j] *= __builtin_amdgcn_rcpf(fmaxf(gn[j], 1e-6f)); }
#pragma unroll
                    for (int j = 0; j < 4; ++j) { acc[ai][bj][m][0][j] *= g[j]; acc[ai][bj][m][1][j] *= g[4 + j]; }
                }
                if (b == 2) {
                    const f32x4 a0 = acc[ai][0][m][0], a1 = acc[ai][0][m][1], b0 = acc[ai][1][m][0], b1 = acc[ai][1][m][1];
                    uint4 p0, p1;
                    p0.x = pack2(a0[0], a0[1]); p0.y = pack2(a0[2], a0[3]); p0.z = pack2(a1[0], a1[1]); p0.w = pack2(a1[2], a1[3]);
                    p1.x = pack2(b0[0], b0[1]); p1.y = pack2(b0[2], b0[3]); p1.z = pack2(b1[0], b1[1]); p1.w = pack2(b1[2], b1[3]);
                    store_wide32((char*)(p.ws + OFF_H), ((unsigned)(u.pm * 256 + ai * 128 + wr * 64 + m * 16 + fr) * 1024u + (unsigned)(u.pn * 256 + 64 * wc + 16 * fq)) * 2u, 2048u, fr, p0, p1);
                }
            }
        }
    };
    g8::gemm8<true, false, false>((LAS unsigned char*)lds, DIN * 2, 1024, 512, gen, epi);
}

DEV void phase_out(const Params& p, int layer, char* lds) {
    const char* M = (const char*)(p.ws + OFF_H);
    const char* W = (const char*)(p.ws + OFF_WOUT);
    const float* mod = (const float*)(p.ws + OFF_MOD) + (size_t)layer * 16 * 6144;
    struct Gen { g8::TileOrder o; const char* M; const char* W; int G, c;
        DEV bool next(int i, g8::GUnit& u) const { int pm, pn; if (!o.get(i * G + c, pm, pn)) return false; u.pm = pm; u.pn = pn; u.aux = i; u.rows = nullptr;
            u.A = M + (size_t)pm * 256 * 2048; u.B = W + (size_t)pn * 256 * 2048; return true; } } gen;
    gen.o.init(T / 256, 4); gen.M = M; gen.W = W; gen.G = gridDim.x; gen.c = bid_op();
    const float* xf = p.in[I_X];
    const bf16_t* xh = (const bf16_t*)p.out;
    const int jmax = (MOE_CBLOCKS + (int)gridDim.x - 1) / (int)gridDim.x, umin = (T / 256 * 4) / (int)gridDim.x, jslice = (jmax + umin - 1) / umin;
    auto epi = [&](const f32x4 (&acc)[2][2][4][2], const g8::GUnit& u, int wr, int wc, int fr, int fq) {
        const int bb = (u.pm * 256) >> 11;
        const int c0 = u.pn * 256 + 64 * wc + 16 * fq;
        f32x4 g1[4];
#pragma unroll
        for (int q = 0; q < 4; ++q) g1[q] = *(const f32x4*)(mod + (size_t)bb * 6144 + 2 * 1024 + c0 + 4 * q);
#pragma unroll
        for (int ai = 0; ai < 2; ++ai) {
            const unsigned r0 = (unsigned)(u.pm * 256 + ai * 128 + wr * 64 + fr);
            if (layer == 0) {
#pragma unroll
                for (int mh = 0; mh < 2; ++mh) {
                    f32x4 xr[2][4];
#pragma unroll
                    for (int m = 0; m < 2; ++m)
#pragma unroll
                        for (int q = 0; q < 4; ++q) xr[m][q] = *(const f32x4*)(xf + (size_t)(r0 + (mh * 2 + m) * 16) * 1024 + c0 + 4 * q);
#pragma unroll
                    for (int m2 = 0; m2 < 2; ++m2) {
                        const int m = mh * 2 + m2;
                        float o[16];
#pragma unroll
                        for (int bj = 0; bj < 2; ++bj)
#pragma unroll
                            for (int n = 0; n < 2; ++n)
#pragma unroll
                                for (int j = 0; j < 4; ++j) o[8 * bj + 4 * n + j] = xr[m2][2 * bj + n][j] + g1[2 * bj + n][j] * acc[ai][bj][m][n][j];
                        uint4 p0, p1;
                        p0.x = pack2(o[0], o[1]); p0.y = pack2(o[2], o[3]); p0.z = pack2(o[4], o[5]); p0.w = pack2(o[6], o[7]);
                        p1.x = pack2(o[8], o[9]); p1.y = pack2(o[10], o[11]); p1.z = pack2(o[12], o[13]); p1.w = pack2(o[14], o[15]);
                        store_wide32((char*)(p.ws + OFF_XB), ((r0 + m * 16) * 1024u + (unsigned)c0) * 2u, 2048u, fr, p0, p1);
                    }
                }
            } else {
                uint4 xr[4][2];
#pragma unroll
                for (int m = 0; m < 4; ++m)
#pragma unroll
                    for (int q = 0; q < 2; ++q) xr[m][q] = *(const uint4*)(xh + (size_t)(r0 + m * 16) * 1024 + c0 + 8 * q);
#pragma unroll
                for (int m = 0; m < 4; ++m) {
                    float o[16];
#pragma unroll
                    for (int bj = 0; bj < 2; ++bj) {
                        float xv[8]; unpack8(xr[m][bj], xv);
#pragma unroll
                        for (int n = 0; n < 2; ++n)
#pragma unroll
                            for (int j = 0; j < 4; ++j) o[8 * bj + 4 * n + j] = xv[4 * n + j] + g1[2 * bj + n][j] * acc[ai][bj][m][n][j];
                    }
                    uint4 p0, p1;
                    p0.x = pack2(o[0], o[1]); p0.y = pack2(o[2], o[3]); p0.z = pack2(o[4], o[5]); p0.w = pack2(o[6], o[7]);
                    p1.x = pack2(o[8], o[9]); p1.y = pack2(o[10], o[11]); p1.z = pack2(o[12], o[13]); p1.w = pack2(o[14], o[15]);
                    store_wide32((char*)(p.ws + OFF_XB), ((r0 + m * 16) * 1024u + (unsigned)c0) * 2u, 2048u, fr, p0, p1);
                }
            }
        }
        { const int j0 = u.aux * jslice, j1 = (j0 + jslice < jmax) ? j0 + jslice : jmax; conv_moe_slice(p, layer, j0, j1); }
    };
    g8::gemm8<true, false, false>((LAS unsigned char*)lds, 2048, 2048, 1024, gen, epi);
}

DEV void phase_front(const Params& p, int layer, char* lds) {
    constexpr int LDH = 1032;
    bf16_t* HT = (bf16_t*)lds;
    float* LG = (float*)(HT + 32 * LDH);
    int* cntl = (int*)(LG + 32 * 64);
    int* basel = cntl + 128;
    int* sel = basel + 128;
    const int tid = tid_op(), lane = tid & 63, wid = tid >> 6, qi = lane & 15, g = lane >> 4;
    const float* gam = p.in[I_N2G] + layer * 1024;
    const float* mod = (const float*)(p.ws + OFF_MOD) + (size_t)layer * 16 * 6144;
    const bf16_t* WrT = (const bf16_t*)(p.ws + OFF_WRT);
    bf16_t* Hb = (bf16_t*)(p.ws + OFF_H);
    const float bias = p.in[I_RB][layer * 64 + lane];
    int* idx = (int*)(p.ws + OFF_IDX); float* wts = (float*)(p.ws + OFF_WTS); int* rank = (int*)(p.ws + OFF_RANK);
    int* cnt = (int*)(p.ws + OFF_CNT) + layer * 128 * CNT_STRIDE;
    __syncthreads();
    if (tid < 128) cntl[tid] = 0;
    const int ntok = T / (int)gridDim.x, tbase = bid_op() * ntok;
    const int grp = lane >> 3;
#pragma unroll 1
    for (int sub = 0; sub < ntok / 32; ++sub) {
        const int t0 = tbase + sub * 32;
        {
            f32x4 v[4][4];
#pragma unroll
            for (int rr = 0; rr < 4; ++rr) {
                const bf16_t* xr = (const bf16_t*)(p.ws + OFF_XB) + (size_t)(t0 + wid * 4 + rr) * 1024;
#pragma unroll
                for (int i = 0; i < 4; ++i) { const uint2 q = *(const uint2*)(xr + i * 256 + lane * 4);
                    v[rr][i] = (f32x4){__uint_as_float(q.x << 16), __uint_as_float(q.x & 0xffff0000u), __uint_as_float(q.y << 16), __uint_as_float(q.y & 0xffff0000u)}; }
            }
            const int b = t0 >> 11;
            const float* sh = mod + (size_t)b * 6144 + 3 * 1024;
            const float* sc = sh + 1024;
#pragma unroll
            for (int rr = 0; rr < 4; ++rr) {
                float ss = 0.f;
#pragma unroll
                for (int i = 0; i < 4; ++i) ss += v[rr][i][0] * v[rr][i][0] + v[rr][i][1] * v[rr][i][1] + v[rr][i][2] * v[rr][i][2] + v[rr][i][3] * v[rr][i][3];
                ss = wave_sum(ss);
                const float rstd = rsqrtf(ss * (1.f / 1024.f) + 1e-6f);
                const int row = t0 + wid * 4 + rr;
#pragma unroll
                for (int i = 0; i < 4; ++i) {
                    const int c = i * 256 + lane * 4;
                    const f32x4 g4 = *(const f32x4*)(gam + c), sc4 = *(const f32x4*)(sc + c), sh4 = *(const f32x4*)(sh + c);
                    const float y0 = v[rr][i][0] * rstd * g4[0] * (1.f + sc4[0]) + sh4[0], y1 = v[rr][i][1] * rstd * g4[1] * (1.f + sc4[1]) + sh4[1];
                    const float y2 = v[rr][i][2] * rstd * g4[2] * (1.f + sc4[2]) + sh4[2], y3 = v[rr][i][3] * rstd * g4[3] * (1.f + sc4[3]) + sh4[3];
                    uint2 o; o.x = pack2(y0, y1); o.y = pack2(y2, y3);
                    *(unsigned*)(p.ws + OFF_H2F8 + (size_t)row * 1024 + c) = pack4_fp8(y0 * F8_ACT_SCALE, y1 * F8_ACT_SCALE, y2 * F8_ACT_SCALE, y3 * F8_ACT_SCALE);
                    *(uint2*)&HT[(wid * 4 + rr) * LDH + c] = o;
                }
            }
        }
        __syncthreads();
        {
            const int mt = wid >> 2, nt = wid & 3;
            f32x4 acc = (f32x4){0.f, 0.f, 0.f, 0.f};
            const bf16_t* wp = WrT + (size_t)(nt * 16 + qi) * 1024 + 8 * g;
            const bf16_t* hp = HT + (mt * 16 + qi) * LDH + 8 * g;
#pragma unroll
            for (int k8 = 0; k8 < 2; ++k8) {
                bf16x8 bw[16];
#pragma unroll
                for (int kk = 0; kk < 16; ++kk) bw[kk] = *(const bf16x8*)(wp + 32 * (k8 * 16 + kk));
#pragma unroll
                for (int kk = 0; kk < 16; ++kk) acc = __builtin_amdgcn_mfma_f32_16x16x32_bf16(*(const bf16x8*)(hp + 32 * (k8 * 16 + kk)), bw[kk], acc, 0, 0, 0);
            }
#pragma unroll
            for (int j = 0; j < 4; ++j) LG[(mt * 16 + 4 * g + j) * 64 + nt * 16 + qi] = acc[j];
        }
        __syncthreads();
#pragma unroll 1
        for (int rr = 0; rr < 4; ++rr) {
            const int k = sub * 32 + wid * 4 + rr, t = tbase + k;
            const float s = fsigmoid(LG[(wid * 4 + rr) * 64 + lane]);
            const float c = s + bias;
            float m1 = c;
            m1 = fmaxf(m1, sx(m1, 1)); m1 = fmaxf(m1, sx(m1, 2)); m1 = fmaxf(m1, sx(m1, 4));
            const unsigned long long bal = __ballot(c == m1);
            const unsigned gb = (unsigned)((bal >> (grp * 8)) & 0xffull);
            const int first = __ffs(gb) - 1;
            float c2 = ((lane & 7) == first) ? -INFINITY : c;
            c2 = fmaxf(c2, sx(c2, 1)); c2 = fmaxf(c2, sx(c2, 2)); c2 = fmaxf(c2, sx(c2, 4));
            const float gs = m1 + c2;
            int cg = 0;
#pragma unroll
            for (int gg = 0; gg < 8; ++gg) { const float v = __builtin_bit_cast(float, __builtin_amdgcn_readlane(__builtin_bit_cast(int, gs), gg * 8)); cg += (v > gs || (v == gs && gg < grp)) ? 1 : 0; }
            const float masked = (cg < 4) ? c : -INFINITY;
            int r = 0;
#pragma unroll
            for (int j = 0; j < 64; ++j) { const float v = __builtin_bit_cast(float, __builtin_amdgcn_readlane(__builtin_bit_cast(int, masked), j)); r += (v > masked || (v == masked && j < lane)) ? 1 : 0; }
            const bool selb = (r < 8) && (cg < 4);
            const float wsum = wave_sum(selb ? s : 0.f);
            if (selb) {
                const int half = t / HALF_T;
                idx[(size_t)t * 8 + r] = lane;
                wts[(size_t)t * 8 + r] = s / wsum * 2.5f;
                const int lr = atomicAdd(&cntl[half * 64 + lane], 1);
                sel[k * 8 + r] = (lane << 16) | lr;
            }
        }
    }
    __syncthreads();
    if (tid < 128) basel[tid] = atomicAdd(&cnt[tid * CNT_STRIDE], cntl[tid]);
    __syncthreads();
    for (int i = tid; i < ntok * 8; i += 512) {
        const int t = tbase + (i >> 3), half = t / HALF_T, v = sel[i];
        rank[(size_t)t * 8 + (i & 7)] = basel[half * 64 + (v >> 16)] + (v & 0xffff);
    }
}

DEV void phase_scatter(const Params& p, int layer, char* lds) {
    int* poff = (int*)lds;
    const int* cnt = (const int*)(p.ws + OFF_CNT) + layer * 128 * CNT_STRIDE;
    const int t = tid_op();
    int* cl = poff + 132;
    __syncthreads();
    if (t < 128) cl[t] = cnt[t * CNT_STRIDE];
    __syncthreads();
    if (t < NHALF) {
        int o = 0;
        for (int l = 0; l < NLIST; ++l) { poff[t * 66 + l] = o; const int c = (l < NEXP) ? cl[t * 64 + l] : HALF_T; o += (c + 255) / 256 * 256; }
        poff[t * 66 + NLIST] = o;
    }
    __syncthreads();
    const int* idx = (const int*)(p.ws + OFF_IDX); const int* rank = (const int*)(p.ws + OFF_RANK);
    int* rowtok = (int*)(p.ws + OFF_ROWTOK); int* posa = (int*)(p.ws + OFF_POS);
    int* tilel = (int*)(p.ws + OFF_TILEL);
    const int gt = bid_op() * 512 + t, gn = gridDim.x * 512;
    for (int a = gt; a < T * 8; a += gn) {
        const int tok = a >> 3, k = a & 7, half = tok / HALF_T, e = idx[a];
        const int pos = poff[half * 66 + e] + rank[a];
        rowtok[half * ROWCAP + pos] = tok; posa[tok * NSLOT + k] = pos;
    }
    for (int tok = gt; tok < T; tok += gn) {
        const int half = tok / HALF_T, tl = tok - half * HALF_T;
        const int pos = poff[half * 66 + NEXP] + tl;
        rowtok[half * ROWCAP + pos] = tok; posa[tok * NSLOT + 8] = pos;
    }
    for (int j = gt; j < NHALF * NLIST * 256; j += gn) {
        const int half = j / (NLIST * 256), l = (j / 256) % NLIST, i = j & 255;
        const int c = (l < NEXP) ? cnt[(half * 64 + l) * CNT_STRIDE] : HALF_T;
        if ((c & 255) != 0 && i >= (c & 255)) {
            const int pos = poff[half * 66 + l] + (c & ~255) + i;
            rowtok[half * ROWCAP + pos] = half * HALF_T;
        }
    }
    for (int j = gt; j < NHALF * TILECAP; j += gn) {
        const int half = j / TILECAP, tile = j % TILECAP;
        const int row = tile * 256;
        if (row < poff[half * 66 + NLIST]) {
            int l = 0;
            for (int q = 1; q < NLIST; ++q) if (row >= poff[half * 66 + q]) l = q;
            tilel[half * (TILECAP + 16) + tile] = l;
        }
        if (tile == 0) tilel[half * (TILECAP + 16) + TILECAP] = poff[half * 66 + NLIST] / 256;
    }
}

DEV void phase_moe_up(const Params& p, int half, char* lds) {
    const char* H = (const char*)(p.ws + OFF_H2F8);
    const char* W13 = (const char*)(p.ws + OFF_W13);
    bf16_t* HID = (bf16_t*)(p.ws + OFF_HID);
    const int* rowtok = (const int*)(p.ws + OFF_ROWTOK) + half * ROWCAP;
    const int* tilel = (const int*)(p.ws + OFF_TILEL) + half * (TILECAP + 16);
    LAS int* TL = (LAS int*)(lds + 131072);
    struct Gen { const char* H; const char* W; const int* rowtok; LAS const int* tl; LAS int* rb; int nun, G, c;
        DEV bool next(int i, g8::GUnit& u) const { const int L = i * G + c; if (L >= nun) return false; const int tile = L >> 1, pn = L & 1, l = __builtin_amdgcn_readfirstlane(tl[tile]);
            u.pm = tile; u.pn = pn; u.aux = l; u.rows = rowtok + tile * 256; u.A = H; u.B = W + ((size_t)l * 512 + pn * 256) * 1024; return true; } } gen;
    gen.H = H; gen.W = W13; gen.rowtok = rowtok; gen.tl = TL; gen.rb = TL + TL_PAD; gen.nun = __builtin_amdgcn_readfirstlane(tilel[TILECAP]) * 2; gen.G = gridDim.x; gen.c = bid_op();
    __syncthreads();
    for (int i = tid_op(); i < (gen.nun >> 1); i += 512) TL[i] = tilel[i];
    __syncthreads();
    auto epi = [&](const f32x4 (&acc)[2][2][4][2], const g8::GUnit& u, int wr, int wc, int fr, int fq) {
#pragma unroll
        for (int ai = 0; ai < 2; ++ai)
#pragma unroll
            for (int m = 0; m < 4; ++m) {
                const int row = u.pm * 256 + ai * 128 + wr * 64 + m * 16 + fr;
                uint2 o;
#pragma unroll
                for (int bj = 0; bj < 2; ++bj) {
                    const f32x4 v1 = acc[ai][bj][m][0], v3 = acc[ai][bj][m][1];
                    const unsigned w = pack4_fp8(fsilu(v1[0]) * v3[0] * F8_ACT_SCALE, fsilu(v1[1]) * v3[1] * F8_ACT_SCALE, fsilu(v1[2]) * v3[2] * F8_ACT_SCALE, fsilu(v1[3]) * v3[3] * F8_ACT_SCALE);
                    if (bj == 0) o.x = w; else o.y = w;
                }
                *(uint2*)((unsigned char*)HID + (size_t)row * 256 + u.pn * 128 + 32 * wc + 8 * fq) = o;
            }
    };
    g8::gemm8<true, true, true, -9>((LAS unsigned char*)lds, 1024, 1024, 512, gen, epi);
}
DEV void phase_moe_down(const Params& p, int half, char* lds) {
    const char* HID = (const char*)(p.ws + OFF_HID);
    const char* W2 = (const char*)(p.ws + OFF_W2);
    unsigned char* OA = (unsigned char*)(p.ws + OFF_OUTA);
    const int* tilel = (const int*)(p.ws + OFF_TILEL) + half * (TILECAP + 16);
    LAS int* TL = (LAS int*)(lds + 131072);
    struct Gen { const char* HID; const char* W; const char* WS; LAS const int* tl; int nun, G, c;
        DEV bool next(int i, g8::GUnit& u) const { const int L = i * G + c; if (L >= nun) return false; const int tile = L >> 2, pn = L & 3, l = __builtin_amdgcn_readfirstlane(tl[tile]);
            u.pm = tile; u.pn = pn; u.aux = l; u.rows = nullptr; u.A = HID + (size_t)tile * 256 * 256; u.B = (l < NEXP ? W + (size_t)l * 1024 * 256 : WS) + (size_t)pn * 256 * 256; return true; } } gen;
    gen.HID = HID; gen.W = W2; gen.WS = (const char*)(p.ws + OFF_W2S); gen.tl = TL; gen.nun = __builtin_amdgcn_readfirstlane(tilel[TILECAP]) * 4; gen.G = gridDim.x; gen.c = bid_op();
    __syncthreads();
    for (int i = tid_op(); i < (gen.nun >> 2); i += 512) TL[i] = tilel[i];
    __syncthreads();
    auto epi = [&](const f32x4 (&acc)[2][2][4][2], const g8::GUnit& u, int wr, int wc, int fr, int fq) {
#pragma unroll
        for (int ai = 0; ai < 2; ++ai)
#pragma unroll
            for (int m = 0; m < 4; ++m) {
                const int row = u.pm * 256 + ai * 128 + wr * 64 + m * 16 + fr;
                unsigned w4[4];
#pragma unroll
                for (int bj = 0; bj < 2; ++bj) {
                    const f32x4 v0 = acc[ai][bj][m][0], v1 = acc[ai][bj][m][1];
                    w4[2 * bj] = pack4_fp8(v0[0], v0[1], v0[2], v0[3]); w4[2 * bj + 1] = pack4_fp8(v1[0], v1[1], v1[2], v1[3]);
                }
                *(uint4*)(OA + (size_t)row * 1024 + u.pn * 256 + 64 * wc + 16 * fq) = make_uint4(w4[0], w4[1], w4[2], w4[3]);
            }
    };
    g8::gemm8<true, false, true, -5>((LAS unsigned char*)lds, 256, 256, 128, gen, epi);
}
DEV void phase_combine(const Params& p, int layer, int half) {
    const unsigned char* OA = (const unsigned char*)(p.ws + OFF_OUTA);
    const float* mod = (const float*)(p.ws + OFF_MOD) + (size_t)layer * 16 * 6144;
    const float* modn = (const float*)(p.ws + OFF_MOD) + (size_t)(layer + 1) * 16 * 6144;
    const float* gnx = p.in[I_N1G] + (layer + 1) * 1024;
    bf16_t* Hb = (bf16_t*)(p.ws + OFF_H);
    const int tid = tid_op(), lane = tid & 63, wid = tid >> 6;
    typedef float f32x2v __attribute__((ext_vector_type(2)));
    for (int tl0 = bid_op() * 8 + wid; tl0 < HALF_T; tl0 += gridDim.x * 8) {
        const int tok = __builtin_amdgcn_readfirstlane(half * HALF_T + tl0), b = tok >> 11;
        const float* wt = (const float*)(p.ws + OFF_WTS) + (size_t)tok * 8;
        const int* ps = (const int*)(p.ws + OFF_POS) + (size_t)tok * NSLOT;
        uint4 rw[NSLOT];
#pragma unroll
        for (int k = 0; k < NSLOT; ++k) rw[k] = *(const uint4*)(OA + (size_t)ps[k] * 1024 + lane * 16);
        float* o = p.out + (size_t)tok * 1024 + lane * 16;
        float x[16];
        { const bf16_t* xb = (const bf16_t*)(p.ws + OFF_XB) + (size_t)tok * 1024 + lane * 16;
          const uint4 q0 = *(const uint4*)xb, q1 = *(const uint4*)(xb + 8); unpack8(q0, x); unpack8(q1, x + 8); }
        float a[16];
#pragma unroll
        for (int j = 0; j < 16; ++j) a[j] = 0.f;
#pragma unroll
        for (int k = 0; k < NSLOT; ++k) {
            const float w = ((k < 8) ? wt[k] : 1.f) * (1.f / 16.f);
            const unsigned uu[4] = {rw[k].x, rw[k].y, rw[k].z, rw[k].w};
#pragma unroll
            for (int q = 0; q < 4; ++q) {
                const f32x2v f0 = __builtin_amdgcn_cvt_pk_f32_fp8((int)uu[q], false), f1 = __builtin_amdgcn_cvt_pk_f32_fp8((int)uu[q], true);
                a[4 * q] += w * f0[0]; a[4 * q + 1] += w * f0[1]; a[4 * q + 2] += w * f1[0]; a[4 * q + 3] += w * f1[1];
            }
        }
        const float* g2 = mod + (size_t)b * 6144 + 5 * 1024 + lane * 16;
        float xn[16]; float ss = 0.f;
#pragma unroll
        for (int q = 0; q < 4; ++q) {
            const f32x4 gq = *(const f32x4*)(g2 + 4 * q);
#pragma unroll
            for (int j = 0; j < 4; ++j) { xn[4 * q + j] = x[4 * q + j] + gq[j] * a[4 * q + j]; ss += xn[4 * q + j] * xn[4 * q + j]; }
            if (layer != 0) *(f32x4*)(o + 4 * q) = (f32x4){xn[4 * q], xn[4 * q + 1], xn[4 * q + 2], xn[4 * q + 3]};
        }
        if (layer == 0) {
            {
                bf16_t* ob = (bf16_t*)p.out + (size_t)tok * 1024 + lane * 16; uint4 w;
                w.x = pack2(xn[0], xn[1]); w.y = pack2(xn[2], xn[3]); w.z = pack2(xn[4], xn[5]); w.w = pack2(xn[6], xn[7]); *(uint4*)ob = w;
                w.x = pack2(xn[8], xn[9]); w.y = pack2(xn[10], xn[11]); w.z = pack2(xn[12], xn[13]); w.w = pack2(xn[14], xn[15]); *(uint4*)(ob + 8) = w;
            }
            ss = wave_sum(ss);
            const float rstd = rsqrtf(ss * (1.f / 1024.f) + 1e-6f);
            const float* sh = modn + (size_t)b * 6144 + lane * 16;
            const float* sc = sh + 1024;
            float h[16];
#pragma unroll
            for (int j = 0; j < 16; ++j) h[j] = xn[j] * rstd * gnx[lane * 16 + j] * (1.f + sc[j]) + sh[j];
            uint4 w;
            w.x = pack2(h[0], h[1]); w.y = pack2(h[2], h[3]); w.z = pack2(h[4], h[5]); w.w = pack2(h[6], h[7]);
            *(uint4*)(Hb + (size_t)tok * 1024 + lane * 16) = w;
            w.x = pack2(h[8], h[9]); w.y = pack2(h[10], h[11]); w.z = pack2(h[12], h[13]); w.w = pack2(h[14], h[15]);
            *(uint4*)(Hb + (size_t)tok * 1024 + lane * 16 + 8) = w;
            const float s8 = F8_ACT_SCALE;
            *(uint4*)(p.ws + OFF_H8 + (size_t)tok * 1024 + lane * 16) = make_uint4(pack4_fp8(h[0] * s8, h[1] * s8, h[2] * s8, h[3] * s8), pack4_fp8(h[4] * s8, h[5] * s8, h[6] * s8, h[7] * s8),
                                                                                   pack4_fp8(h[8] * s8, h[9] * s8, h[10] * s8, h[11] * s8), pack4_fp8(h[12] * s8, h[13] * s8, h[14] * s8, h[15] * s8));
        }
    }
}

typedef short v4i16_t __attribute__((ext_vector_type(4)));
DEV v4i16_t lds_tr(const bf16_t* ptr) { return __builtin_amdgcn_ds_read_tr16_b64_v4i16((LAS v4i16_t*)ptr); }

DEV void prep_hgrn(const Params& p, int layer, int u, char* lds, int tid, uint4 rf0, uint4 rf1, uint4 rq0, uint4 rq1) {
    float* LF = (float*)lds;
    float* OFFS = LF + 64 * 128;
    bf16_t* P = (bf16_t*)(p.ws + OFF_PROJ);
    const int bh = u >> 5, c = u & 31, b = bh >> 2, h = bh & 3;
    const int row0 = tid >> 4, col0 = (tid & 15) * 8;
    bf16_t* gb = P + ((size_t)b * SEQ + c * 64 + row0) * DIN + h * 128 + col0;
    float kk[2][8], qq[2][8];
    float lbv[8];
#pragma unroll
    for (int j = 0; j < 8; ++j) { lbv[j] = 0.f; if (layer == 1) { const float p0 = p.in[I_HLB][h * 128 + col0 + j], p1 = p.in[I_HLB][512 + h * 128 + col0 + j]; lbv[j] = 1.f / (1.f + __expf(p0 - p1)); } }
    lds_barrier();
#pragma unroll
    for (int i = 0; i < 2; ++i) {
        const int row = row0 + 32 * i;
        float z[8], qv[8], lf[8];
        unpack8(i == 0 ? rf0 : rf1, z); unpack8(i == 0 ? rq0 : rq1, qv);
#pragma unroll
        for (int j = 0; j < 8; ++j) {
            const float lb = lbv[j];
            const float sg = fsigmoid(z[j]);
            lf[j] = __logf(lb + (1.f - lb) * sg);
            kk[i][j] = (1.f - lb) * (1.f - sg);
            qq[i][j] = fsilu(qv[j]);
        }
        *(f32x4*)&LF[row * 128 + col0] = (f32x4){lf[0], lf[1], lf[2], lf[3]};
        *(f32x4*)&LF[row * 128 + col0 + 4] = (f32x4){lf[4], lf[5], lf[6], lf[7]};
    }
    lds_barrier();
    {
        const int d = tid & 127, part = tid >> 7;
        float v[16];
#pragma unroll
        for (int t = 0; t < 16; ++t) v[t] = LF[(part * 16 + t) * 128 + d];
#pragma unroll
        for (int t = 1; t < 16; ++t) v[t] += v[t - 1];
#pragma unroll
        for (int t = 0; t < 16; ++t) LF[(part * 16 + t) * 128 + d] = v[t];
        OFFS[part * 128 + d] = v[15];
    }
    lds_barrier();
#pragma unroll
    for (int i = 0; i < 2; ++i) {
        const int row = row0 + 32 * i, part = row >> 4;
        float qm[8], km[8];
#pragma unroll
        for (int j = 0; j < 8; ++j) {
            const int d = col0 + j;
            const float o0 = OFFS[d], o1 = OFFS[128 + d], o2 = OFFS[256 + d];
            const float off = (part > 0 ? o0 : 0.f) + (part > 1 ? o1 : 0.f) + (part > 2 ? o2 : 0.f);
            const float At = LF[row * 128 + d] + off, Am = LF[31 * 128 + d] + o0;
            qm[j] = qq[i][j] * __expf(At - Am);
            km[j] = kk[i][j] * __expf(fminf(Am - At, 60.f));
        }
        uint4 w; w.x = pack2(qm[0], qm[1]); w.y = pack2(qm[2], qm[3]); w.z = pack2(qm[4], qm[5]); w.w = pack2(qm[6], qm[7]);
        *(uint4*)(gb + (size_t)(32 * i) * DIN + C_HQ) = w;
        w.x = pack2(km[0], km[1]); w.y = pack2(km[2], km[3]); w.z = pack2(km[4], km[5]); w.w = pack2(km[6], km[7]);
        *(uint4*)(gb + (size_t)(32 * i) * DIN + C_HF) = w;
    }
    if (tid < 128) {
        const float o0 = OFFS[tid], o1 = OFFS[128 + tid], o2 = OFFS[256 + tid];
        const float Am = LF[31 * 128 + tid] + o0, Ac = LF[63 * 128 + tid] + o0 + o1 + o2;
        float* ev = (float*)(p.ws + OFF_EVBUF) + (size_t)u * 384;
        ev[tid] = __expf(Am); ev[128 + tid] = __expf(Ac); ev[256 + tid] = __expf(Ac - Am);
    }
}

DEV void prep_mlstm(const Params& p, int layer, int u, char* lds, int tid, uint4 rr0, uint4 rr1, uint4 rr2, float gmi, float gmf) {
    bf16_t* RAW = (bf16_t*)lds;
    float* EQ = (float*)(RAW + 67 * 128 + 64);
    float* EW = EQ + 64;
    float* CW = EW + 64;
    const int lane = tid & 63, wid = tid >> 6;
    const int bh = u >> 5, c = u & 31, h = bh & 3, t0 = c * 64;
    const int pr = tid >> 4, pc8 = (tid & 15) * 8;
    lds_barrier();
    *(uint4*)&RAW[pr * 128 + pc8] = rr0;
    *(uint4*)&RAW[(pr + 32) * 128 + pc8] = rr1;
    if (tid < 48) *(uint4*)&RAW[(pr + 64) * 128 + pc8] = rr2;
    {
        const int j = tid >> 7, cc = tid & 127;
        const int ch = (cc < 64) ? (h * 64 + cc) : (256 + h * 64 + (cc - 64));
        CW[j * 128 + cc] = p.in[I_MCONV][(size_t)layer * 4 * 512 + j * 512 + ch];
    }
    if (wid == 0) {
        const float ip = gmi + p.in[I_MBI][layer * 4 + h];
        float bc = logsigmoid_f(gmf + p.in[I_MBF][layer * 4 + h]);
#pragma unroll
        for (int o = 1; o < 64; o <<= 1) { const float n = sup(bc, o); if (lane >= o) bc += n; }
        const float bcC = sfrom(bc, 63);
        const float eq = __expf(bc), ew = __expf(bcC - bc + ip);
        EQ[lane] = eq; EW[lane] = ew;
        *(f32x4*)((float*)(p.ws + OFF_GBUF) + ((size_t)bh * SEQ + t0 + lane) * 4) = (f32x4){bc, ip, eq, ew};
        if (lane == 0) ((float*)(p.ws + OFF_ECBUF))[u] = __expf(bcC);
    }
    lds_barrier();
    bf16_t* blk = (bf16_t*)(p.ws + OFF_H) + (size_t)u * (4 * 64 * 64);
#pragma unroll 1
    for (int hh = 0; hh < 2; ++hh) {
        const int row = tid >> 3, c8 = (tid & 7) * 16 + hh * 8;
        float a[8];
#pragma unroll
        for (int e = 0; e < 8; ++e) a[e] = 0.f;
#pragma unroll
        for (int j = 0; j < 4; ++j) {
            float x[8];
            unpack8(*(const uint4*)&RAW[(row + j) * 128 + c8], x);
            const f32x4 w0 = *(const f32x4*)&CW[j * 128 + c8], w1 = *(const f32x4*)&CW[j * 128 + c8 + 4];
            a[0] += w0[0] * x[0]; a[1] += w0[1] * x[1]; a[2] += w0[2] * x[2]; a[3] += w0[3] * x[3];
            a[4] += w1[0] * x[4]; a[5] += w1[1] * x[5]; a[6] += w1[2] * x[6]; a[7] += w1[3] * x[7];
        }
        const bool isq = c8 < 64;
        const float sc = isq ? 1.f : 0.125f;
        const float ex = isq ? EQ[row] : EW[row];
        float y[8], ys[8];
#pragma unroll
        for (int e = 0; e < 8; ++e) { y[e] = fsilu(a[e]) * sc; ys[e] = y[e] * ex; }
        bf16_t* d0 = blk + (isq ? 0 : 4096) + row * 64 + (c8 & 63);
        uint4 w;
        w.x = pack2(y[0], y[1]); w.y = pack2(y[2], y[3]); w.z = pack2(y[4], y[5]); w.w = pack2(y[6], y[7]); *(uint4*)d0 = w;
        w.x = pack2(ys[0], ys[1]); w.y = pack2(ys[2], ys[3]); w.z = pack2(ys[4], ys[5]); w.w = pack2(ys[6], ys[7]); *(uint4*)(d0 + 8192) = w;
    }
}

DEV void prep_foxk(const Params& p, int layer, int u, int tid, uint4 kr0, uint4 kr1, uint4 kr2, uint4 kr3) {
    bf16_t* P = (bf16_t*)(p.ws + OFF_PROJ);
    const int bh = u >> 3, rb = u & 7, b = bh >> 3, h = bh & 7;
    const int r = tid >> 3, c8 = (tid & 7) * 8;
    bf16_t* kp = P + ((size_t)b * SEQ + rb * 256 + r) * DIN + C_FK + h * 64 + c8;
    float gk[8];
#pragma unroll
    for (int d = 0; d < 8; ++d) gk[d] = p.in[I_FOXKG][layer * 64 + c8 + d];
#pragma unroll
    for (int i = 0; i < 4; ++i) {
        float kf[8]; unpack8(i == 0 ? kr0 : i == 1 ? kr1 : i == 2 ? kr2 : kr3, kf);
        float ss = 0.f;
#pragma unroll
        for (int d = 0; d < 8; ++d) ss += kf[d] * kf[d];
        ss += sx(ss, 1); ss += sx(ss, 2); ss += sx(ss, 4);
        const float rstd = rsqrtf(ss * (1.f / 64.f) + 1e-6f);
        uint4 w;
        w.x = pack2(kf[0] * rstd * gk[0], kf[1] * rstd * gk[1]); w.y = pack2(kf[2] * rstd * gk[2], kf[3] * rstd * gk[3]);
        w.z = pack2(kf[4] * rstd * gk[4], kf[5] * rstd * gk[5]); w.w = pack2(kf[6] * rstd * gk[6], kf[7] * rstd * gk[7]);
        *(uint4*)(kp + (size_t)(64 * i) * DIN) = w;
    }
}
DEV void prep_foxf(const Params& p, int layer, int bh, char* lds, int tid) {
    float* wsum = (float*)lds;
    const float* GS = (const float*)(p.ws + OFF_GS);
    const int lane = tid & 63, wid = tid >> 6, b = bh >> 3, h = bh & 7;
    const float bfv = p.in[I_FOXBF][layer * 8 + h];
    float v[4]; float loc = 0.f;
#pragma unroll
    for (int i = 0; i < 4; ++i) { const int s = tid * 4 + i; v[i] = logsigmoid_f(GS[((size_t)b * SEQ + s) * 16 + h] + bfv); loc += v[i]; v[i] = loc; }
    float inc = loc;
#pragma unroll
    for (int o = 1; o < 64; o <<= 1) { const float n = sup(inc, o); if (lane >= o) inc += n; }
    lds_barrier();
    if (lane == 63) wsum[wid] = inc;
    lds_barrier();
    float base = inc - loc;
    for (int w = 0; w < wid; ++w) base += wsum[w];
    constexpr float L2E = 1.4426950408889634f;
    *(f32x4*)((float*)(p.ws + OFF_FBUF) + (size_t)bh * SEQ + tid * 4) = (f32x4){-(base + v[0]) * L2E, -(base + v[1]) * L2E, -(base + v[2]) * L2E, -(base + v[3]) * L2E};
}
DEV void phase_prep(const Params& p, int layer, char* lds) {
    const int tid = tid_op(), G = gridDim.x, bid = bid_op();
    const bf16_t* P = (const bf16_t*)(p.ws + OFF_PROJ);
    const float* GS = (const float*)(p.ws + OFF_GS);
    {
        const int row0 = tid >> 4, col0 = (tid & 15) * 8;
        uint4 a0, a1, a2, a3, n0 = make_uint4(0u, 0u, 0u, 0u), n1 = n0, n2 = n0, n3 = n0;
#define HGP_LOAD(r0_, r1_, r2_, r3_, u_) do { const int bh_ = (u_) >> 5, c_ = (u_) & 31; const bf16_t* gb_ = P + ((size_t)(bh_ >> 2) * SEQ + c_ * 64 + row0) * DIN + (bh_ & 3) * 128 + col0; \
            r0_ = *(const uint4*)(gb_ + C_HF); r1_ = *(const uint4*)(gb_ + (size_t)32 * DIN + C_HF); r2_ = *(const uint4*)(gb_ + C_HQ); r3_ = *(const uint4*)(gb_ + (size_t)32 * DIN + C_HQ); } while (0)
        int u = bid;
        if (u < 2048) HGP_LOAD(a0, a1, a2, a3, u);
        for (; u < 2048; u += G) {
            if (u + G < 2048) HGP_LOAD(n0, n1, n2, n3, u + G);
            prep_hgrn(p, layer, u, lds, tid, a0, a1, a2, a3);
            a0 = n0; a1 = n1; a2 = n2; a3 = n3;
        }
#undef HGP_LOAD
    }
    {
        const int pr = tid >> 4, pc8 = (tid & 15) * 8;
        uint4 a0, a1, a2, n0 = make_uint4(0u, 0u, 0u, 0u), n1 = n0, n2 = n0; float g0 = 0.f, g1 = 0.f, m0 = 0.f, m1 = 0.f;
#define MLP_LOAD(r0_, r1_, r2_, gi_, gf_, u_) do { const int bh_ = (u_) >> 5, t0_ = ((u_) & 31) * 64, h_ = bh_ & 3; const bf16_t* rowb_ = P + (size_t)(bh_ >> 2) * SEQ * DIN; \
            const unsigned off_ = (unsigned)pr * DIN + (unsigned)((pc8 < 64) ? (C_MQK + h_ * 64 + pc8) : (C_MQK + 256 + h_ * 64 + (pc8 - 64))); \
            const bf16_t* ub_ = rowb_ + (ptrdiff_t)(t0_ - 3) * DIN; const bool ok_ = (t0_ - 3 + pr >= 0); \
            r0_ = *(const uint4*)(ok_ ? ub_ + off_ : rowb_); if (!ok_) r0_ = make_uint4(0u, 0u, 0u, 0u); \
            r1_ = *(const uint4*)(ub_ + off_ + 32u * DIN); r2_ = *(const uint4*)((tid < 48) ? ub_ + off_ + 64u * DIN : rowb_); \
            const float* gp_ = GS + ((size_t)(bh_ >> 2) * SEQ + t0_ + (tid & 63)) * 16 + 8; gi_ = gp_[h_]; gf_ = gp_[4 + h_]; } while (0)
        int u = bid;
        if (u < 2048) MLP_LOAD(a0, a1, a2, g0, g1, u);
        for (; u < 2048; u += G) {
            if (u + G < 2048) MLP_LOAD(n0, n1, n2, m0, m1, u + G);
            prep_mlstm(p, layer, u, lds, tid, a0, a1, a2, g0, g1);
            a0 = n0; a1 = n1; a2 = n2; g0 = m0; g1 = m1;
        }
#undef MLP_LOAD
    }
    {
        const int r = tid >> 3, c8 = (tid & 7) * 8;
        uint4 a0, a1, a2, a3, n0 = make_uint4(0u, 0u, 0u, 0u), n1 = n0, n2 = n0, n3 = n0;
#define FKP_LOAD(r0_, r1_, r2_, r3_, u_) do { const int bh_ = (u_) >> 3, rb_ = (u_) & 7; const bf16_t* kp_ = P + ((size_t)(bh_ >> 3) * SEQ + rb_ * 256 + r) * DIN + C_FK + (bh_ & 7) * 64 + c8; \
            r0_ = *(const uint4*)kp_; r1_ = *(const uint4*)(kp_ + (size_t)64 * DIN); r2_ = *(const uint4*)(kp_ + (size_t)128 * DIN); r3_ = *(const uint4*)(kp_ + (size_t)192 * DIN); } while (0)
        int u = bid;
        if (u < 1024) FKP_LOAD(a0, a1, a2, a3, u);
        for (; u < 1024; u += G) {
            if (u + G < 1024) FKP_LOAD(n0, n1, n2, n3, u + G);
            prep_foxk(p, layer, u, tid, a0, a1, a2, a3);
            a0 = n0; a1 = n1; a2 = n2; a3 = n3;
        }
#undef FKP_LOAD
    }
    for (int u = (bid + G - 128 % G) % G; u < 128; u += G) prep_foxf(p, layer, u, lds, tid);
}

template <bool DRY = false>
DEV void phase_fox(const Params& p, int layer, char* lds) {
    constexpr int LDK = 72;
    constexpr float LOG2E = 1.4426950408889634f;
    bf16_t* Ks = (bf16_t*)lds;
    bf16_t* Vs = Ks + 128 * LDK;
    float* Fs = (float*)(Vs + 128 * LDK);
    int* qsh = (int*)(Fs + 128);
    bf16_t* P = (bf16_t*)(p.ws + OFF_PROJ);
    const int tid = tid_op(), lane = tid & 63, wid = tid >> 6, qi = lane & 15, g = lane >> 4, tq = qi >> 2, tp = lane & 3;
    int* qctr = (int*)(p.ws + OFF_QCTR) + layer * 64 + (DRY ? 32 : 0);
    const int skey = tid >> 3, sc8 = (tid & 7) * 8;
    for (;;) {
        __syncthreads();
        if (tid == 0) qsh[0] = atomicAdd(qctr, 1);
        __syncthreads();
        const int u = qsh[0];
        if (u >= NB * 8 * 8) break;
        const int qb = 7 - (u / (NB * 8)), bh = u % (NB * 8), b = bh >> 3, h = bh & 7;
        const int q0 = qb * 256, nst = 2 * qb + 2;
        const float* Fg = (const float*)(p.ws + OFF_FBUF) + (size_t)bh * SEQ;
        const int wrow = q0 + wid * 32;
        bf16x8 qf[2][2];
#pragma unroll
        for (int t = 0; t < 2; ++t) {
            const int trow = wrow + 16 * t + qi;
            const bf16_t* qp = P + ((size_t)b * SEQ + trow) * DIN + C_FQ + h * 64 + 8 * g;
            float q[16];
            unpack8(*(const uint4*)qp, q); unpack8(*(const uint4*)(qp + 32), q + 8);
            float ss = 0.f;
#pragma unroll
            for (int d = 0; d < 16; ++d) ss += q[d] * q[d];
            ss += sx(ss, 16); ss += sx(ss, 32);
            const float rstd = rsqrtf(ss * (1.f / 64.f) + 1e-6f) * (0.125f * LOG2E);
            const float* gq = p.in[I_FOXQG] + layer * 64 + 8 * g;
#pragma unroll
            for (int s2 = 0; s2 < 2; ++s2) {
                uint4 w;
                w.x = pack2(q[8 * s2 + 0] * rstd * gq[32 * s2 + 0], q[8 * s2 + 1] * rstd * gq[32 * s2 + 1]);
                w.y = pack2(q[8 * s2 + 2] * rstd * gq[32 * s2 + 2], q[8 * s2 + 3] * rstd * gq[32 * s2 + 3]);
                w.z = pack2(q[8 * s2 + 4] * rstd * gq[32 * s2 + 4], q[8 * s2 + 5] * rstd * gq[32 * s2 + 5]);
                w.w = pack2(q[8 * s2 + 6] * rstd * gq[32 * s2 + 6], q[8 * s2 + 7] * rstd * gq[32 * s2 + 7]);
                qf[t][s2] = __builtin_bit_cast(bf16x8, w);
            }
        }
        const bf16_t* kvp = P + ((size_t)b * SEQ + skey) * DIN + h * 64 + sc8;
        uint4 kA0, kA1, vA0, vA1; float fA = 0.f;
#define FOX_LOAD(K0, K1, V0, V1, FF, st_) do { const bf16_t* np_ = kvp + (size_t)(st_) * 128 * DIN; \
            K0 = *(const uint4*)(np_ + C_FK); K1 = *(const uint4*)(np_ + (size_t)64 * DIN + C_FK); V0 = *(const uint4*)(np_ + C_FV); V1 = *(const uint4*)(np_ + (size_t)64 * DIN + C_FV); \
            if (tid < 128) FF = Fg[(st_) * 128 + tid]; } while (0)
        FOX_LOAD(kA0, kA1, vA0, vA1, fA, 0);
        float m[2] = {-INFINITY, -INFINITY}, lsum[2] = {0.f, 0.f};
        f32x4 oacc[2][4];
#pragma unroll
        for (int t = 0; t < 2; ++t)
#pragma unroll
            for (int dt = 0; dt < 4; ++dt) oacc[t][dt] = (f32x4){0.f, 0.f, 0.f, 0.f};
#define FOX_COMPUTE(st) do { \
            if ((st) * 128 <= wrow + 31) {                         \
                f32x4 sacc[2][8]; \
                _Pragma("unroll") for (int n = 0; n < 8; ++n) { \
                    sacc[0][n] = *(const f32x4*)&Fs[n * 16 + 4 * g]; sacc[1][n] = sacc[0][n];            \
                    _Pragma("unroll") for (int s2 = 0; s2 < 2; ++s2) { \
                        const bf16x8 kfr = *(const bf16x8*)&Ks[(n * 16 + qi) * LDK + 32 * s2 + 8 * g]; \
                        sacc[0][n] = __builtin_amdgcn_mfma_f32_16x16x32_bf16(kfr, qf[0][s2], sacc[0][n], 0, 0, 0); \
                        sacc[1][n] = __builtin_amdgcn_mfma_f32_16x16x32_bf16(kfr, qf[1][s2], sacc[1][n], 0, 0, 0); \
                    } \
                } \
                const bool diag = ((st) * 128 + 127 > wrow);         \
                bf16x8 pf[2][4]; \
                _Pragma("unroll") for (int t = 0; t < 2; ++t) { \
                    const int trow = wrow + 16 * t + qi; \
                    float mx = -INFINITY; \
                    _Pragma("unroll") for (int n = 0; n < 8; ++n) { \
                        _Pragma("unroll") for (int j = 0; j < 4; ++j) { \
                            float v = sacc[t][n][j]; \
                            if (diag) v = ((st) * 128 + n * 16 + 4 * g + j <= trow) ? v : -INFINITY; \
                            sacc[t][n][j] = v; mx = fmaxf(mx, v); \
                        } \
                    } \
                    mx = fmaxf(mx, sx(mx, 16)); mx = fmaxf(mx, sx(mx, 32)); \
                    const float mn = fmaxf(m[t], mx); \
                    const float corr = __builtin_amdgcn_exp2f(m[t] - mn); \
                    m[t] = mn; \
                    float ps = 0.f; \
                    _Pragma("unroll") for (int n = 0; n < 8; ++n) \
                        _Pragma("unroll") for (int j = 0; j < 4; ++j) { const float e = __builtin_amdgcn_exp2f(sacc[t][n][j] - mn); sacc[t][n][j] = e; ps += e; } \
                    lsum[t] = lsum[t] * corr + ps; \
                    _Pragma("unroll") for (int dt = 0; dt < 4; ++dt) { oacc[t][dt][0] *= corr; oacc[t][dt][1] *= corr; oacc[t][dt][2] *= corr; oacc[t][dt][3] *= corr; } \
                    _Pragma("unroll") for (int ks = 0; ks < 4; ++ks) { \
                        uint4 w; \
                        w.x = pack2(sacc[t][2 * ks][0], sacc[t][2 * ks][1]); w.y = pack2(sacc[t][2 * ks][2], sacc[t][2 * ks][3]); \
                        w.z = pack2(sacc[t][2 * ks + 1][0], sacc[t][2 * ks + 1][1]); w.w = pack2(sacc[t][2 * ks + 1][2], sacc[t][2 * ks + 1][3]); \
                        pf[t][ks] = __builtin_bit_cast(bf16x8, w); \
                    } \
                } \
                _Pragma("unroll") for (int ks = 0; ks < 4; ++ks) \
                    _Pragma("unroll") for (int dt = 0; dt < 4; ++dt) { \
                        const v4i16_t lo = lds_tr(&Vs[((2 * ks) * 16 + 4 * g + tq) * LDK + dt * 16 + 4 * tp]); \
                        const v4i16_t hi = lds_tr(&Vs[((2 * ks + 1) * 16 + 4 * g + tq) * LDK + dt * 16 + 4 * tp]); \
                        const bf16x8 vfr = (bf16x8){lo[0], lo[1], lo[2], lo[3], hi[0], hi[1], hi[2], hi[3]}; \
                        oacc[0][dt] = __builtin_amdgcn_mfma_f32_16x16x32_bf16(vfr, pf[0][ks], oacc[0][dt], 0, 0, 0); \
                        oacc[1][dt] = __builtin_amdgcn_mfma_f32_16x16x32_bf16(vfr, pf[1][ks], oacc[1][dt], 0, 0, 0); \
                    } \
            } \
        } while (0)
#define FOX_STEP(K0, K1, V0, V1, FF, st_) do { \
            __syncthreads(); \
            *(uint4*)&Ks[skey * LDK + sc8] = K0; *(uint4*)&Ks[(skey + 64) * LDK + sc8] = K1; \
            *(uint4*)&Vs[skey * LDK + sc8] = V0; *(uint4*)&Vs[(skey + 64) * LDK + sc8] = V1; \
            if (tid < 128) Fs[tid] = FF; \
            __syncthreads(); \
            if ((st_) + 1 < nst) FOX_LOAD(K0, K1, V0, V1, FF, (st_) + 1); \
            FOX_COMPUTE((st_)); } while (0)
#pragma unroll 1
        for (int st = 0; st < nst; ++st) {
            FOX_STEP(kA0, kA1, vA0, vA1, fA, st);
        }
#undef FOX_LOAD
#undef FOX_STEP
#undef FOX_COMPUTE
#pragma unroll
        for (int t = 0; t < 2; ++t) {
            float l = lsum[t];
            l += sx(l, 16); l += sx(l, 32);
            const float il = 1.f / l;
            const int trow = wrow + 16 * t + qi;
            bf16_t* op = DRY ? (bf16_t*)(p.ws + OFF_WIN) + ((size_t)b * SEQ + trow) * 128 + (h & 1) * 64 + 4 * g : P + ((size_t)b * SEQ + trow) * DIN + C_FQ + h * 64 + 4 * g;
#pragma unroll
            for (int dt = 0; dt < 4; ++dt) {
                uint2 o; o.x = pack2(oacc[t][dt][0] * il, oacc[t][dt][1] * il); o.y = pack2(oacc[t][dt][2] * il, oacc[t][dt][3] * il);
                *(uint2*)(op + dt * 16) = o;
            }
        }
    }
}

template <bool DRY = false>
DEV void phase_mlstm(const Params& p, int layer, char* lds) {
    constexpr int LDQ = 72, LDV = 136;
    bf16_t* Qs = (bf16_t*)lds;
    bf16_t* Ks = Qs + 64 * LDQ;
    bf16_t* QD = Ks + 64 * LDQ;
    bf16_t* KW = QD + 64 * LDQ;
    bf16_t* VV = KW + 64 * LDQ;
    bf16_t* PP = VV + 64 * LDV;
    float* GT = (float*)(PP + 64 * LDQ);
    float* ECs = GT + 256;
    float* OS = ECs + 4;
    bf16_t* P = (bf16_t*)(p.ws + OFF_PROJ);
    const int tid = tid_op(), lane = tid & 63, wid = tid >> 6, qi = lane & 15, g = lane >> 4, tq = qi >> 2, tp = lane & 3;
    const int row0 = tid >> 4, col0 = (tid & 15) * 8;
    const int prow = tid >> 3, pch = (tid & 7) * 8;
    const short one_bf = (qi == 0) ? (short)0x3F80 : (short)0;
    const bf16x8 ones = (bf16x8){one_bf, one_bf, one_bf, one_bf, one_bf, one_bf, one_bf, one_bf};
    for (int u = bid_op(); u < NB * 4; u += gridDim.x) {
        const int b = u >> 2, h = u & 3;
        lds_barrier();
        for (int i = tid; i < 64 * LDQ / 2; i += 512) ((unsigned*)PP)[i] = 0u;
        float gn[8];
#pragma unroll
        for (int j = 0; j < 8; ++j) gn[j] = p.in[I_MNG][layer * 512 + h * 128 + col0 + j];
        f32x4 Cst[4], Nst[4];
#pragma unroll
        for (int dt = 0; dt < 4; ++dt) { Cst[dt] = (f32x4){0.f, 0.f, 0.f, 0.f}; Nst[dt] = (f32x4){0.f, 0.f, 0.f, 0.f}; }
        const bf16_t* rowb = P + (size_t)b * SEQ * DIN;
        const bf16_t* mlb = (const bf16_t*)(p.ws + OFF_H) + (size_t)u * 32 * (4 * 64 * 64);
        const float* gbuf = (const float*)(p.ws + OFF_GBUF) + (size_t)u * SEQ * 4;
        const float* ecb = (const float*)(p.ws + OFF_ECBUF) + u * 32;
        const unsigned off_v = (unsigned)row0 * DIN + (unsigned)(C_MV + h * 128 + col0);
        const unsigned off_o = (unsigned)row0 * DIN + (unsigned)(C_MO + h * 128 + col0);
        const unsigned off_m = (unsigned)tid * 8u;
        uint4 m0, m1, m2, m3, rv0, rv1, rg0, rg1; f32x4 gt4 = (f32x4){0.f, 0.f, 0.f, 0.f}; float ecv = 0.f;
#define ML_PREFETCH(c_) do { const int c__ = (c_); const bf16_t* mb_ = mlb + (size_t)c__ * (4 * 64 * 64); const bf16_t* uv_ = rowb + (size_t)(c__ * 64) * DIN; \
            m0 = *(const uint4*)(mb_ + off_m); m1 = *(const uint4*)(mb_ + 4096 + off_m); m2 = *(const uint4*)(mb_ + 8192 + off_m); m3 = *(const uint4*)(mb_ + 12288 + off_m); \
            rv0 = *(const uint4*)(uv_ + off_v); rv1 = *(const uint4*)(uv_ + off_v + 32u * DIN); rg0 = *(const uint4*)(uv_ + off_o); rg1 = *(const uint4*)(uv_ + off_o + 32u * DIN); \
            if (tid < 64) gt4 = *(const f32x4*)(gbuf + (size_t)(c__ * 64 + tid) * 4); ecv = ecb[c__]; } while (0)
        ML_PREFETCH(0);
#pragma unroll 1
        for (int c = 0; c < SEQ / 64; ++c) {
            *(uint4*)&Qs[prow * LDQ + pch] = m0; *(uint4*)&Ks[prow * LDQ + pch] = m1; *(uint4*)&QD[prow * LDQ + pch] = m2; *(uint4*)&KW[prow * LDQ + pch] = m3;
            *(uint4*)&VV[row0 * LDV + col0] = rv0; *(uint4*)&VV[(row0 + 32) * LDV + col0] = rv1;
            if (tid < 64) *(f32x4*)&GT[tid * 4] = gt4;
            const float ec = ecv;
            const uint4 g0 = rg0, g1 = rg1;
            if (c + 1 < SEQ / 64) ML_PREFETCH(c + 1);
            lds_barrier();
#pragma unroll
            for (int rep = 0; rep < 2; ++rep) {
                const int idx = wid + 8 * rep;
                if (idx < 10) {
                    const int tt = (idx >= 6) ? 3 : (idx >= 3) ? 2 : (idx >= 1) ? 1 : 0, st = idx - tt * (tt + 1) / 2;
                    f32x4 acc = (f32x4){0.f, 0.f, 0.f, 0.f};
#pragma unroll
                    for (int ks = 0; ks < 2; ++ks) {
                        const bf16x8 a = *(const bf16x8*)&Ks[(st * 16 + qi) * LDQ + 32 * ks + 8 * g];
                        const bf16x8 bq = *(const bf16x8*)&Qs[(tt * 16 + qi) * LDQ + 32 * ks + 8 * g];
                        acc = __builtin_amdgcn_mfma_f32_16x16x32_bf16(a, bq, acc, 0, 0, 0);
                    }
                    const float bt = GT[(tt * 16 + qi) * 4];
#pragma unroll
                    for (int j = 0; j < 4; ++j) {
                        const f32x4 gs = *(const f32x4*)&GT[(st * 16 + 4 * g + j) * 4];
                        const bool valid = (st < tt) || (4 * g + j <= qi);
                        acc[j] = valid ? acc[j] * __expf(bt - gs[0] + gs[1]) : 0.f;
                    }
                    uint2 w; w.x = pack2(acc[0], acc[1]); w.y = pack2(acc[2], acc[3]);
                    *(uint2*)&PP[(tt * 16 + qi) * LDQ + st * 16 + 4 * g] = w;
                }
            }
            f32x4 o[4], dn[4];
            {
                bf16x8 cp[2], np[2];
#pragma unroll
                for (int k2 = 0; k2 < 2; ++k2) {
                    uint4 w;
                    w.x = pack2(Cst[2 * k2][0], Cst[2 * k2][1]); w.y = pack2(Cst[2 * k2][2], Cst[2 * k2][3]);
                    w.z = pack2(Cst[2 * k2 + 1][0], Cst[2 * k2 + 1][1]); w.w = pack2(Cst[2 * k2 + 1][2], Cst[2 * k2 + 1][3]);
                    cp[k2] = __builtin_bit_cast(bf16x8, w);
                    w.x = pack2(Nst[2 * k2][0], Nst[2 * k2][1]); w.y = pack2(Nst[2 * k2][2], Nst[2 * k2][3]);
                    w.z = pack2(Nst[2 * k2 + 1][0], Nst[2 * k2 + 1][1]); w.w = pack2(Nst[2 * k2 + 1][2], Nst[2 * k2 + 1][3]);
                    np[k2] = __builtin_bit_cast(bf16x8, w);
                }
#pragma unroll
                for (int tt = 0; tt < 4; ++tt) {
                    o[tt] = (f32x4){0.f, 0.f, 0.f, 0.f}; dn[tt] = (f32x4){0.f, 0.f, 0.f, 0.f};
#pragma unroll
                    for (int k2 = 0; k2 < 2; ++k2) {
                        const uint2 a0 = *(const uint2*)&QD[(tt * 16 + qi) * LDQ + (2 * k2) * 16 + 4 * g];
                        const uint2 a1 = *(const uint2*)&QD[(tt * 16 + qi) * LDQ + (2 * k2 + 1) * 16 + 4 * g];
                        const bf16x8 af = __builtin_bit_cast(bf16x8, make_uint4(a0.x, a0.y, a1.x, a1.y));
                        o[tt] = __builtin_amdgcn_mfma_f32_16x16x32_bf16(af, cp[k2], o[tt], 0, 0, 0);
                        dn[tt] = __builtin_amdgcn_mfma_f32_16x16x32_bf16(af, np[k2], dn[tt], 0, 0, 0);
                    }
                }
            }
            bf16x8 vf[2];
#pragma unroll
            for (int ks = 0; ks < 2; ++ks) {
                const v4i16_t lo = lds_tr(&VV[(32 * ks + 8 * g + tq) * LDV + 16 * wid + 4 * tp]);
                const v4i16_t hi = lds_tr(&VV[(32 * ks + 8 * g + 4 + tq) * LDV + 16 * wid + 4 * tp]);
                vf[ks] = (bf16x8){lo[0], lo[1], lo[2], lo[3], hi[0], hi[1], hi[2], hi[3]};
            }
#pragma unroll
            for (int dt = 0; dt < 4; ++dt) {
#pragma unroll
                for (int j = 0; j < 4; ++j) { Cst[dt][j] *= ec; Nst[dt][j] *= ec; }
#pragma unroll
                for (int ks = 0; ks < 2; ++ks) {
                    const v4i16_t lo = lds_tr(&KW[(32 * ks + 8 * g + tq) * LDQ + dt * 16 + 4 * tp]);
                    const v4i16_t hi = lds_tr(&KW[(32 * ks + 8 * g + 4 + tq) * LDQ + dt * 16 + 4 * tp]);
                    const bf16x8 kfr = (bf16x8){lo[0], lo[1], lo[2], lo[3], hi[0], hi[1], hi[2], hi[3]};
                    Cst[dt] = __builtin_amdgcn_mfma_f32_16x16x32_bf16(kfr, vf[ks], Cst[dt], 0, 0, 0);
                    Nst[dt] = __builtin_amdgcn_mfma_f32_16x16x32_bf16(kfr, ones, Nst[dt], 0, 0, 0);
                }
            }
            lds_barrier();
#pragma unroll
            for (int tt = 0; tt < 4; ++tt)
#pragma unroll
                for (int ks = 0; ks < 2; ++ks)
                    if (ks <= (tt >> 1)) {
                        const bf16x8 a = *(const bf16x8*)&PP[(tt * 16 + qi) * LDQ + 32 * ks + 8 * g];
                        o[tt] = __builtin_amdgcn_mfma_f32_16x16x32_bf16(a, vf[ks], o[tt], 0, 0, 0);
                        dn[tt] = __builtin_amdgcn_mfma_f32_16x16x32_bf16(a, ones, dn[tt], 0, 0, 0);
                    }
#pragma unroll
            for (int tt = 0; tt < 4; ++tt)
#pragma unroll
                for (int j = 0; j < 4; ++j) {
                    const float den = sfrom(dn[tt][j], lane & 48);
                    OS[(tt * 16 + 4 * g + j) * 128 + 16 * wid + qi] = o[tt][j] * __builtin_amdgcn_rcpf(fmaxf(fabsf(den), 1.f));
                }
            lds_barrier();
            bf16_t* uo = (bf16_t*)rowb + (size_t)(c * 64) * DIN;
#pragma unroll
            for (int i = 0; i < 2; ++i) {
                const int row = row0 + 32 * i;
                const f32x4 oa = *(const f32x4*)&OS[row * 128 + col0], ob = *(const f32x4*)&OS[row * 128 + col0 + 4];
                float ss = oa[0] * oa[0] + oa[1] * oa[1] + oa[2] * oa[2] + oa[3] * oa[3] + ob[0] * ob[0] + ob[1] * ob[1] + ob[2] * ob[2] + ob[3] * ob[3];
                ss += sx(ss, 1); ss += sx(ss, 2); ss += sx(ss, 4); ss += sx(ss, 8);
                const float rstd = rsqrtf(ss * (1.f / 128.f) + 1e-6f);
                float gg[8]; unpack8((i == 0) ? g0 : g1, gg);
#pragma unroll
                for (int j = 0; j < 8; ++j) gg[j] = fsigmoid(gg[j]) * gn[j];
                uint4 w;
                w.x = pack2(oa[0] * rstd * gg[0], oa[1] * rstd * gg[1]); w.y = pack2(oa[2] * rstd * gg[2], oa[3] * rstd * gg[3]);
                w.z = pack2(ob[0] * rstd * gg[4], ob[1] * rstd * gg[5]); w.w = pack2(ob[2] * rstd * gg[6], ob[3] * rstd * gg[7]);
                if constexpr (DRY) *(uint4*)((bf16_t*)(p.ws + OFF_WIN) + ((size_t)b * SEQ + c * 64 + row) * 128 + col0) = w;
                else *(uint4*)(uo + off_o + (unsigned)(32 * i) * DIN) = w;
            }
        }
#undef ML_PREFETCH
    }
}

template <bool DRY = false>
DEV void phase_hgrn(const Params& p, int layer, char* lds) {
    constexpr int LDA = 136, LDP = 72;
    bf16_t* QM = (bf16_t*)lds;
    bf16_t* KM = QM + 64 * LDA;
    bf16_t* VV = KM + 64 * LDA;
    bf16_t* PP = VV + 64 * LDA;
    float* EM = (float*)(PP + 64 * LDP);
    float* EC = EM + 128;
    float* EK = EC + 128;
    float* OS = EK + 128;
    bf16_t* P = (bf16_t*)(p.ws + OFF_PROJ);
    const int tid = tid_op(), lane = tid & 63, wid = tid >> 6, qi = lane & 15, g = lane >> 4, tq = qi >> 2, tp = lane & 3;
    const int row0 = tid >> 4, col0 = (tid & 15) * 8;
    for (int u = (bid_op() + (int)gridDim.x - 64) % (int)gridDim.x; u < NB * 4; u += gridDim.x) {
        const int b = u >> 2, h = u & 3;
        float gn[8];
#pragma unroll
        for (int j = 0; j < 8; ++j) gn[j] = p.in[I_HNG][layer * 512 + h * 128 + col0 + j];
        lds_barrier();
        for (int i = tid; i < 64 * LDP / 2; i += 512) ((unsigned*)PP)[i] = 0u;
        f32x4 S[8];
#pragma unroll
        for (int dt = 0; dt < 8; ++dt) S[dt] = (f32x4){0.f, 0.f, 0.f, 0.f};
        bf16_t* gbase = P + ((size_t)b * SEQ + row0) * DIN + h * 128 + col0;
        const float* evb = (const float*)(p.ws + OFF_EVBUF) + (size_t)u * 32 * 384;
        uint4 q0r, q1r, k0r, k1r, v0r, v1r, g0r, g1r; f32x4 ev4 = (f32x4){0.f, 0.f, 0.f, 0.f};
#define HG_PREFETCH(c_) do { const bf16_t* rp_ = gbase + (size_t)((c_) * 64) * DIN; \
            q0r = *(const uint4*)(rp_ + C_HQ); q1r = *(const uint4*)(rp_ + (size_t)32 * DIN + C_HQ); k0r = *(const uint4*)(rp_ + C_HF); k1r = *(const uint4*)(rp_ + (size_t)32 * DIN + C_HF); \
            v0r = *(const uint4*)(rp_ + C_HI); v1r = *(const uint4*)(rp_ + (size_t)32 * DIN + C_HI); g0r = *(const uint4*)(rp_ + C_HG); g1r = *(const uint4*)(rp_ + (size_t)32 * DIN + C_HG); \
            if (tid < 96) ev4 = *(const f32x4*)(evb + (size_t)(c_) * 384 + tid * 4); } while (0)
        HG_PREFETCH(0);
#pragma unroll 1
        for (int c = 0; c < SEQ / 64; ++c) {
            *(uint4*)&QM[row0 * LDA + col0] = q0r; *(uint4*)&QM[(row0 + 32) * LDA + col0] = q1r;
            *(uint4*)&KM[row0 * LDA + col0] = k0r; *(uint4*)&KM[(row0 + 32) * LDA + col0] = k1r;
            *(uint4*)&VV[row0 * LDA + col0] = v0r; *(uint4*)&VV[(row0 + 32) * LDA + col0] = v1r;
            if (tid < 96) *(f32x4*)&EM[tid * 4] = ev4;
            const uint4 rg0 = g0r, rg1 = g1r;
            if (c + 1 < SEQ / 64) HG_PREFETCH(c + 1);
            lds_barrier();
#pragma unroll
            for (int rep = 0; rep < 2; ++rep) {
                const int idx = wid + 8 * rep;
                if (idx < 10) {
                    const int tt = (idx >= 6) ? 3 : (idx >= 3) ? 2 : (idx >= 1) ? 1 : 0, st = idx - tt * (tt + 1) / 2;
                    f32x4 acc = (f32x4){0.f, 0.f, 0.f, 0.f};
#pragma unroll
                    for (int ks = 0; ks < 4; ++ks) {
                        const bf16x8 a = *(const bf16x8*)&KM[(st * 16 + qi) * LDA + 32 * ks + 8 * g];
                        const bf16x8 bq = *(const bf16x8*)&QM[(tt * 16 + qi) * LDA + 32 * ks + 8 * g];
                        acc = __builtin_amdgcn_mfma_f32_16x16x32_bf16(a, bq, acc, 0, 0, 0);
                    }
                    if (tt == st) {
#pragma unroll
                        for (int j = 0; j < 4; ++j) if (4 * g + j > qi) acc[j] = 0.f;
                    }
                    uint2 w; w.x = pack2(acc[0], acc[1]); w.y = pack2(acc[2], acc[3]);
                    *(uint2*)&PP[(tt * 16 + qi) * LDP + st * 16 + 4 * g] = w;
                }
            }
            f32x4 o[4];
            {
                bf16x8 sp[4];
#pragma unroll
                for (int k2 = 0; k2 < 4; ++k2) {
                    const f32x4 e0 = *(const f32x4*)&EM[(2 * k2) * 16 + 4 * g], e1 = *(const f32x4*)&EM[(2 * k2 + 1) * 16 + 4 * g];
                    uint4 w;
                    w.x = pack2(S[2 * k2][0] * e0[0], S[2 * k2][1] * e0[1]); w.y = pack2(S[2 * k2][2] * e0[2], S[2 * k2][3] * e0[3]);
                    w.z = pack2(S[2 * k2 + 1][0] * e1[0], S[2 * k2 + 1][1] * e1[1]); w.w = pack2(S[2 * k2 + 1][2] * e1[2], S[2 * k2 + 1][3] * e1[3]);
                    sp[k2] = __builtin_bit_cast(bf16x8, w);
                }
#pragma unroll
                for (int tt = 0; tt < 4; ++tt) {
                    o[tt] = (f32x4){0.f, 0.f, 0.f, 0.f};
#pragma unroll
                    for (int k2 = 0; k2 < 4; ++k2) {
                        const uint2 a0 = *(const uint2*)&QM[(tt * 16 + qi) * LDA + (2 * k2) * 16 + 4 * g];
                        const uint2 a1 = *(const uint2*)&QM[(tt * 16 + qi) * LDA + (2 * k2 + 1) * 16 + 4 * g];
                        const uint4 w = make_uint4(a0.x, a0.y, a1.x, a1.y);
                        o[tt] = __builtin_amdgcn_mfma_f32_16x16x32_bf16(__builtin_bit_cast(bf16x8, w), sp[k2], o[tt], 0, 0, 0);
                    }
                }
            }
            bf16x8 vf[2];
#pragma unroll
            for (int ks = 0; ks < 2; ++ks) {
                const v4i16_t lo = lds_tr(&VV[(32 * ks + 8 * g + tq) * LDA + 16 * wid + 4 * tp]);
                const v4i16_t hi = lds_tr(&VV[(32 * ks + 8 * g + 4 + tq) * LDA + 16 * wid + 4 * tp]);
                vf[ks] = (bf16x8){lo[0], lo[1], lo[2], lo[3], hi[0], hi[1], hi[2], hi[3]};
            }
#pragma unroll
            for (int dt = 0; dt < 8; ++dt) {
                f32x4 Tacc = (f32x4){0.f, 0.f, 0.f, 0.f};
#pragma unroll
                for (int ks = 0; ks < 2; ++ks) {
                    const v4i16_t lo = lds_tr(&KM[(32 * ks + 8 * g + tq) * LDA + dt * 16 + 4 * tp]);
                    const v4i16_t hi = lds_tr(&KM[(32 * ks + 8 * g + 4 + tq) * LDA + dt * 16 + 4 * tp]);
                    const bf16x8 kfr = (bf16x8){lo[0], lo[1], lo[2], lo[3], hi[0], hi[1], hi[2], hi[3]};
                    Tacc = __builtin_amdgcn_mfma_f32_16x16x32_bf16(kfr, vf[ks], Tacc, 0, 0, 0);
                }
                const f32x4 ec = *(const f32x4*)&EC[dt * 16 + 4 * g], ek = *(const f32x4*)&EK[dt * 16 + 4 * g];
#pragma unroll
                for (int j = 0; j < 4; ++j) S[dt][j] = ec[j] * S[dt][j] + ek[j] * Tacc[j];
            }
            lds_barrier();
#pragma unroll
            for (int tt = 0; tt < 4; ++tt)
#pragma unroll
                for (int ks = 0; ks < 2; ++ks)
                    if (ks <= (tt >> 1)) {
                        const bf16x8 a = *(const bf16x8*)&PP[(tt * 16 + qi) * LDP + 32 * ks + 8 * g];
                        o[tt] = __builtin_amdgcn_mfma_f32_16x16x32_bf16(a, vf[ks], o[tt], 0, 0, 0);
                    }
#pragma unroll
            for (int tt = 0; tt < 4; ++tt)
#pragma unroll
                for (int j = 0; j < 4; ++j) OS[(tt * 16 + 4 * g + j) * 128 + 16 * wid + qi] = o[tt][j];
            lds_barrier();
#pragma unroll
            for (int i = 0; i < 2; ++i) {
                const int row = row0 + 32 * i;
                const f32x4 oa = *(const f32x4*)&OS[row * 128 + col0], ob = *(const f32x4*)&OS[row * 128 + col0 + 4];
                float ss = oa[0] * oa[0] + oa[1] * oa[1] + oa[2] * oa[2] + oa[3] * oa[3] + ob[0] * ob[0] + ob[1] * ob[1] + ob[2] * ob[2] + ob[3] * ob[3];
                ss += sx(ss, 1); ss += sx(ss, 2); ss += sx(ss, 4); ss += sx(ss, 8);
                const float rstd = rsqrtf(ss * (1.f / 128.f) + 1e-6f);
                float gg[8]; unpack8((i == 0) ? rg0 : rg1, gg);
#pragma unroll
                for (int j = 0; j < 8; ++j) gg[j] = fsilu(gg[j]) * gn[j];
                uint4 w;
                w.x = pack2(oa[0] * rstd * gg[0], oa[1] * rstd * gg[1]); w.y = pack2(oa[2] * rstd * gg[2], oa[3] * rstd * gg[3]);
                w.z = pack2(ob[0] * rstd * gg[4], ob[1] * rstd * gg[5]); w.w = pack2(ob[2] * rstd * gg[6], ob[3] * rstd * gg[7]);
                if constexpr (DRY) *(uint4*)((bf16_t*)(p.ws + OFF_WIN) + ((size_t)b * SEQ + c * 64 + row) * 128 + col0) = w;
                else *(uint4*)(gbase + (size_t)(c * 64 + 32 * i) * DIN + C_HG) = w;
            }
        }
#undef HG_PREFETCH
    }
}

#define XB_TMO      128
#define XB_XCNT(j)  (256  + 64 * (j))
#define XB_XSUB(j)  (1280 + 64 * (j))
#define XB_XGEN(j)  (2304 + 64 * (j))
#define XB_TOP      3328
#define XB_TOPGEN   3392
#define XCD_BAR_WORDS 3456
#define XB_SPIN_CAP (1u << 18)
__device__ __forceinline__ unsigned xb_ld(unsigned* p)              { return __hip_atomic_load(p, __ATOMIC_RELAXED, __HIP_MEMORY_SCOPE_AGENT); }
__device__ __forceinline__ unsigned xb_add(unsigned* p, unsigned v) { return __hip_atomic_fetch_add(p, v, __ATOMIC_RELAXED, __HIP_MEMORY_SCOPE_AGENT); }
__device__ __forceinline__ unsigned xb_xcc_id() { return (unsigned)__builtin_amdgcn_s_getreg((3 << 11) | 20) & 0xFu; }
#define XB_SPIN(cond, bar) do { unsigned _sp = 0; while (cond) { __builtin_amdgcn_s_sleep(1); \
    if ((++_sp & 255u) == 0u) { if (xb_ld(&(bar)[XB_TMO])) break; if (_sp > XB_SPIN_CAP) { atomicAdd(&(bar)[XB_TMO], 1u); break; } } } } while (0)
struct XcdBarrier { unsigned* bar; unsigned x; volatile LAS unsigned* st; };
__device__ __forceinline__ XcdBarrier xcd_barrier_post(unsigned* bar, volatile LAS unsigned* st) {
    XcdBarrier b; b.bar = bar; b.x = xb_xcc_id(); b.st = st;
    if (threadIdx.x == 0) (void)xb_add(&bar[XB_XCNT(b.x)], 1u);
    return b;
}
__device__ __forceinline__ void xcd_barrier_complete(unsigned* bar, unsigned x, unsigned& nloc, unsigned& nx) {
    const unsigned G = gridDim.x * gridDim.y * gridDim.z;
    unsigned sum, cnt, mine, sp = 0u;
    for (;;) {
        sum = 0u; cnt = 0u; mine = 0u;
#pragma unroll
        for (unsigned j = 0; j < 16; ++j) { const unsigned c = xb_ld(&bar[XB_XCNT(j)]); sum += c; cnt += (c > 0u) ? 1u : 0u; mine = (j == x) ? c : mine; }
        if (sum == G) break;
        __builtin_amdgcn_s_sleep(1);
        if ((++sp & 255u) == 0u) { if (xb_ld(&bar[XB_TMO])) break; if (sp > XB_SPIN_CAP) { atomicAdd(&bar[XB_TMO], 1u); break; } }
    }
    nloc = mine > 0u ? mine : 1u; nx = cnt > 0u ? cnt : 1u;
}
__device__ __forceinline__ void xcd_barrier(const XcdBarrier& b) {
    asm volatile("s_waitcnt vmcnt(0)" ::: "memory");
    __syncthreads();
    if (threadIdx.x == 0) {
        unsigned* bar = b.bar;
        __builtin_amdgcn_s_waitcnt(0);
        unsigned nloc = b.st[0], nx = b.st[1];
        if (nloc == 0u) { xcd_barrier_complete(bar, b.x, nloc, nx); b.st[0] = nloc; b.st[1] = nx; }
        const unsigned old = xb_add(&bar[XB_XSUB(b.x)], 1u);
        const unsigned gen = old / nloc;
        if (old + 1u == (gen + 1u) * nloc) {
            __builtin_amdgcn_fence(__ATOMIC_RELEASE, "agent");
            asm volatile("s_waitcnt vmcnt(0)" ::: "memory");
            const unsigned og = xb_add(&bar[XB_TOP], 1u);
            const unsigned tg = og / nx;
            if (og + 1u == (tg + 1u) * nx) xb_add(&bar[XB_TOPGEN], 1u);
            else XB_SPIN(xb_ld(&bar[XB_TOPGEN]) == tg, bar);
            __builtin_amdgcn_fence(__ATOMIC_ACQUIRE, "agent");
            xb_add(&bar[XB_XGEN(b.x)], 1u);
            asm volatile("s_waitcnt vmcnt(0)" ::: "memory");
        } else {
            XB_SPIN(xb_ld(&bar[XB_XGEN(b.x)]) == gen, bar);
            __builtin_amdgcn_fence(__ATOMIC_ACQUIRE, "agent");
            asm volatile("s_waitcnt vmcnt(0)" ::: "memory");
        }
    }
    __syncthreads();
}

constexpr int LDS_BYTES = 131072 + 16 + TL_PAD * 4 + 2 * 256 * 4;
__global__ void __launch_bounds__(512, 2) mega_fwd(Params p) {
    extern __shared__ __attribute__((aligned(16))) char lds_all[];
    char* lds = lds_all + 16;
    if (threadIdx.x == 0) *(uint4*)lds_all = make_uint4(0u, 0u, 0u, 0u);
    __syncthreads();
    (void)xcd_barrier_post((unsigned*)(p.ws + OFF_CTL), (volatile LAS unsigned*)lds_all);
#define GRID_BAR() do { XcdBarrier b_; b_.bar = (unsigned*)(p.ws + OFF_CTL); b_.x = xb_xcc_id(); b_.st = (volatile LAS unsigned*)lds_all; xcd_barrier(b_); } while (0)
    bf16_t* Hb = (bf16_t*)(p.ws + OFF_H);
    phase_convert_mix(p, 0, lds);
    phase_ada(p, lds);
    GRID_BAR();
    phase_norm(p, p.in[I_X], 0, 0, Hb);
    GRID_BAR();
#pragma unroll 1
    for (int layer = 0; layer < 2; ++layer) {
        phase_inproj(p, lds);
        GRID_BAR();
        phase_prep(p, layer, lds);
        GRID_BAR();
        phase_mlstm(p, layer, lds);
        phase_hgrn(p, layer, lds);
        phase_fox(p, layer, lds);
        GRID_BAR();
        phase_merge(p, lds);
        GRID_BAR();
        phase_out(p, layer, lds);
        GRID_BAR();
        phase_front(p, layer, lds);
        GRID_BAR();
        phase_scatter(p, layer, lds);
        GRID_BAR();
#pragma unroll 1
        for (int half = 0; half < NHALF; ++half) {
            phase_moe_up(p, half, lds);
            GRID_BAR();
            phase_moe_down(p, half, lds);
            GRID_BAR();
            phase_combine(p, layer, half);
            if (layer == 0 && half == NHALF - 1) phase_convert_mix(p, 1, lds);
            GRID_BAR();
        }
    }
}

extern "C" void kernel_launch(void* const* d_in, const int* in_sizes, int n_in, void* d_out, int out_size, void* d_ws, size_t ws_size, hipStream_t stream) {
    (void)in_sizes; (void)n_in; (void)out_size; (void)ws_size;
    Params p{};
    for (int i = 0; i < 26; ++i) p.in[i] = (const float*)d_in[i];
    p.out = (float*)d_out;
    p.ws = (unsigned char*)d_ws;
    static int grid = 0;
    if (!grid) {
        int dev = 0, cus = 0, per_cu = 0;
        (void)hipGetDevice(&dev);
        (void)hipDeviceGetAttribute(&cus, hipDeviceAttributeMultiprocessorCount, dev);
        (void)hipFuncSetAttribute((const void*)mega_fwd, hipFuncAttributeMaxDynamicSharedMemorySize, LDS_BYTES);
        (void)hipOccupancyMaxActiveBlocksPerMultiprocessor(&per_cu, mega_fwd, 512, LDS_BYTES);
        if (cus <= 0) cus = 256;
        grid = cus * (per_cu < 1 ? per_cu : 1);
        if (grid <= 0) grid = cus;
        if (grid > 256) grid = 256;
    }
    (void)hipMemsetAsync(d_ws, 0, CTL_BYTES, stream);
    hipLaunchKernelGGL(mega_fwd, dim3(grid), dim3(512), LDS_BYTES, stream, p);
}
```

```cpp
#include <hip/hip_runtime.h>
#include <stdint.h>
#include <stddef.h>

#define DEV __device__ __forceinline__
typedef unsigned short bf16_t;
typedef short bf16x8 __attribute__((ext_vector_type(8)));
typedef float f32x4 __attribute__((ext_vector_type(4)));
typedef float f32x2 __attribute__((ext_vector_type(2)));
typedef __bf16 bf16x2_t __attribute__((ext_vector_type(2)));

constexpr int T = 32768, DM = 1024, NB = 16, SEQ = 2048, DIN = 8208;
constexpr int C_FQ = 0, C_FK = 512, C_FV = 1024, C_FF = 1536, C_MQK = 1544, C_MV = 2056, C_MI = 2568, C_MF = 2572, C_MO = 2576,
              C_HF = 3088, C_HQ = 3600, C_HI = 4112, C_HG = 4624, C_GATES = 5136;
constexpr int C_MERGED = 512;
constexpr int NEXP = 64, TOPK = 8, NLIST = 65, NHALF = 1, HALF_T = T / NHALF, NSLOT = 9;
constexpr int ROWCAP = 311296;
constexpr int TILECAP = ROWCAP / 256;
constexpr int TL_PAD = (TILECAP + 63) / 64 * 64;

constexpr size_t AL(size_t x) { return (x + 255) & ~(size_t)255; }
constexpr size_t OFF_CTL = 0;
constexpr size_t OFF_CNT = 32768;
constexpr int CNT_STRIDE = 32;
constexpr size_t OFF_QCTR = 65536;
constexpr size_t CTL_BYTES = 131072;
constexpr size_t OFF_MOD = CTL_BYTES;
constexpr size_t OFF_GS = AL(OFF_MOD + (size_t)2 * 16 * 6144 * 4);
constexpr size_t OFF_IDX = AL(OFF_GS + (size_t)T * 16 * 4);
constexpr size_t OFF_WTS = AL(OFF_IDX + (size_t)T * 8 * 4);
constexpr size_t OFF_RANK = AL(OFF_WTS + (size_t)T * 8 * 4);
constexpr size_t OFF_ROWTOK = AL(OFF_RANK + (size_t)T * 8 * 4);
constexpr size_t OFF_POS = AL(OFF_ROWTOK + (size_t)NHALF * ROWCAP * 4);
constexpr size_t OFF_TILEL = AL(OFF_POS + (size_t)T * NSLOT * 4);
constexpr size_t OFF_WIN = AL(OFF_TILEL + (size_t)NHALF * (TILECAP + 16) * 4);
constexpr size_t OFF_WG8 = AL(OFF_WIN + (size_t)5376 * 1024 * 2);
constexpr size_t OFF_WBR = AL(OFF_WG8 + (size_t)5632 * 1024);
constexpr size_t OFF_WOUT = AL(OFF_WBR + (size_t)3 * 1024 * 512 * 2);
constexpr size_t OFF_WRT = AL(OFF_WOUT + (size_t)1024 * 1024 * 2);
constexpr size_t OFF_H = AL(OFF_WRT + (size_t)256 * 1024 * 2);
constexpr size_t OFF_H2F8 = OFF_H + (size_t)T * 1024;
constexpr size_t OFF_PROJ = AL(OFF_H + (size_t)T * 1024 * 2);
constexpr size_t OFF_END = AL(OFF_PROJ + (size_t)T * DIN * 2);
constexpr size_t OFF_W13 = OFF_PROJ;
constexpr size_t OFF_HID = AL(OFF_W13 + (size_t)NLIST * 512 * 1024);
constexpr size_t OFF_OUTA = AL(OFF_HID + (size_t)ROWCAP * 256);
constexpr size_t OFF_MOE_END = AL(OFF_OUTA + (size_t)ROWCAP * 1024);
constexpr size_t OFF_XB = OFF_MOE_END;
constexpr size_t OFF_W2 = OFF_MOE_END + (size_t)T * 2048;
static_assert(OFF_XB + (size_t)T * 2048 + (size_t)NEXP * 1024 * 256 <= OFF_END, "x1 rows and the routed down weights must fit behind the MoE overlay");
constexpr size_t OFF_FBUF = OFF_END;
constexpr size_t OFF_GBUF = AL(OFF_FBUF + (size_t)128 * SEQ * 4);
constexpr size_t OFF_ECBUF = AL(OFF_GBUF + (size_t)64 * SEQ * 16);
constexpr size_t OFF_EVBUF = AL(OFF_ECBUF + (size_t)64 * 32 * 4);
constexpr size_t OFF_H8 = AL(OFF_EVBUF + (size_t)64 * 32 * 384 * 4);
constexpr size_t OFF_W2S = AL(OFF_H8 + (size_t)T * 1024);
constexpr size_t OFF_END2 = AL(OFF_W2S + (size_t)1024 * 256 * 2);
static_assert((size_t)NEXP * 1024 * 256 * 2 <= (size_t)T * 1024, "routed W2 fits the lower half of H");
static_assert(OFF_MOE_END <= OFF_END, "MoE overlay must fit inside proj region");
static_assert(OFF_END2 <= (size_t)682 * 1000 * 1000, "workspace too large");
static_assert((size_t)64 * 32 * 4 * 64 * 64 * 2 <= (size_t)T * 1024 * 2, "mLSTM operand blocks fit the H region");

struct Params {
    const float* in[26];
    float* out;
    unsigned char* ws;
};
enum { I_X = 0, I_C, I_ADAW, I_ADAB, I_N1G, I_N2G, I_WIN, I_FOXBF, I_FOXQG, I_FOXKG, I_MCONV, I_MBI, I_MBF, I_MNG, I_HLB, I_HNG,
       I_WBR, I_WOUT, I_RW, I_RB, I_EW1, I_EW3, I_EW2, I_SW1, I_SW3, I_SW2 };

DEV int tid_op() { int t = threadIdx.x; asm volatile("" : "+v"(t)); return t; }
DEV int bid_op() { int b = blockIdx.x; asm volatile("" : "+s"(b)); return b; }
DEV float bf2f(bf16_t v) { return __uint_as_float((unsigned)v << 16); }
DEV unsigned pack2(float lo, float hi) { f32x2 v = {lo, hi}; bf16x2_t b = __builtin_convertvector(v, bf16x2_t); return __builtin_bit_cast(unsigned, b); }
DEV bf16_t f2bf(float f) { return (bf16_t)(pack2(f, 0.f) & 0xffffu); }
DEV float sigmoid_f(float x) { return 1.f / (1.f + __expf(-x)); }
DEV float silu_f(float x) { return x / (1.f + __expf(-x)); }
DEV float fsigmoid(float x) { return __builtin_amdgcn_rcpf(1.f + __expf(-x)); }
DEV float fsilu(float x) { return x * __builtin_amdgcn_rcpf(1.f + __expf(-x)); }
DEV unsigned pack4_fp8(float a, float b, float c, float d) {
    a = __builtin_amdgcn_fmed3f(a, -448.f, 448.f); b = __builtin_amdgcn_fmed3f(b, -448.f, 448.f); c = __builtin_amdgcn_fmed3f(c, -448.f, 448.f); d = __builtin_amdgcn_fmed3f(d, -448.f, 448.f);
    int v = __builtin_amdgcn_cvt_pk_fp8_f32(a, b, 0, false); v = __builtin_amdgcn_cvt_pk_fp8_f32(c, d, v, true); return (unsigned)v;
}
constexpr float F8_ACT_SCALE = 8.f, F8_W_SCALE = 64.f;
DEV float logsigmoid_f(float x) { return fminf(x, 0.f) - log1pf(__expf(-fabsf(x))); }
DEV int lane_op() { int l = (int)__builtin_amdgcn_mbcnt_hi(~0u, __builtin_amdgcn_mbcnt_lo(~0u, 0u)); asm volatile("" : "+v"(l)); return l; }
DEV float sx(float v, int o) { return __builtin_bit_cast(float, __builtin_amdgcn_ds_bpermute((lane_op() ^ o) << 2, __builtin_bit_cast(int, v))); }
DEV float sfrom(float v, int src) { return __builtin_bit_cast(float, __builtin_amdgcn_ds_bpermute(src << 2, __builtin_bit_cast(int, v))); }
DEV float sup(float v, int o) { const int l = lane_op(); return __builtin_bit_cast(float, __builtin_amdgcn_ds_bpermute(((l >= o) ? l - o : l) << 2, __builtin_bit_cast(int, v))); }
DEV float wave_sum(float v) {
#pragma unroll
    for (int o = 32; o > 0; o >>= 1) v += sx(v, o);
    return v;
}
DEV void unpack8(uint4 u, float* f) {
    f[0] = __uint_as_float(u.x << 16); f[1] = __uint_as_float(u.x & 0xffff0000u);
    f[2] = __uint_as_float(u.y << 16); f[3] = __uint_as_float(u.y & 0xffff0000u);
    f[4] = __uint_as_float(u.z << 16); f[5] = __uint_as_float(u.z & 0xffff0000u);
    f[6] = __uint_as_float(u.w << 16); f[7] = __uint_as_float(u.w & 0xffff0000u);
}


constexpr int VB_COLS = 2576, VF_VALS = 2560, VF_COLS = 5632;
DEV int vb_to_proj(int vc) { const int blk = vc >> 9; return ((blk == 0) ? C_FQ : (blk == 1) ? C_FK : (blk == 2) ? C_MQK : (blk == 3) ? C_HF : C_HQ) + (vc & 511); }
DEV int vf_to_proj(int vc) { if (vc >= VF_VALS) return C_GATES + (vc - VF_VALS); const int blk = vc >> 9; return ((blk == 0) ? C_FV : (blk == 1) ? C_MV : (blk == 2) ? C_MO : (blk == 3) ? C_HI : C_HG) + (vc & 511); }
DEV int inproj_vrow(int n, bool& f8) {
    f8 = false;
    if (n < C_FV) return n;
    if (n < C_FF) { f8 = true; return n - C_FV; }
    if (n < C_MQK) return 2560 + (n - C_FF);
    if (n < C_MV) return 1024 + (n - C_MQK);
    if (n < C_MI) { f8 = true; return 512 + (n - C_MV); }
    if (n < C_MO) return 2568 + (n - C_MI);
    if (n < C_HF) { f8 = true; return 1024 + (n - C_MO); }
    if (n < C_HQ) return 1536 + (n - C_HF);
    if (n < C_HI) return 2048 + (n - C_HQ);
    if (n < C_HG) { f8 = true; return 1536 + (n - C_HI); }
    if (n < C_GATES) { f8 = true; return 2048 + (n - C_HG); }
    f8 = true; return VF_VALS + (n - C_GATES);
}
DEV void lds_barrier() { asm volatile("s_waitcnt lgkmcnt(0)\n\ts_barrier" ::: "memory"); }
DEV const float* arg_in(int idx) {
    typedef const float* fptr_t;
    const __attribute__((address_space(4))) char* ka = (const __attribute__((address_space(4))) char*)__builtin_amdgcn_kernarg_segment_ptr();
    return *(const __attribute__((address_space(4))) fptr_t*)(ka + idx * 8);
}
struct MB { const float* src; unsigned char* dst; int ld; bool ok, f8; };
DEV MB mix_cb(const Params& p, int layer, int u, int lane, int wid) {
    MB c;
    int job, kb, nb, b = 0;
    if (u < 1032) { job = 0; kb = u & 7; nb = u >> 3; }
    else if (u < 1224) { const int r = (u - 1032) & 63; job = 1; b = (u - 1032) >> 6; kb = r & 3; nb = r >> 2; }
    else if (u < 1352) { job = 2; kb = (u - 1224) & 7; nb = (u - 1224) >> 3; }
    else { job = 3; kb = u - 1352; nb = 0; }
    const int N = (job == 0) ? DIN : (job == 3) ? 64 : 1024, K = (job == 1) ? 512 : 1024;
    const float* base = arg_in((job == 0) ? (int)I_WIN : (int)I_WBR + job - 1);
    const int n = nb * 64 + lane, k0 = kb * 128 + 16 * wid;
    c.ok = n < N; c.ld = N;
    c.src = base + ((size_t)layer * (job == 1 ? 3 : 1) + b) * (size_t)K * N + (size_t)k0 * N + (c.ok ? n : 0);
    bool f8 = false; int nm = n;
    if (job == 0) nm = inproj_vrow(c.ok ? n : 0, f8);
    c.f8 = f8;
    const size_t doff = (job == 0) ? (f8 ? OFF_WG8 : OFF_WIN) : (job == 1) ? OFF_WBR + (size_t)b * 1024 * 512 * 2 : (job == 2) ? OFF_WOUT : OFF_WRT;
    c.dst = p.ws + doff + (f8 ? (size_t)nm * 1024 + k0 : ((size_t)nm * K + k0) * 2);
    return c;
}
constexpr int MIX_CBLOCKS = 1032 + 192 + 128 + 8;
DEV void phase_convert_mix(const Params& p, int layer, char* lds) {
    const int t = tid_op(), lane = t & 63, wid = t >> 6, G = gridDim.x;
    int u = bid_op();
    if (u >= MIX_CBLOCKS) return;
    MB c = mix_cb(p, layer, u, lane, wid);
    float v[16];
#pragma unroll
    for (int i = 0; i < 16; ++i) v[i] = c.src[(size_t)i * c.ld];
#pragma unroll 1
    for (; u < MIX_CBLOCKS; u += G) {
        const bool more = u + G < MIX_CBLOCKS;
        const MB cn = mix_cb(p, layer, more ? u + G : u, lane, wid);
        float nx[16];
#pragma unroll
        for (int i = 0; i < 16; ++i) nx[i] = cn.src[(size_t)i * cn.ld];
        if (c.ok) {
            if (c.f8) { const float sc = F8_W_SCALE;
                *(uint4*)c.dst = make_uint4(pack4_fp8(v[0] * sc, v[1] * sc, v[2] * sc, v[3] * sc), pack4_fp8(v[4] * sc, v[5] * sc, v[6] * sc, v[7] * sc),
                                            pack4_fp8(v[8] * sc, v[9] * sc, v[10] * sc, v[11] * sc), pack4_fp8(v[12] * sc, v[13] * sc, v[14] * sc, v[15] * sc)); }
            else { *(uint4*)c.dst = make_uint4(pack2(v[0], v[1]), pack2(v[2], v[3]), pack2(v[4], v[5]), pack2(v[6], v[7]));
                   *(uint4*)(c.dst + 16) = make_uint4(pack2(v[8], v[9]), pack2(v[10], v[11]), pack2(v[12], v[13]), pack2(v[14], v[15])); }
        }
        c = cn;
#pragma unroll
        for (int i = 0; i < 16; ++i) v[i] = nx[i];
    }
}
struct CB { const float* src; unsigned char* dst; int ld; };
DEV CB moe_cb(const Params& p, int layer, int u, int lane, int wid) {
    CB c;
    const int e = u / 96, r = u % 96, which = r >> 5, t = r & 31;
    const float* base = arg_in((int)I_EW1 + (e < NEXP ? 0 : 3) + which);
    const float* w = base + (size_t)(e < NEXP ? layer * NEXP + e : layer) * 262144;
    if (which < 2) { const int kb = t & 7, nb = t >> 3, hc = nb * 64 + lane, nm = (hc >> 3) * 16 + ((hc >> 2) & 1) * 8 + (hc & 3) + (which ? 4 : 0);
        c.src = w + (size_t)(kb * 128 + 16 * wid) * 256 + hc; c.ld = 256; c.dst = p.ws + OFF_W13 + (size_t)e * 512 * 1024 + (size_t)nm * 1024 + kb * 128 + 16 * wid; }
    else { const int kb = t & 1, nb = t >> 1, n = nb * 64 + lane;
        c.src = w + (size_t)(kb * 128 + 16 * wid) * 1024 + n; c.ld = 1024; c.dst = p.ws + (e < NEXP ? OFF_W2 + (size_t)e * 1024 * 256 : OFF_W2S) + (size_t)n * 256 + kb * 128 + 16 * wid; }
    return c;
}
constexpr int MOE_CBLOCKS = NLIST * 96;
DEV void conv_moe_slice(const Params& p, int layer, int j0, int j1) {
    const int t = tid_op(), lane = t & 63, wid = t >> 6, G = gridDim.x, b = bid_op();
    if (j0 >= j1 || b + G * j0 >= MOE_CBLOCKS) return;
    CB c = moe_cb(p, layer, b + G * j0, lane, wid);
    float v[16];
#pragma unroll
    for (int i = 0; i < 16; ++i) v[i] = c.src[(size_t)i * c.ld];
#pragma unroll 1
    for (int j = j0; j < j1; ++j) {
        const int un = b + G * (j + 1);
        const bool more = (j + 1 < j1) && un < MOE_CBLOCKS;
        const CB cn = moe_cb(p, layer, more ? un : b + G * j, lane, wid);
        float nx[16];
#pragma unroll
        for (int i = 0; i < 16; ++i) nx[i] = cn.src[(size_t)i * cn.ld];
        const float sc = F8_W_SCALE;
        *(uint4*)c.dst = make_uint4(pack4_fp8(v[0] * sc, v[1] * sc, v[2] * sc, v[3] * sc), pack4_fp8(v[4] * sc, v[5] * sc, v[6] * sc, v[7] * sc),
                                    pack4_fp8(v[8] * sc, v[9] * sc, v[10] * sc, v[11] * sc), pack4_fp8(v[12] * sc, v[13] * sc, v[14] * sc, v[15] * sc));
        if (!more) break;
        c = cn;
#pragma unroll
        for (int i = 0; i < 16; ++i) v[i] = nx[i];
    }
}

DEV void phase_ada(const Params& p, char* lds) {
    float* condT = (float*)lds;
    float* red = condT + 1024 * 16;
    const int t = tid_op();
    for (int i = t; i < 16 * 1024; i += 512) { const int b = i >> 10, k = i & 1023; condT[k * 16 + b] = silu_f(p.in[I_C][i]); }
    __syncthreads();
    float* mod = (float*)(p.ws + OFF_MOD);
    for (int u = bid_op(); u < 2 * 96; u += gridDim.x) {
        const int l = u / 96, j0 = (u % 96) * 64, col = t & 63, kg = t >> 6;
        const float* w = p.in[I_ADAW] + (size_t)l * 1024 * 6144 + j0 + col;
        float acc[16];
#pragma unroll
        for (int b = 0; b < 16; ++b) acc[b] = 0.f;
        for (int k0 = kg * 128; k0 < kg * 128 + 128; k0 += 8) {
            float wv8[8];
#pragma unroll
            for (int uu = 0; uu < 8; ++uu) wv8[uu] = w[(size_t)(k0 + uu) * 6144];
#pragma unroll
            for (int uu = 0; uu < 8; ++uu) {
                const float wv = wv8[uu];
                const f32x4* cp = (const f32x4*)(condT + (k0 + uu) * 16);
#pragma unroll
                for (int q = 0; q < 4; ++q) { const f32x4 c4 = cp[q]; acc[q * 4 + 0] += c4[0] * wv; acc[q * 4 + 1] += c4[1] * wv; acc[q * 4 + 2] += c4[2] * wv; acc[q * 4 + 3] += c4[3] * wv; }
            }
        }
        __syncthreads();
#pragma unroll
        for (int b = 0; b < 16; ++b) red[(kg * 16 + b) * 64 + col] = acc[b];
        __syncthreads();
        for (int i = t; i < 16 * 64; i += 512) {
            const int b = i >> 6, c = i & 63;
            float s = p.in[I_ADAB][l * 6144 + j0 + c];
#pragma unroll
            for (int g = 0; g < 8; ++g) s += red[(g * 16 + b) * 64 + c];
            mod[((size_t)l * 16 + b) * 6144 + j0 + c] = s;
        }
    }
}

DEV void phase_norm(const Params& p, const float* xin, int layer, int which, bf16_t* hout) {
    const int lane = tid_op() & 63, wid = tid_op() >> 6;
    const float* g = p.in[which ? I_N2G : I_N1G] + layer * 1024;
    const float* mod = (const float*)(p.ws + OFF_MOD) + (size_t)layer * 16 * 6144;
    for (int row = bid_op() * 8 + wid; row < T; row += gridDim.x * 8) {
        const float* xr = xin + (size_t)row * 1024;
        f32x4 v[4]; float ss = 0.f;
#pragma unroll
        for (int i = 0; i < 4; ++i) { v[i] = *(const f32x4*)(xr + i * 256 + lane * 4); ss += v[i][0] * v[i][0] + v[i][1] * v[i][1] + v[i][2] * v[i][2] + v[i][3] * v[i][3]; }
        ss = wave_sum(ss);
        const float rstd = rsqrtf(ss * (1.f / 1024.f) + 1e-6f);
        const int b = row >> 11;
        const float* sh = mod + (size_t)b * 6144 + (which ? 3 : 0) * 1024;
        const float* sc = sh + 1024;
#pragma unroll
        for (int i = 0; i < 4; ++i) {
            const int c = i * 256 + lane * 4;
            const f32x4 g4 = *(const f32x4*)(g + c), sc4 = *(const f32x4*)(sc + c), sh4 = *(const f32x4*)(sh + c);
            float h0 = v[i][0] * rstd * g4[0] * (1.f + sc4[0]) + sh4[0];
            float h1 = v[i][1] * rstd * g4[1] * (1.f + sc4[1]) + sh4[1];
            float h2 = v[i][2] * rstd * g4[2] * (1.f + sc4[2]) + sh4[2];
            float h3 = v[i][3] * rstd * g4[3] * (1.f + sc4[3]) + sh4[3];
            uint2 o; o.x = pack2(h0, h1); o.y = pack2(h2, h3);
            *(uint2*)(hout + (size_t)row * 1024 + c) = o;
            if (which == 0) *(unsigned*)(p.ws + OFF_H8 + (size_t)row * 1024 + c) = pack4_fp8(h0 * F8_ACT_SCALE, h1 * F8_ACT_SCALE, h2 * F8_ACT_SCALE, h3 * F8_ACT_SCALE);
        }
    }
}

#define LAS __attribute__((address_space(3)))
namespace g8 {
typedef unsigned u32x4 __attribute__((ext_vector_type(4)));
constexpr int BM = 256, BK = 64, HALF = 128, HTB = HALF * BK * 2, STAGE_BYTES = 8 * HTB;
DEV int lds_byte(int r, int c) { const int st = (r >> 4) * 2 + (c >> 5), rr = r & 15, cc = c & 31, ob = rr * 64 + cc * 2; return st * 1024 + (ob ^ (((ob >> 9) & 1) << 5)); }
DEV void stage_rc(int b, int& R, int& C) { const int st = b / 1024, sb = b % 1024, swz = sb ^ (((sb >> 9) & 1) << 5); R = (st >> 1) * 16 + swz / 64; C = (st & 1) * 32 + (swz % 64) / 2; }
DEV int perm32(int rho) { const int n = rho >> 4, i = rho & 15; return 8 * (i >> 2) + 4 * n + (i & 3); }

struct GUnit { const char* A; const char* B; const int* rows; int pm, pn, aux; };

typedef int v8i_t __attribute__((ext_vector_type(8)));
typedef int v4i_t __attribute__((ext_vector_type(4)));
DEV v8i_t cat8(bf16x8 a, bf16x8 b) { const v4i_t x = __builtin_bit_cast(v4i_t, a), y = __builtin_bit_cast(v4i_t, b); return (v8i_t){x[0], x[1], x[2], x[3], y[0], y[1], y[2], y[3]}; }
template <bool PERM, bool GATHER, bool F8, int SEXP = 0, class Gen, class Epi>
DEV void gemm8(LAS unsigned char* lds, const int lda_b, const int ldb_b, const int K, const Gen& S, const Epi& E) {
    int tid_ = tid_op();
    const int tid = tid_, wid = __builtin_amdgcn_readfirstlane(tid >> 6), lane = tid & 63, wr = wid >> 2, wc = wid & 3, fr = lane & 15, fq = lane >> 4;
    const int nt = K / BK;
    int Rs[2], Cb[2];
    unsigned voffB[2];
#pragma unroll
    for (int i = 0; i < 2; ++i) { int R, C; stage_rc(tid * 16 + i * 8192, R, C); const int Rb = PERM ? (64 * (R >> 5) + 16 * ((R & 15) >> 2) + 4 * ((R >> 4) & 1) + (R & 3)) : R;
        Rs[i] = R; Cb[i] = C * 2; voffB[i] = (unsigned)Rb * (unsigned)ldb_b + (unsigned)C * 2u; }
    const size_t kstep = (size_t)(BK * 2);
    const size_t hstepB = (size_t)(PERM ? 8 : HALF) * ldb_b;
    const unsigned ldsw = (unsigned)wid * 1024u;
    const int aoff = lds_byte(wr * 64 + fr, fq * 8), boff = lds_byte(wc * 32 + fr, fq * 8);
#define PG8_SA(b, h) (((b) * 2 + (h)) * HTB)
#define PG8_SB(b, h) ((4 + (b) * 2 + (h)) * HTB)
#define PG8_STAGE(bufoff, gbase, voff) do { _Pragma("unroll") for (int _i = 0; _i < 2; ++_i) \
        __builtin_amdgcn_global_load_lds((const unsigned*)((const char*)(gbase) + (voff)[_i]), (LAS unsigned*)(lds + (bufoff) + ldsw + _i * 8192), 16, 0, 0); } while (0)
#define PG8_LDA(dst, b, h) do { _Pragma("unroll") for (int m = 0; m < 4; ++m) { if constexpr (F8) dst##8[m] = cat8(*(const LAS bf16x8*)(lds + PG8_SA(b, h) + aoff + m * 2048), *(const LAS bf16x8*)(lds + PG8_SA(b, h) + aoff + m * 2048 + 1024)); \
        else { _Pragma("unroll") for (int k = 0; k < 2; ++k) dst[m][k] = *(const LAS bf16x8*)(lds + PG8_SA(b, h) + aoff + m * 2048 + k * 1024); } } } while (0)
#define PG8_LDB(dst, b, h) do { _Pragma("unroll") for (int n = 0; n < 2; ++n) { if constexpr (F8) dst##8[n] = cat8(*(const LAS bf16x8*)(lds + PG8_SB(b, h) + boff + n * 2048), *(const LAS bf16x8*)(lds + PG8_SB(b, h) + boff + n * 2048 + 1024)); \
        else { _Pragma("unroll") for (int k = 0; k < 2; ++k) dst[n][k] = *(const LAS bf16x8*)(lds + PG8_SB(b, h) + boff + n * 2048 + k * 1024); } } } while (0)
#define PG8_MMA(ai, bj, At, Bt) do { __builtin_amdgcn_s_setprio(1); _Pragma("unroll") for (int m = 0; m < 4; ++m) _Pragma("unroll") for (int n = 0; n < 2; ++n) { \
        if constexpr (F8) asm volatile("v_mfma_scale_f32_16x16x128_f8f6f4 %0, %1, %2, %0, %3, %4 op_sel_hi:[0,0,0]" : "+v"(acc[ai][bj][m][n]) : "v"(Bt##8[n]), "v"(At##8[m]), "v"(0x7f7f7f7f), "v"(0x01010101 * (127 + SEXP))); \
        else { _Pragma("unroll") for (int k = 0; k < 2; ++k) acc[ai][bj][m][n] = __builtin_amdgcn_mfma_f32_16x16x32_bf16(Bt[n][k], At[m][k], acc[ai][bj][m][n], 0, 0, 0); } } \
        __builtin_amdgcn_s_setprio(0); } while (0)
#define PG8_WAIT_V(n) asm volatile("s_waitcnt vmcnt(" #n ")" ::: "memory")
#define PG8_WAIT_L(n) asm volatile("s_waitcnt lgkmcnt(" #n ")" ::: "memory")
#define PG8_BAR __builtin_amdgcn_s_barrier()
#define PG8_SCHED __builtin_amdgcn_sched_barrier(0)
    GUnit cur, nxt; int ui = 0;
    if (!S.next(0, cur)) return;
    unsigned cOff[2][2], nOff[2][2];
    auto mkoff = [&](unsigned (&o)[2][2], int buf) {
#pragma unroll
        for (int h = 0; h < 2; ++h)
#pragma unroll
            for (int i = 0; i < 2; ++i) {
                if constexpr (GATHER) o[h][i] = (unsigned)S.rb[buf * 256 + h * HALF + Rs[i]] * (unsigned)lda_b + (unsigned)Cb[i];
                else o[h][i] = (unsigned)(h * HALF + Rs[i]) * (unsigned)lda_b + (unsigned)Cb[i];
            }
    };
    auto rows_dma = [&](const int* rows, int buf) {
        if constexpr (GATHER) __builtin_amdgcn_global_load_lds((const unsigned*)(rows + lane * 4), (LAS unsigned*)(S.rb + buf * 256), 16, 0, 0);
    };
    if constexpr (GATHER) {
        if (wid == 0) { rows_dma(cur.rows, 0); GUnit t1; if (S.next(1, t1)) rows_dma(t1.rows, 1); }
        asm volatile("s_waitcnt vmcnt(0)" ::: "memory");
        __builtin_amdgcn_s_barrier();
    }
    mkoff(cOff, 0);
    f32x4 acc[2][2][4][2];
#pragma unroll
    for (int a = 0; a < 2; ++a)
#pragma unroll
        for (int b = 0; b < 2; ++b)
#pragma unroll
            for (int m = 0; m < 4; ++m)
#pragma unroll
                for (int n = 0; n < 2; ++n) acc[a][b][m][n] = (f32x4){0.f, 0.f, 0.f, 0.f};
    bf16x8 At[4][2], B0[2][2], B1[2][2];
    v8i_t At8[4], B08[2], B18[2];
    const char* cA = cur.A; const char* cB = cur.B;
    PG8_STAGE(PG8_SB(0, 0), cB, voffB); PG8_STAGE(PG8_SB(0, 1), cB + hstepB, voffB); PG8_STAGE(PG8_SA(0, 0), cA, cOff[0]); PG8_STAGE(PG8_SA(0, 1), cA, cOff[1]);
    if (wr == 1) PG8_BAR;
    PG8_WAIT_V(2); PG8_BAR;
    PG8_STAGE(PG8_SB(1, 0), cB + kstep, voffB); PG8_STAGE(PG8_SA(1, 0), cA + kstep, cOff[0]); PG8_STAGE(PG8_SB(1, 1), cB + hstepB + kstep, voffB);
    PG8_WAIT_V(6); PG8_BAR;
    for (;;) {
        const bool has_next = S.next(ui + 1, nxt);
        if constexpr (GATHER) {
            { GUnit t2; if (S.next(ui + 2, t2) && wid == 0) rows_dma(t2.rows, ui & 1); }
            if (has_next) mkoff(nOff, (ui + 1) & 1);
            else {
#pragma unroll
                for (int h = 0; h < 2; ++h)
#pragma unroll
                    for (int i = 0; i < 2; ++i) nOff[h][i] = cOff[h][i];
            }
        }
        const char* nA = has_next ? nxt.A : cA; const char* nB = has_next ? nxt.B : cB;
#pragma unroll 1
        for (int t = 0; t < nt; t += 2) {
            const bool last = (t == nt - 2);
            const char* a1 = cA + (size_t)(t + 1) * kstep;
            const char* a2 = last ? nA : cA + (size_t)(t + 2) * kstep; const char* b2 = last ? nB : cB + (size_t)(t + 2) * kstep;
            const char* a3 = a2 + kstep; const char* b3 = b2 + kstep;
            unsigned o2[2][2];
#pragma unroll
            for (int h = 0; h < 2; ++h)
#pragma unroll
                for (int i = 0; i < 2; ++i) { if constexpr (GATHER) o2[h][i] = last ? nOff[h][i] : cOff[h][i]; else o2[h][i] = cOff[h][i]; }
            PG8_LDB(B0, 0, 0); PG8_LDB(B1, 0, 1); PG8_SCHED; PG8_LDA(At, 0, 0); PG8_STAGE(PG8_SA(1, 1), a1, cOff[1]);
            PG8_WAIT_V(8); PG8_WAIT_L(0); PG8_BAR; PG8_MMA(0, 0, At, B0); PG8_MMA(0, 1, At, B1); PG8_BAR; PG8_SCHED;
            PG8_LDA(At, 0, 1); PG8_STAGE(PG8_SB(0, 0), b2, voffB); PG8_STAGE(PG8_SB(0, 1), b2 + hstepB, voffB); PG8_STAGE(PG8_SA(0, 0), a2, o2[0]);
            PG8_WAIT_V(8); PG8_WAIT_L(0); PG8_BAR; PG8_MMA(1, 0, At, B0); PG8_MMA(1, 1, At, B1); PG8_BAR; PG8_SCHED;
            PG8_LDB(B0, 1, 0); PG8_LDB(B1, 1, 1); PG8_SCHED; PG8_LDA(At, 1, 0); PG8_STAGE(PG8_SA(0, 1), a2, o2[1]);
            PG8_WAIT_V(8); PG8_WAIT_L(0); PG8_BAR; PG8_MMA(0, 0, At, B0); PG8_MMA(0, 1, At, B1); PG8_BAR; PG8_SCHED;
            PG8_LDA(At, 1, 1); PG8_STAGE(PG8_SB(1, 0), b3, voffB); PG8_STAGE(PG8_SB(1, 1), b3 + hstepB, voffB); PG8_STAGE(PG8_SA(1, 0), a3, o2[0]);
            PG8_WAIT_V(8); PG8_WAIT_L(0); PG8_BAR; PG8_MMA(1, 0, At, B0); PG8_MMA(1, 1, At, B1); PG8_BAR; PG8_SCHED;
        }
        if (wr == 0) PG8_BAR;
        if constexpr (F8) asm volatile("s_nop 15\n\ts_nop 15" ::: "memory");
        { int pm_ = cur.pm, pn_ = cur.pn; asm volatile("" : "+s"(pm_), "+s"(pn_)); cur.pm = pm_; cur.pn = pn_; }
        E(acc, cur, wr, wc, fr, fq);
        if (!has_next) break;
        if (!(nxt.aux & 256)) {
#pragma unroll
            for (int a = 0; a < 2; ++a)
#pragma unroll
                for (int b = 0; b < 2; ++b)
#pragma unroll
                    for (int m = 0; m < 4; ++m)
#pragma unroll
                        for (int n = 0; n < 2; ++n) acc[a][b][m][n] = (f32x4){0.f, 0.f, 0.f, 0.f};
        }
        cur = nxt; cA = nA; cB = nB; ++ui;
        if constexpr (GATHER) {
#pragma unroll
            for (int h = 0; h < 2; ++h)
#pragma unroll
                for (int i = 0; i < 2; ++i) cOff[h][i] = nOff[h][i];
        }
        if (wr == 1) PG8_BAR;
    }
    PG8_WAIT_V(0);
    PG8_BAR;
#undef PG8_SA
#undef PG8_SB
#undef PG8_STAGE
#undef PG8_LDA
#undef PG8_LDB
#undef PG8_MMA
#undef PG8_WAIT_V
#undef PG8_WAIT_L
#undef PG8_BAR
#undef PG8_SCHED
}

struct TileOrder {
    int nM, nN, nwg;
    DEV void init(int nM_, int nN_) { nM = nM_; nN = nN_; nwg = nM * nN; }
    DEV bool get(int L, int& pm, int& pn) const {
        if (L >= nwg) return false;
        constexpr int NXCD = 8, WGM = 8;
        int wgid = L; { const int q = nwg / NXCD, r = nwg % NXCD, xcd = wgid % NXCD, off = wgid / NXCD; wgid = (xcd < r ? xcd * (q + 1) : r * (q + 1) + (xcd - r) * q) + off; }
        const int nig = WGM * nN, gid = wgid / nig, fm = gid * WGM, gsz = (nM - fm) < WGM ? (nM - fm) : WGM;
        pm = fm + ((wgid % nig) % gsz); pn = (wgid % nig) / gsz; return true;
    }
};
}

DEV unsigned ldsaddr_dummy() { return 0; }


DEV uint4 dpp_swap1(uint4 v) {
    uint4 r;
    r.x = (unsigned)__builtin_amdgcn_update_dpp(0, (int)v.x, 0xB1, 0xF, 0xF, true); r.y = (unsigned)__builtin_amdgcn_update_dpp(0, (int)v.y, 0xB1, 0xF, 0xF, true);
    r.z = (unsigned)__builtin_amdgcn_update_dpp(0, (int)v.z, 0xB1, 0xF, 0xF, true); r.w = (unsigned)__builtin_amdgcn_update_dpp(0, (int)v.w, 0xB1, 0xF, 0xF, true);
    return r;
}
DEV uint4 sel4(bool c, uint4 a, uint4 b) { uint4 r; r.x = c ? a.x : b.x; r.y = c ? a.y : b.y; r.z = c ? a.z : b.z; r.w = c ? a.w : b.w; return r; }
DEV void store_wide32(char* base, unsigned off, unsigned pitch, int fr, uint4 p0, uint4 p1) {
    const bool odd = fr & 1;
    const uint4 got = dpp_swap1(sel4(odd, p0, p1));
    *(uint4*)(base + (odd ? off - pitch + 16u : off)) = sel4(odd, got, p0);
    *(uint4*)(base + (odd ? off + 16u : off + pitch)) = sel4(odd, p1, got);
}

DEV void phase_inproj(const Params& p, char* lds) {
    bf16_t* P = (bf16_t*)(p.ws + OFF_PROJ);
    float* GS = (float*)(p.ws + OFF_GS);
    {
        struct Gen { g8::TileOrder o; const char* H; const char* W; int G, c;
            DEV bool next(int i, g8::GUnit& u) const { int pm, pn; if (!o.get(i * G + c, pm, pn)) return false; u.pm = pm; u.pn = pn; u.aux = 0; u.rows = nullptr;
                u.A = H + (size_t)pm * 256 * 2048; u.B = W + (size_t)pn * 256 * 2048; return true; } } gen;
        gen.o.init(T / 256, 11); gen.H = (const char*)(p.ws + OFF_H); gen.W = (const char*)(p.ws + OFF_WIN); gen.G = gridDim.x; gen.c = bid_op();
        auto epi = [&](const f32x4 (&acc)[2][2][4][2], const g8::GUnit& u, int wr, int wc, int fr, int fq) {
            const int vc0 = u.pn * 256 + 64 * wc + 16 * fq;
            if (vc0 < 2560) {
                const unsigned pc0 = (unsigned)vb_to_proj(vc0);
#pragma unroll
                for (int ai = 0; ai < 2; ++ai)
#pragma unroll
                    for (int m = 0; m < 4; ++m) {
                        const int row = u.pm * 256 + ai * 128 + wr * 64 + m * 16 + fr;
                        const f32x4 a0 = acc[ai][0][m][0], a1 = acc[ai][0][m][1], b0 = acc[ai][1][m][0], b1 = acc[ai][1][m][1];
                        uint4 p0, p1;
                        p0.x = pack2(a0[0], a0[1]); p0.y = pack2(a0[2], a0[3]); p0.z = pack2(a1[0], a1[1]); p0.w = pack2(a1[2], a1[3]);
                        p1.x = pack2(b0[0], b0[1]); p1.y = pack2(b0[2], b0[3]); p1.z = pack2(b1[0], b1[1]); p1.w = pack2(b1[2], b1[3]);
                        store_wide32((char*)P, ((unsigned)row * DIN + pc0) * 2u, (unsigned)DIN * 2u, fr, p0, p1);
                    }
            } else if (vc0 == 2560) {
#pragma unroll
                for (int ai = 0; ai < 2; ++ai)
#pragma unroll
                    for (int m = 0; m < 4; ++m) {
                        const int row = u.pm * 256 + ai * 128 + wr * 64 + m * 16 + fr;
                        const f32x4 a0 = acc[ai][0][m][0], a1 = acc[ai][0][m][1], b0 = acc[ai][1][m][0], b1 = acc[ai][1][m][1];
                        uint4 p0, p1;
                        p0.x = pack2(a0[0], a0[1]); p0.y = pack2(a0[2], a0[3]); p0.z = pack2(a1[0], a1[1]); p0.w = pack2(a1[2], a1[3]);
                        p1.x = pack2(b0[0], b0[1]); p1.y = pack2(b0[2], b0[3]); p1.z = pack2(b1[0], b1[1]); p1.w = pack2(b1[2], b1[3]);
                        *(uint4*)(P + (size_t)row * DIN + C_FF) = p0; *(uint4*)(P + (size_t)row * DIN + C_MI) = p1;
                        *(f32x4*)(GS + (size_t)row * 16) = a0; *(f32x4*)(GS + (size_t)row * 16 + 4) = a1;
                        *(f32x4*)(GS + (size_t)row * 16 + 8) = b0; *(f32x4*)(GS + (size_t)row * 16 + 12) = b1;
                    }
            }
        };
        g8::gemm8<true, false, false>((LAS unsigned char*)lds, 2048, 2048, 1024, gen, epi);
    }
    {
        struct Gen { g8::TileOrder o; const char* H; const char* W; int G, c;
            DEV bool next(int i, g8::GUnit& u) const { int pm, pn;
                int L = i * G + c;
                if (G == 256) { if (i >= 10) { if (c < 128 || i >= 12) return false; L = 2560 + (i - 10) * 128 + (c - 128); } }
                if (!o.get(L, pm, pn)) return false; u.pm = pm; u.pn = pn; u.aux = 0; u.rows = nullptr;
                u.A = H + (size_t)pm * 256 * 1024; u.B = W + (size_t)pn * 256 * 1024; return true; } } gen;
        gen.o.init(T / 256, 22); gen.H = (const char*)(p.ws + OFF_H8); gen.W = (const char*)(p.ws + OFF_WG8); gen.G = gridDim.x; gen.c = bid_op();
        auto epi = [&](const f32x4 (&acc)[2][2][4][2], const g8::GUnit& u, int wr, int wc, int fr, int fq) {
            const int vc0 = u.pn * 256 + 64 * wc + 16 * fq;
            const unsigned pc0 = (unsigned)vf_to_proj(vc0);
            const bool gate = u.pn >= 10;
#pragma unroll
            for (int ai = 0; ai < 2; ++ai)
#pragma unroll
                for (int m = 0; m < 4; ++m) {
                    const int row = u.pm * 256 + ai * 128 + wr * 64 + m * 16 + fr;
                    f32x4 a0 = acc[ai][0][m][0], a1 = acc[ai][0][m][1], b0 = acc[ai][1][m][0], b1 = acc[ai][1][m][1];
                    if (gate) {
#pragma unroll
                        for (int j = 0; j < 4; ++j) { a0[j] = fsigmoid(a0[j]); a1[j] = fsigmoid(a1[j]); b0[j] = fsigmoid(b0[j]); b1[j] = fsigmoid(b1[j]); }
                    }
                    uint4 p0, p1;
                    p0.x = pack2(a0[0], a0[1]); p0.y = pack2(a0[2], a0[3]); p0.z = pack2(a1[0], a1[1]); p0.w = pack2(a1[2], a1[3]);
                    p1.x = pack2(b0[0], b0[1]); p1.y = pack2(b0[2], b0[3]); p1.z = pack2(b1[0], b1[1]); p1.w = pack2(b1[2], b1[3]);
                    store_wide32((char*)P, ((unsigned)row * DIN + pc0) * 2u, (unsigned)DIN * 2u, fr, p0, p1);
                }
        };
        g8::gemm8<true, false, true, -9>((LAS unsigned char*)lds, 1024, 1024, 512, gen, epi);
    }
}

DEV void phase_merge(const Params& p, char* lds) {
    bf16_t* P = (bf16_t*)(p.ws + OFF_PROJ);
    const char* W = (const char*)(p.ws + OFF_WBR);
    struct Gen { g8::TileOrder o; const char* P; const char* W; int G, c;
        DEV bool next(int i, g8::GUnit& u) const { int pm, pn; const int ti = i / 3, b = i - ti * 3; if (!o.get(ti * G + c, pm, pn)) return false; u.pm = pm; u.pn = pn; u.aux = b | (b > 0 ? 256 : 0); u.rows = nullptr;
            const int ycol = (b == 0) ? C_FQ : (b == 1) ? C_MO : C_HG;
            u.A = P + ((size_t)pm * 256 * DIN + ycol) * 2; u.B = W + ((size_t)b * 1024 + pn * 256) * 512 * 2; return true; } } gen;
    gen.o.init(T / 256, 4); gen.P = (const char*)P; gen.W = W; gen.G = gridDim.x; gen.c = bid_op();
    auto epi = [&](f32x4 (&acc)[2][2][4][2], const g8::GUnit& u, int wr, int wc, int fr, int fq) {
        const int b = u.aux & 3;
#pragma unroll
        for (int ai = 0; ai < 2; ++ai) {
            uint4 gq[8], hq[8];
            bf16_t* rp = P + (size_t)(u.pm * 256 + ai * 128 + wr * 64 + fr) * DIN + u.pn * 256 + 64 * wc + 16 * fq;
#pragma unroll
            for (int m = 0; m < 4; ++m)
#pragma unroll
                for (int hf = 0; hf < 2; ++hf) {
                    const bf16_t* q = rp + (size_t)(m * 16) * DIN + hf * 8 + C_GATES + b * 1024;
                    gq[m * 2 + hf] = *(const uint4*)q;
                    if (b < 2) hq[m * 2 + hf] = *(const uint4*)(q + 1024);
                }
#pragma unroll
            for (int m = 0; m < 4; ++m) {
#pragma unroll
                for (int bj = 0; bj < 2; ++bj) {
                    float g[8]; unpack8(gq[m * 2 + bj], g);
                    if (b > 0) {
#pragma unroll
                        for (int j = 0; j < 8; ++j) g[j] = fmaxf(g[j], 1e-6f);
                    }
                    if (b < 2) { float gn[8]; unpack8(hq[m * 2 + bj], gn);
#pragma unroll
                        for (int j = 0; j < 8; ++j) g[j] *= __builtin_amdgcn_rcpf(fmaxf(gn[j], 1e-6f)); }
#pragma unroll
                    for (int j = 0; j < 4; ++j) { acc[ai][bj][m][0][j] *= g[j]; acc[ai][bj][m][1][j] *= g[4 + j]; }
                }
                if (b == 2) {
                    const f32x4 a0 = acc[ai][0][m][0], a1 = acc[ai][0][m][1], b0 = acc[ai][1][m][0], b1 = acc[ai][1][m][1];
                    uint4 p0, p1;
                    p0.x = pack2(a0[0], a0[1]); p0.y = pack2(a0[2], a0[3]); p0.z = pack2(a1[0], a1[1]); p0.w = pack2(a1[2], a1[3]);
                    p1.x = pack2(b0[0], b0[1]); p1.y = pack2(b0[2], b0[3]); p1.z = pack2(b1[0], b1[1]); p1.w = pack2(b1[2], b1[3]);
                    store_wide32((char*)(p.ws + OFF_H), ((unsigned)(u.pm * 256 + ai * 128 + wr * 64 + m * 16 + fr) * 1024u + (unsigned)(u.pn * 256 + 64 * wc + 16 * fq)) * 2u, 2048u, fr, p0, p1);
                }
            }
        }
    };
    g8::gemm8<true, false, false>((LAS unsigned char*)lds, DIN * 2, 1024, 512, gen, epi);
}

DEV void phase_out(const Params& p, int layer, char* lds) {
    const char* M = (const char*)(p.ws + OFF_H);
    const char* W = (const char*)(p.ws + OFF_WOUT);
    const float* mod = (const float*)(p.ws + OFF_MOD) + (size_t)layer * 16 * 6144;
    struct Gen { g8::TileOrder o; const char* M; const char* W; int G, c;
        DEV bool next(int i, g8::GUnit& u) const { int pm, pn; if (!o.get(i * G + c, pm, pn)) return false; u.pm = pm; u.pn = pn; u.aux = i; u.rows = nullptr;
            u.A = M + (size_t)pm * 256 * 2048; u.B = W + (size_t)pn * 256 * 2048; return true; } } gen;
    gen.o.init(T / 256, 4); gen.M = M; gen.W = W; gen.G = gridDim.x; gen.c = bid_op();
    const float* xf = p.in[I_X];
    const bf16_t* xh = (const bf16_t*)p.out;
    const int jmax = (MOE_CBLOCKS + (int)gridDim.x - 1) / (int)gridDim.x, umin = (T / 256 * 4) / (int)gridDim.x, jslice = (jmax + umin - 1) / umin;
    auto epi = [&](const f32x4 (&acc)[2][2][4][2], const g8::GUnit& u, int wr, int wc, int fr, int fq) {
        const int bb = (u.pm * 256) >> 11;
        const int c0 = u.pn * 256 + 64 * wc + 16 * fq;
        f32x4 g1[4];
#pragma unroll
        for (int q = 0; q < 4; ++q) g1[q] = *(const f32x4*)(mod + (size_t)bb * 6144 + 2 * 1024 + c0 + 4 * q);
#pragma unroll
        for (int ai = 0; ai < 2; ++ai) {
            const unsigned r0 = (unsigned)(u.pm * 256 + ai * 128 + wr * 64 + fr);
            if (layer == 0) {
#pragma unroll
                for (int mh = 0; mh < 2; ++mh) {
                    f32x4 xr[2][4];
#pragma unroll
                    for (int m = 0; m < 2; ++m)
#pragma unroll
                        for (int q = 0; q < 4; ++q) xr[m][q] = *(const f32x4*)(xf + (size_t)(r0 + (mh * 2 + m) * 16) * 1024 + c0 + 4 * q);
#pragma unroll
                    for (int m2 = 0; m2 < 2; ++m2) {
                        const int m = mh * 2 + m2;
                        float o[16];
#pragma unroll
                        for (int bj = 0; bj < 2; ++bj)
#pragma unroll
                            for (int n = 0; n < 2; ++n)
#pragma unroll
                                for (int j = 0; j < 4; ++j) o[8 * bj + 4 * n + j] = xr[m2][2 * bj + n][j] + g1[2 * bj + n][j] * acc[ai][bj][m][n][j];
                        uint4 p0, p1;
                        p0.x = pack2(o[0], o[1]); p0.y = pack2(o[2], o[3]); p0.z = pack2(o[4], o[5]); p0.w = pack2(o[6], o[7]);
                        p1.x = pack2(o[8], o[9]); p1.y = pack2(o[10], o[11]); p1.z = pack2(o[12], o[13]); p1.w = pack2(o[14], o[15]);
                        store_wide32((char*)(p.ws + OFF_XB), ((r0 + m * 16) * 1024u + (unsigned)c0) * 2u, 2048u, fr, p0, p1);
                    }
                }
            } else {
                uint4 xr[4][2];
#pragma unroll
                for (int m = 0; m < 4; ++m)
#pragma unroll
                    for (int q = 0; q < 2; ++q) xr[m][q] = *(const uint4*)(xh + (size_t)(r0 + m * 16) * 1024 + c0 + 8 * q);
#pragma unroll
                for (int m = 0; m < 4; ++m) {
                    float o[16];
#pragma unroll
                    for (int bj = 0; bj < 2; ++bj) {
                        float xv[8]; unpack8(xr[m][bj], xv);
#pragma unroll
                        for (int n = 0; n < 2; ++n)
#pragma unroll
                            for (int j = 0; j < 4; ++j) o[8 * bj + 4 * n + j] = xv[4 * n + j] + g1[2 * bj + n][j] * acc[ai][bj][m][n][j];
                    }
                    uint4 p0, p1;
                    p0.x = pack2(o[0], o[1]); p0.y = pack2(o[2], o[3]); p0.z = pack2(o[4], o[5]); p0.w = pack2(o[6], o[7]);
                    p1.x = pack2(o[8], o[9]); p1.y = pack2(o[10], o[11]); p1.z = pack2(o[12], o[13]); p1.w = pack2(o[14], o[15]);
                    store_wide32((char*)(p.ws + OFF_XB), ((r0 + m * 16) * 1024u + (unsigned)c0) * 2u, 2048u, fr, p0, p1);
                }
            }
        }
        { const int j0 = u.aux * jslice, j1 = (j0 + jslice < jmax) ? j0 + jslice : jmax; conv_moe_slice(p, layer, j0, j1); }
    };
    g8::gemm8<true, false, false>((LAS unsigned char*)lds, 2048, 2048, 1024, gen, epi);
}

DEV void phase_front(const Params& p, int layer, char* lds) {
    constexpr int LDH = 1032;
    bf16_t* HT = (bf16_t*)lds;
    float* LG = (float*)(HT + 32 * LDH);
    int* cntl = (int*)(LG + 32 * 64);
    int* basel = cntl + 128;
    int* sel = basel + 128;
    const int tid = tid_op(), lane = tid & 63, wid = tid >> 6, qi = lane & 15, g = lane >> 4;
    const float* gam = p.in[I_N2G] + layer * 1024;
    const float* mod = (const float*)(p.ws + OFF_MOD) + (size_t)layer * 16 * 6144;
    const bf16_t* WrT = (const bf16_t*)(p.ws + OFF_WRT);
    bf16_t* Hb = (bf16_t*)(p.ws + OFF_H);
    const float bias = p.in[I_RB][layer * 64 + lane];
    int* idx = (int*)(p.ws + OFF_IDX); float* wts = (float*)(p.ws + OFF_WTS); int* rank = (int*)(p.ws + OFF_RANK);
    int* cnt = (int*)(p.ws + OFF_CNT) + layer * 128 * CNT_STRIDE;
    __syncthreads();
    if (tid < 128) cntl[tid] = 0;
    const int ntok = T / (int)gridDim.x, tbase = bid_op() * ntok;
    const int grp = lane >> 3;
#pragma unroll 1
    for (int sub = 0; sub < ntok / 32; ++sub) {
        const int t0 = tbase + sub * 32;
        {
            f32x4 v[4][4];
#pragma unroll
            for (int rr = 0; rr < 4; ++rr) {
                const bf16_t* xr = (const bf16_t*)(p.ws + OFF_XB) + (size_t)(t0 + wid * 4 + rr) * 1024;
#pragma unroll
                for (int i = 0; i < 4; ++i) { const uint2 q = *(const uint2*)(xr + i * 256 + lane * 4);
                    v[rr][i] = (f32x4){__uint_as_float(q.x << 16), __uint_as_float(q.x & 0xffff0000u), __uint_as_float(q.y << 16), __uint_as_float(q.y & 0xffff0000u)}; }
            }
            const int b = t0 >> 11;
            const float* sh = mod + (size_t)b * 6144 + 3 * 1024;
            const float* sc = sh + 1024;
#pragma unroll
            for (int rr = 0; rr < 4; ++rr) {
                float ss = 0.f;
#pragma unroll
                for (int i = 0; i < 4; ++i) ss += v[rr][i][0] * v[rr][i][0] + v[rr][i][1] * v[rr][i][1] + v[rr][i][2] * v[rr][i][2] + v[rr][i][3] * v[rr][i][3];
                ss = wave_sum(ss);
                const float rstd = rsqrtf(ss * (1.f / 1024.f) + 1e-6f);
                const int row = t0 + wid * 4 + rr;
#pragma unroll
                for (int i = 0; i < 4; ++i) {
                    const int c = i * 256 + lane * 4;
                    const f32x4 g4 = *(const f32x4*)(gam + c), sc4 = *(const f32x4*)(sc + c), sh4 = *(const f32x4*)(sh + c);
                    const float y0 = v[rr][i][0] * rstd * g4[0] * (1.f + sc4[0]) + sh4[0], y1 = v[rr][i][1] * rstd * g4[1] * (1.f + sc4[1]) + sh4[1];
                    const float y2 = v[rr][i][2] * rstd * g4[2] * (1.f + sc4[2]) + sh4[2], y3 = v[rr][i][3] * rstd * g4[3] * (1.f + sc4[3]) + sh4[3];
                    uint2 o; o.x = pack2(y0, y1); o.y = pack2(y2, y3);
                    *(unsigned*)(p.ws + OFF_H2F8 + (size_t)row * 1024 + c) = pack4_fp8(y0 * F8_ACT_SCALE, y1 * F8_ACT_SCALE, y2 * F8_ACT_SCALE, y3 * F8_ACT_SCALE);
                    *(uint2*)&HT[(wid * 4 + rr) * LDH + c] = o;
                }
            }
        }
        __syncthreads();
        {
            const int mt = wid >> 2, nt = wid & 3;
            f32x4 acc = (f32x4){0.f, 0.f, 0.f, 0.f};
            const bf16_t* wp = WrT + (size_t)(nt * 16 + qi) * 1024 + 8 * g;
            const bf16_t* hp = HT + (mt * 16 + qi) * LDH + 8 * g;
#pragma unroll
            for (int k8 = 0; k8 < 2; ++k8) {
                bf16x8 bw[16];
#pragma unroll
                for (int kk = 0; kk < 16; ++kk) bw[kk] = *(const bf16x8*)(wp + 32 * (k8 * 16 + kk));
#pragma unroll
                for (int kk = 0; kk < 16; ++kk) acc = __builtin_amdgcn_mfma_f32_16x16x32_bf16(*(const bf16x8*)(hp + 32 * (k8 * 16 + kk)), bw[kk], acc, 0, 0, 0);
            }
#pragma unroll
            for (int j = 0; j < 4; ++j) LG[(mt * 16 + 4 * g + j) * 64 + nt * 16 + qi] = acc[j];
        }
        __syncthreads();
#pragma unroll 1
        for (int rr = 0; rr < 4; ++rr) {
            const int k = sub * 32 + wid * 4 + rr, t = tbase + k;
            const float s = fsigmoid(LG[(wid * 4 + rr) * 64 + lane]);
            const float c = s + bias;
            float m1 = c;
            m1 = fmaxf(m1, sx(m1, 1)); m1 = fmaxf(m1, sx(m1, 2)); m1 = fmaxf(m1, sx(m1, 4));
            const unsigned long long bal = __ballot(c == m1);
            const unsigned gb = (unsigned)((bal >> (grp * 8)) & 0xffull);
            const int first = __ffs(gb) - 1;
            float c2 = ((lane & 7) == first) ? -INFINITY : c;
            c2 = fmaxf(c2, sx(c2, 1)); c2 = fmaxf(c2, sx(c2, 2)); c2 = fmaxf(c2, sx(c2, 4));
            const float gs = m1 + c2;
            int cg = 0;
#pragma unroll
            for (int gg = 0; gg < 8; ++gg) { const float v = __builtin_bit_cast(float, __builtin_amdgcn_readlane(__builtin_bit_cast(int, gs), gg * 8)); cg += (v > gs || (v == gs && gg < grp)) ? 1 : 0; }
            const float masked = (cg < 4) ? c : -INFINITY;
            int r = 0;
#pragma unroll
            for (int j = 0; j < 64; ++j) { const float v = __builtin_bit_cast(float, __builtin_amdgcn_readlane(__builtin_bit_cast(int, masked), j)); r += (v > masked || (v == masked && j < lane)) ? 1 : 0; }
            const bool selb = (r < 8) && (cg < 4);
            const float wsum = wave_sum(selb ? s : 0.f);
            if (selb) {
                const int half = t / HALF_T;
                idx[(size_t)t * 8 + r] = lane;
                wts[(size_t)t * 8 + r] = s / wsum * 2.5f;
                const int lr = atomicAdd(&cntl[half * 64 + lane], 1);
                sel[k * 8 + r] = (lane << 16) | lr;
            }
        }
    }
    __syncthreads();
    if (tid < 128) basel[tid] = atomicAdd(&cnt[tid * CNT_STRIDE], cntl[tid]);
    __syncthreads();
    for (int i = tid; i < ntok * 8; i += 512) {
        const int t = tbase + (i >> 3), half = t / HALF_T, v = sel[i];
        rank[(size_t)t * 8 + (i & 7)] = basel[half * 64 + (v >> 16)] + (v & 0xffff);
    }
}

DEV void phase_scatter(const Params& p, int layer, char* lds) {
    int* poff = (int*)lds;
    const int* cnt = (const int*)(p.ws + OFF_CNT) + layer * 128 * CNT_STRIDE;
    const int t = tid_op();
    int* cl = poff + 132;
    __syncthreads();
    if (t < 128) cl[t] = cnt[t * CNT_STRIDE];
    __syncthreads();
    if (t < NHALF) {
        int o = 0;
        for (int l = 0; l < NLIST; ++l) { poff[t * 66 + l] = o; const int c = (l < NEXP) ? cl[t * 64 + l] : HALF_T; o += (c + 255) / 256 * 256; }
        poff[t * 66 + NLIST] = o;
    }
    __syncthreads();
    const int* idx = (const int*)(p.ws + OFF_IDX); const int* rank = (const int*)(p.ws + OFF_RANK);
    int* rowtok = (int*)(p.ws + OFF_ROWTOK); int* posa = (int*)(p.ws + OFF_POS);
    int* tilel = (int*)(p.ws + OFF_TILEL);
    const int gt = bid_op() * 512 + t, gn = gridDim.x * 512;
    for (int a = gt; a < T * 8; a += gn) {
        const int tok = a >> 3, k = a & 7, half = tok / HALF_T, e = idx[a];
        const int pos = poff[half * 66 + e] + rank[a];
        rowtok[half * ROWCAP + pos] = tok; posa[tok * NSLOT + k] = pos;
    }
    for (int tok = gt; tok < T; tok += gn) {
        const int half = tok / HALF_T, tl = tok - half * HALF_T;
        const int pos = poff[half * 66 + NEXP] + tl;
        rowtok[half * ROWCAP + pos] = tok; posa[tok * NSLOT + 8] = pos;
    }
    for (int j = gt; j < NHALF * NLIST * 256; j += gn) {
        const int half = j / (NLIST * 256), l = (j / 256) % NLIST, i = j & 255;
        const int c = (l < NEXP) ? cnt[(half * 64 + l) * CNT_STRIDE] : HALF_T;
        if ((c & 255) != 0 && i >= (c & 255)) {
            const int pos = poff[half * 66 + l] + (c & ~255) + i;
            rowtok[half * ROWCAP + pos] = half * HALF_T;
        }
    }
    for (int j = gt; j < NHALF * TILECAP; j += gn) {
        const int half = j / TILECAP, tile = j % TILECAP;
        const int row = tile * 256;
        if (row < poff[half * 66 + NLIST]) {
            int l = 0;
            for (int q = 1; q < NLIST; ++q) if (row >= poff[half * 66 + q]) l = q;
            tilel[half * (TILECAP + 16) + tile] = l;
        }
        if (tile == 0) tilel[half * (TILECAP + 16) + TILECAP] = poff[half * 66 + NLIST] / 256;
    }
}

DEV void phase_moe_up(const Params& p, int half, char* lds) {
    const char* H = (const char*)(p.ws + OFF_H2F8);
    const char* W13 = (const char*)(p.ws + OFF_W13);
    bf16_t* HID = (bf16_t*)(p.ws + OFF_HID);
    const int* rowtok = (const int*)(p.ws + OFF_ROWTOK) + half * ROWCAP;
    const int* tilel = (const int*)(p.ws + OFF_TILEL) + half * (TILECAP + 16);
    LAS int* TL = (LAS int*)(lds + 131072);
    struct Gen { const char* H; const char* W; const int* rowtok; LAS const int* tl; LAS int* rb; int nun, G, c;
        DEV bool next(int i, g8::GUnit& u) const { const int L = i * G + c; if (L >= nun) return false; const int tile = L >> 1, pn = L & 1, l = __builtin_amdgcn_readfirstlane(tl[tile]);
            u.pm = tile; u.pn = pn; u.aux = l; u.rows = rowtok + tile * 256; u.A = H; u.B = W + ((size_t)l * 512 + pn * 256) * 1024; return true; } } gen;
    gen.H = H; gen.W = W13; gen.rowtok = rowtok; gen.tl = TL; gen.rb = TL + TL_PAD; gen.nun = __builtin_amdgcn_readfirstlane(tilel[TILECAP]) * 2; gen.G = gridDim.x; gen.c = bid_op();
    __syncthreads();
    for (int i = tid_op(); i < (gen.nun >> 1); i += 512) TL[i] = tilel[i];
    __syncthreads();
    auto epi = [&](const f32x4 (&acc)[2][2][4][2], const g8::GUnit& u, int wr, int wc, int fr, int fq) {
#pragma unroll
        for (int ai = 0; ai < 2; ++ai)
#pragma unroll
            for (int m = 0; m < 4; ++m) {
                const int row = u.pm * 256 + ai * 128 + wr * 64 + m * 16 + fr;
                uint2 o;
#pragma unroll
                for (int bj = 0; bj < 2; ++bj) {
                    const f32x4 v1 = acc[ai][bj][m][0], v3 = acc[ai][bj][m][1];
                    const unsigned w = pack4_fp8(fsilu(v1[0]) * v3[0] * F8_ACT_SCALE, fsilu(v1[1]) * v3[1] * F8_ACT_SCALE, fsilu(v1[2]) * v3[2] * F8_ACT_SCALE, fsilu(v1[3]) * v3[3] * F8_ACT_SCALE);
                    if (bj == 0) o.x = w; else o.y = w;
                }
                *(uint2*)((unsigned char*)HID + (size_t)row * 256 + u.pn * 128 + 32 * wc + 8 * fq) = o;
            }
    };
    g8::gemm8<true, true, true, -9>((LAS unsigned char*)lds, 1024, 1024, 512, gen, epi);
}
DEV void phase_moe_down(const Params& p, int half, char* lds) {
    const char* HID = (const char*)(p.ws + OFF_HID);
    const char* W2 = (const char*)(p.ws + OFF_W2);
    unsigned char* OA = (unsigned char*)(p.ws + OFF_OUTA);
    const int* tilel = (const int*)(p.ws + OFF_TILEL) + half * (TILECAP + 16);
    LAS int* TL = (LAS int*)(lds + 131072);
    struct Gen { const char* HID; const char* W; const char* WS; LAS const int* tl; int nun, G, c;
        DEV bool next(int i, g8::GUnit& u) const { const int L = i * G + c; if (L >= nun) return false; const int tile = L >> 2, pn = L & 3, l = __builtin_amdgcn_readfirstlane(tl[tile]);
            u.pm = tile; u.pn = pn; u.aux = l; u.rows = nullptr; u.A = HID + (size_t)tile * 256 * 256; u.B = (l < NEXP ? W + (size_t)l * 1024 * 256 : WS) + (size_t)pn * 256 * 256; return true; } } gen;
    gen.HID = HID; gen.W = W2; gen.WS = (const char*)(p.ws + OFF_W2S); gen.tl = TL; gen.nun = __builtin_amdgcn_readfirstlane(tilel[TILECAP]) * 4; gen.G = gridDim.x; gen.c = bid_op();
    __syncthreads();
    for (int i = tid_op(); i < (gen.nun >> 2); i += 512) TL[i] = tilel[i];
    __syncthreads();
    auto epi = [&](const f32x4 (&acc)[2][2][4][2], const g8::GUnit& u, int wr, int wc, int fr, int fq) {
#pragma unroll
        for (int ai = 0; ai < 2; ++ai)
#pragma unroll
            for (int m = 0; m < 4; ++m) {
                const int row = u.pm * 256 + ai * 128 + wr * 64 + m * 16 + fr;
                unsigned w4[4];
#pragma unroll
                for (int bj = 0; bj < 2; ++bj) {
                    const f32x4 v0 = acc[ai][bj][m][0], v1 = acc[ai][bj][m][1];
                    w4[2 * bj] = pack4_fp8(v0[0], v0[1], v0[2], v0[3]); w4[2 * bj + 1] = pack4_fp8(v1[0], v1[1], v1[2], v1[3]);
                }
                *(uint4*)(OA + (size_t)row * 1024 + u.pn * 256 + 64 * wc + 16 * fq) = make_uint4(w4[0], w4[1], w4[2], w4[3]);
            }
    };
    g8::gemm8<true, false, true, -5>((LAS unsigned char*)lds, 256, 256, 128, gen, epi);
}
DEV void phase_combine(const Params& p, int layer, int half) {
    const unsigned char* OA = (const unsigned char*)(p.ws + OFF_OUTA);
    const float* mod = (const float*)(p.ws + OFF_MOD) + (size_t)layer * 16 * 6144;
    const float* modn = (const float*)(p.ws + OFF_MOD) + (size_t)(layer + 1) * 16 * 6144;
    const float* gnx = p.in[I_N1G] + (layer + 1) * 1024;
    bf16_t* Hb = (bf16_t*)(p.ws + OFF_H);
    const int tid = tid_op(), lane = tid & 63, wid = tid >> 6;
    typedef float f32x2v __attribute__((ext_vector_type(2)));
    for (int tl0 = bid_op() * 8 + wid; tl0 < HALF_T; tl0 += gridDim.x * 8) {
        const int tok = __builtin_amdgcn_readfirstlane(half * HALF_T + tl0), b = tok >> 11;
        const float* wt = (const float*)(p.ws + OFF_WTS) + (size_t)tok * 8;
        const int* ps = (const int*)(p.ws + OFF_POS) + (size_t)tok * NSLOT;
        uint4 rw[NSLOT];
#pragma unroll
        for (int k = 0; k < NSLOT; ++k) rw[k] = *(const uint4*)(OA + (size_t)ps[k] * 1024 + lane * 16);
        float* o = p.out + (size_t)tok * 1024 + lane * 16;
        float x[16];
        { const bf16_t* xb = (const bf16_t*)(p.ws + OFF_XB) + (size_t)tok * 1024 + lane * 16;
          const uint4 q0 = *(const uint4*)xb, q1 = *(const uint4*)(xb + 8); unpack8(q0, x); unpack8(q1, x + 8); }
        float a[16];
#pragma unroll
        for (int j = 0; j < 16; ++j) a[j] = 0.f;
#pragma unroll
        for (int k = 0; k < NSLOT; ++k) {
            const float w = ((k < 8) ? wt[k] : 1.f) * (1.f / 16.f);
            const unsigned uu[4] = {rw[k].x, rw[k].y, rw[k].z, rw[k].w};
#pragma unroll
            for (int q = 0; q < 4; ++q) {
                const f32x2v f0 = __builtin_amdgcn_cvt_pk_f32_fp8((int)uu[q], false), f1 = __builtin_amdgcn_cvt_pk_f32_fp8((int)uu[q], true);
                a[4 * q] += w * f0[0]; a[4 * q + 1] += w * f0[1]; a[4 * q + 2] += w * f1[0]; a[4 * q + 3] += w * f1[1];
            }
        }
        const float* g2 = mod + (size_t)b * 6144 + 5 * 1024 + lane * 16;
        float xn[16]; float ss = 0.f;
#pragma unroll
        for (int q = 0; q < 4; ++q) {
            const f32x4 gq = *(const f32x4*)(g2 + 4 * q);
#pragma unroll
            for (int j = 0; j < 4; ++j) { xn[4 * q + j] = x[4 * q + j] + gq[j] * a[4 * q + j]; ss += xn[4 * q + j] * xn[4 * q + j]; }
            if (layer != 0) *(f32x4*)(o + 4 * q) = (f32x4){xn[4 * q], xn[4 * q + 1], xn[4 * q + 2], xn[4 * q + 3]};
        }
        if (layer == 0) {
            {
                bf16_t* ob = (bf16_t*)p.out + (size_t)tok * 1024 + lane * 16; uint4 w;
                w.x = pack2(xn[0], xn[1]); w.y = pack2(xn[2], xn[3]); w.z = pack2(xn[4], xn[5]); w.w = pack2(xn[6], xn[7]); *(uint4*)ob = w;
                w.x = pack2(xn[8], xn[9]); w.y = pack2(xn[10], xn[11]); w.z = pack2(xn[12], xn[13]); w.w = pack2(xn[14], xn[15]); *(uint4*)(ob + 8) = w;
            }
            ss = wave_sum(ss);
            const float rstd = rsqrtf(ss * (1.f / 1024.f) + 1e-6f);
            const float* sh = modn + (size_t)b * 6144 + lane * 16;
            const float* sc = sh + 1024;
            float h[16];
#pragma unroll
            for (int j = 0; j < 16; ++j) h[j] = xn[j] * rstd * gnx[lane * 16 + j] * (1.f + sc[j]) + sh[j];
            uint4 w;
            w.x = pack2(h[0], h[1]); w.y = pack2(h[2], h[3]); w.z = pack2(h[4], h[5]); w.w = pack2(h[6], h[7]);
            *(uint4*)(Hb + (size_t)tok * 1024 + lane * 16) = w;
            w.x = pack2(h[8], h[9]); w.y = pack2(h[10], h[11]); w.z = pack2(h[12], h[13]); w.w = pack2(h[14], h[15]);
            *(uint4*)(Hb + (size_t)tok * 1024 + lane * 16 + 8) = w;
            const float s8 = F8_ACT_SCALE;
            *(uint4*)(p.ws + OFF_H8 + (size_t)tok * 1024 + lane * 16) = make_uint4(pack4_fp8(h[0] * s8, h[1] * s8, h[2] * s8, h[3] * s8), pack4_fp8(h[4] * s8, h[5] * s8, h[6] * s8, h[7] * s8),
                                                                                   pack4_fp8(h[8] * s8, h[9] * s8, h[10] * s8, h[11] * s8), pack4_fp8(h[12] * s8, h[13] * s8, h[14] * s8, h[15] * s8));
        }
    }
}

typedef short v4i16_t __attribute__((ext_vector_type(4)));
DEV v4i16_t lds_tr(const bf16_t* ptr) { return __builtin_amdgcn_ds_read_tr16_b64_v4i16((LAS v4i16_t*)ptr); }

DEV void prep_hgrn(const Params& p, int layer, int u, char* lds, int tid, uint4 rf0, uint4 rf1, uint4 rq0, uint4 rq1) {
    float* LF = (float*)lds;
    float* OFFS = LF + 64 * 128;
    bf16_t* P = (bf16_t*)(p.ws + OFF_PROJ);
    const int bh = u >> 5, c = u & 31, b = bh >> 2, h = bh & 3;
    const int row0 = tid >> 4, col0 = (tid & 15) * 8;
    bf16_t* gb = P + ((size_t)b * SEQ + c * 64 + row0) * DIN + h * 128 + col0;
    float kk[2][8], qq[2][8];
    float lbv[8];
#pragma unroll
    for (int j = 0; j < 8; ++j) { lbv[j] = 0.f; if (layer == 1) { const float p0 = p.in[I_HLB][h * 128 + col0 + j], p1 = p.in[I_HLB][512 + h * 128 + col0 + j]; lbv[j] = 1.f / (1.f + __expf(p0 - p1)); } }
    lds_barrier();
#pragma unroll
    for (int i = 0; i < 2; ++i) {
        const int row = row0 + 32 * i;
        float z[8], qv[8], lf[8];
        unpack8(i == 0 ? rf0 : rf1, z); unpack8(i == 0 ? rq0 : rq1, qv);
#pragma unroll
        for (int j = 0; j < 8; ++j) {
            const float lb = lbv[j];
            const float sg = fsigmoid(z[j]);
            lf[j] = __logf(lb + (1.f - lb) * sg);
            kk[i][j] = (1.f - lb) * (1.f - sg);
            qq[i][j] = fsilu(qv[j]);
        }
        *(f32x4*)&LF[row * 128 + col0] = (f32x4){lf[0], lf[1], lf[2], lf[3]};
        *(f32x4*)&LF[row * 128 + col0 + 4] = (f32x4){lf[4], lf[5], lf[6], lf[7]};
    }
    lds_barrier();
    {
        const int d = tid & 127, part = tid >> 7;
        float v[16];
#pragma unroll
        for (int t = 0; t < 16; ++t) v[t] = LF[(part * 16 + t) * 128 + d];
#pragma unroll
        for (int t = 1; t < 16; ++t) v[t] += v[t - 1];
#pragma unroll
        for (int t = 0; t < 16; ++t) LF[(part * 16 + t) * 128 + d] = v[t];
        OFFS[part * 128 + d] = v[15];
    }
    lds_barrier();
#pragma unroll
    for (int i = 0; i < 2; ++i) {
        const int row = row0 + 32 * i, part = row >> 4;
        float qm[8], km[8];
#pragma unroll
        for (int j = 0; j < 8; ++j) {
            const int d = col0 + j;
            const float o0 = OFFS[d], o1 = OFFS[128 + d], o2 = OFFS[256 + d];
            const float off = (part > 0 ? o0 : 0.f) + (part > 1 ? o1 : 0.f) + (part > 2 ? o2 : 0.f);
            const float At = LF[row * 128 + d] + off, Am = LF[31 * 128 + d] + o0;
            qm[j] = qq[i][j] * __expf(At - Am);
            km[j] = kk[i][j] * __expf(fminf(Am - At, 60.f));
        }
        uint4 w; w.x = pack2(qm[0], qm[1]); w.y = pack2(qm[2], qm[3]); w.z = pack2(qm[4], qm[5]); w.w = pack2(qm[6], qm[7]);
        *(uint4*)(gb + (size_t)(32 * i) * DIN + C_HQ) = w;
        w.x = pack2(km[0], km[1]); w.y = pack2(km[2], km[3]); w.z = pack2(km[4], km[5]); w.w = pack2(km[6], km[7]);
        *(uint4*)(gb + (size_t)(32 * i) * DIN + C_HF) = w;
    }
    if (tid < 128) {
        const float o0 = OFFS[tid], o1 = OFFS[128 + tid], o2 = OFFS[256 + tid];
        const float Am = LF[31 * 128 + tid] + o0, Ac = LF[63 * 128 + tid] + o0 + o1 + o2;
        float* ev = (float*)(p.ws + OFF_EVBUF) + (size_t)u * 384;
        ev[tid] = __expf(Am); ev[128 + tid] = __expf(Ac); ev[256 + tid] = __expf(Ac - Am);
    }
}

DEV void prep_mlstm(const Params& p, int layer, int u, char* lds, int tid, uint4 rr0, uint4 rr1, uint4 rr2, float gmi, float gmf) {
    bf16_t* RAW = (bf16_t*)lds;
    float* EQ = (float*)(RAW + 67 * 128 + 64);
    float* EW = EQ + 64;
    float* CW = EW + 64;
    const int lane = tid & 63, wid = tid >> 6;
    const int bh = u >> 5, c = u & 31, h = bh & 3, t0 = c * 64;
    const int pr = tid >> 4, pc8 = (tid & 15) * 8;
    lds_barrier();
    *(uint4*)&RAW[pr * 128 + pc8] = rr0;
    *(uint4*)&RAW[(pr + 32) * 128 + pc8] = rr1;
    if (tid < 48) *(uint4*)&RAW[(pr + 64) * 128 + pc8] = rr2;
    {
        const int j = tid >> 7, cc = tid & 127;
        const int ch = (cc < 64) ? (h * 64 + cc) : (256 + h * 64 + (cc - 64));
        CW[j * 128 + cc] = p.in[I_MCONV][(size_t)layer * 4 * 512 + j * 512 + ch];
    }
    if (wid == 0) {
        const float ip = gmi + p.in[I_MBI][layer * 4 + h];
        float bc = logsigmoid_f(gmf + p.in[I_MBF][layer * 4 + h]);
#pragma unroll
        for (int o = 1; o < 64; o <<= 1) { const float n = sup(bc, o); if (lane >= o) bc += n; }
        const float bcC = sfrom(bc, 63);
        const float eq = __expf(bc), ew = __expf(bcC - bc + ip);
        EQ[lane] = eq; EW[lane] = ew;
        *(f32x4*)((float*)(p.ws + OFF_GBUF) + ((size_t)bh * SEQ + t0 + lane) * 4) = (f32x4){bc, ip, eq, ew};
        if (lane == 0) ((float*)(p.ws + OFF_ECBUF))[u] = __expf(bcC);
    }
    lds_barrier();
    bf16_t* blk = (bf16_t*)(p.ws + OFF_H) + (size_t)u * (4 * 64 * 64);
#pragma unroll 1
    for (int hh = 0; hh < 2; ++hh) {
        const int row = tid >> 3, c8 = (tid & 7) * 16 + hh * 8;
        float a[8];
#pragma unroll
        for (int e = 0; e < 8; ++e) a[e] = 0.f;
#pragma unroll
        for (int j = 0; j < 4; ++j) {
            float x[8];
            unpack8(*(const uint4*)&RAW[(row + j) * 128 + c8], x);
            const f32x4 w0 = *(const f32x4*)&CW[j * 128 + c8], w1 = *(const f32x4*)&CW[j * 128 + c8 + 4];
            a[0] += w0[0] * x[0]; a[1] += w0[1] * x[1]; a[2] += w0[2] * x[2]; a[3] += w0[3] * x[3];
            a[4] += w1[0] * x[4]; a[5] += w1[1] * x[5]; a[6] += w1[2] * x[6]; a[7] += w1[3] * x[7];
        }
        const bool isq = c8 < 64;
        const float sc = isq ? 1.f : 0.125f;
        const float ex = isq ? EQ[row] : EW[row];
        float y[8], ys[8];
#pragma unroll
        for (int e = 0; e < 8; ++e) { y[e] = fsilu(a[e]) * sc; ys[e] = y[e] * ex; }
        bf16_t* d0 = blk + (isq ? 0 : 4096) + row * 64 + (c8 & 63);
        uint4 w;
        w.x = pack2(y[0], y[1]); w.y = pack2(y[2], y[3]); w.z = pack2(y[4], y[5]); w.w = pack2(y[6], y[7]); *(uint4*)d0 = w;
        w.x = pack2(ys[0], ys[1]); w.y = pack2(ys[2], ys[3]); w.z = pack2(ys[4], ys[5]); w.w = pack2(ys[6], ys[7]); *(uint4*)(d0 + 8192) = w;
    }
}

DEV void prep_foxk(const Params& p, int layer, int u, int tid, uint4 kr0, uint4 kr1, uint4 kr2, uint4 kr3) {
    bf16_t* P = (bf16_t*)(p.ws + OFF_PROJ);
    const int bh = u >> 3, rb = u & 7, b = bh >> 3, h = bh & 7;
    const int r = tid >> 3, c8 = (tid & 7) * 8;
    bf16_t* kp = P + ((size_t)b * SEQ + rb * 256 + r) * DIN + C_FK + h * 64 + c8;
    float gk[8];
#pragma unroll
    for (int d = 0; d < 8; ++d) gk[d] = p.in[I_FOXKG][layer * 64 + c8 + d];
#pragma unroll
    for (int i = 0; i < 4; ++i) {
        float kf[8]; unpack8(i == 0 ? kr0 : i == 1 ? kr1 : i == 2 ? kr2 : kr3, kf);
        float ss = 0.f;
#pragma unroll
        for (int d = 0; d < 8; ++d) ss += kf[d] * kf[d];
        ss += sx(ss, 1); ss += sx(ss, 2); ss += sx(ss, 4);
        const float rstd = rsqrtf(ss * (1.f / 64.f) + 1e-6f);
        uint4 w;
        w.x = pack2(kf[0] * rstd * gk[0], kf[1] * rstd * gk[1]); w.y = pack2(kf[2] * rstd * gk[2], kf[3] * rstd * gk[3]);
        w.z = pack2(kf[4] * rstd * gk[4], kf[5] * rstd * gk[5]); w.w = pack2(kf[6] * rstd * gk[6], kf[7] * rstd * gk[7]);
        *(uint4*)(kp + (size_t)(64 * i) * DIN) = w;
    }
}
DEV void prep_foxf(const Params& p, int layer, int bh, char* lds, int tid) {
    float* wsum = (float*)lds;
    const float* GS = (const float*)(p.ws + OFF_GS);
    const int lane = tid & 63, wid = tid >> 6, b = bh >> 3, h = bh & 7;
    const float bfv = p.in[I_FOXBF][layer * 8 + h];
    float v[4]; float loc = 0.f;
#pragma unroll
    for (int i = 0; i < 4; ++i) { const int s = tid * 4 + i; v[i] = logsigmoid_f(GS[((size_t)b * SEQ + s) * 16 + h] + bfv); loc += v[i]; v[i] = loc; }
    float inc = loc;
#pragma unroll
    for (int o = 1; o < 64; o <<= 1) { const float n = sup(inc, o); if (lane >= o) inc += n; }
    lds_barrier();
    if (lane == 63) wsum[wid] = inc;
    lds_barrier();
    float base = inc - loc;
    for (int w = 0; w < wid; ++w) base += wsum[w];
    constexpr float L2E = 1.4426950408889634f;
    *(f32x4*)((float*)(p.ws + OFF_FBUF) + (size_t)bh * SEQ + tid * 4) = (f32x4){-(base + v[0]) * L2E, -(base + v[1]) * L2E, -(base + v[2]) * L2E, -(base + v[3]) * L2E};
}
DEV void phase_prep(const Params& p, int layer, char* lds) {
    const int tid = tid_op(), G = gridDim.x, bid = bid_op();
    const bf16_t* P = (const bf16_t*)(p.ws + OFF_PROJ);
    const float* GS = (const float*)(p.ws + OFF_GS);
    {
        const int row0 = tid >> 4, col0 = (tid & 15) * 8;
        uint4 a0, a1, a2, a3, n0 = make_uint4(0u, 0u, 0u, 0u), n1 = n0, n2 = n0, n3 = n0;
#define HGP_LOAD(r0_, r1_, r2_, r3_, u_) do { const int bh_ = (u_) >> 5, c_ = (u_) & 31; const bf16_t* gb_ = P + ((size_t)(bh_ >> 2) * SEQ + c_ * 64 + row0) * DIN + (bh_ & 3) * 128 + col0; \
            r0_ = *(const uint4*)(gb_ + C_HF); r1_ = *(const uint4*)(gb_ + (size_t)32 * DIN + C_HF); r2_ = *(const uint4*)(gb_ + C_HQ); r3_ = *(const uint4*)(gb_ + (size_t)32 * DIN + C_HQ); } while (0)
        int u = bid;
        if (u < 2048) HGP_LOAD(a0, a1, a2, a3, u);
        for (; u < 2048; u += G) {
            if (u + G < 2048) HGP_LOAD(n0, n1, n2, n3, u + G);
            prep_hgrn(p, layer, u, lds, tid, a0, a1, a2, a3);
            a0 = n0; a1 = n1; a2 = n2; a3 = n3;
        }
#undef HGP_LOAD
    }
    {
        const int pr = tid >> 4, pc8 = (tid & 15) * 8;
        uint4 a0, a1, a2, n0 = make_uint4(0u, 0u, 0u, 0u), n1 = n0, n2 = n0; float g0 = 0.f, g1 = 0.f, m0 = 0.f, m1 = 0.f;
#define MLP_LOAD(r0_, r1_, r2_, gi_, gf_, u_) do { const int bh_ = (u_) >> 5, t0_ = ((u_) & 31) * 64, h_ = bh_ & 3; const bf16_t* rowb_ = P + (size_t)(bh_ >> 2) * SEQ * DIN; \
            const unsigned off_ = (unsigned)pr * DIN + (unsigned)((pc8 < 64) ? (C_MQK + h_ * 64 + pc8) : (C_MQK + 256 + h_ * 64 + (pc8 - 64))); \
            const bf16_t* ub_ = rowb_ + (ptrdiff_t)(t0_ - 3) * DIN; const bool ok_ = (t0_ - 3 + pr >= 0); \
            r0_ = *(const uint4*)(ok_ ? ub_ + off_ : rowb_); if (!ok_) r0_ = make_uint4(0u, 0u, 0u, 0u); \
            r1_ = *(const uint4*)(ub_ + off_ + 32u * DIN); r2_ = *(const uint4*)((tid < 48) ? ub_ + off_ + 64u * DIN : rowb_); \
            const float* gp_ = GS + ((size_t)(bh_ >> 2) * SEQ + t0_ + (tid & 63)) * 16 + 8; gi_ = gp_[h_]; gf_ = gp_[4 + h_]; } while (0)
        int u = bid;
        if (u < 2048) MLP_LOAD(a0, a1, a2, g0, g1, u);
        for (; u < 2048; u += G) {
            if (u + G < 2048) MLP_LOAD(n0, n1, n2, m0, m1, u + G);
            prep_mlstm(p, layer, u, lds, tid, a0, a1, a2, g0, g1);
            a0 = n0; a1 = n1; a2 = n2; g0 = m0; g1 = m1;
        }
#undef MLP_LOAD
    }
    {
        const int r = tid >> 3, c8 = (tid & 7) * 8;
        uint4 a0, a1, a2, a3, n0 = make_uint4(0u, 0u, 0u, 0u), n1 = n0, n2 = n0, n3 = n0;
#define FKP_LOAD(r0_, r1_, r2_, r3_, u_) do { const int bh_ = (u_) >> 3, rb_ = (u_) & 7; const bf16_t* kp_ = P + ((size_t)(bh_ >> 3) * SEQ + rb_ * 256 + r) * DIN + C_FK + (bh_ & 7) * 64 + c8; \
            r0_ = *(const uint4*)kp_; r1_ = *(const uint4*)(kp_ + (size_t)64 * DIN); r2_ = *(const uint4*)(kp_ + (size_t)128 * DIN); r3_ = *(const uint4*)(kp_ + (size_t)192 * DIN); } while (0)
        int u = bid;
        if (u < 1024) FKP_LOAD(a0, a1, a2, a3, u);
        for (; u < 1024; u += G) {
            if (u + G < 1024) FKP_LOAD(n0, n1, n2, n3, u + G);
            prep_foxk(p, layer, u, tid, a0, a1, a2, a3);
            a0 = n0; a1 = n1; a2 = n2; a3 = n3;
        }
#undef FKP_LOAD
    }
    for (int u = (bid + G - 128 % G) % G; u < 128; u += G) prep_foxf(p, layer, u, lds, tid);
}

template <bool DRY = false>
DEV void phase_fox(const Params& p, int layer, char* lds) {
    constexpr int LDK = 72;
    constexpr float LOG2E = 1.4426950408889634f;
    constexpr int BUFB = 2 * 128 * LDK * 2 + 512;
    int* qsh = (int*)(lds + 2 * BUFB);
    bf16_t* P = (bf16_t*)(p.ws + OFF_PROJ);
    const int tid = tid_op(), lane = tid & 63, wid = tid >> 6, qi = lane & 15, g = lane >> 4, tq = qi >> 2, tp = lane & 3;
    int* qctr = (int*)(p.ws + OFF_QCTR) + layer * 64 + (DRY ? 32 : 0);
    const int skey = tid >> 3, sc8 = (tid & 7) * 8;
    for (;;) {
        __syncthreads();
        if (tid == 0) qsh[0] = atomicAdd(qctr, 1);
        __syncthreads();
        const int u = qsh[0];
        if (u >= NB * 8 * 8) break;
        const int qb = 7 - (u / (NB * 8)), bh = u % (NB * 8), b = bh >> 3, h = bh & 7;
        const int q0 = qb * 256, nst = 2 * qb + 2;
        const float* Fg = (const float*)(p.ws + OFF_FBUF) + (size_t)bh * SEQ;
        const int wrow = q0 + wid * 32;
        bf16x8 qf[2][2];
#pragma unroll
        for (int t = 0; t < 2; ++t) {
            const int trow = wrow + 16 * t + qi;
            const bf16_t* qp = P + ((size_t)b * SEQ + trow) * DIN + C_FQ + h * 64 + 8 * g;
            float q[16];
            unpack8(*(const uint4*)qp, q); unpack8(*(const uint4*)(qp + 32), q + 8);
            float ss = 0.f;
#pragma unroll
            for (int d = 0; d < 16; ++d) ss += q[d] * q[d];
            ss += sx(ss, 16); ss += sx(ss, 32);
            const float rstd = rsqrtf(ss * (1.f / 64.f) + 1e-6f) * (0.125f * LOG2E);
            const float* gq = p.in[I_FOXQG] + layer * 64 + 8 * g;
#pragma unroll
            for (int s2 = 0; s2 < 2; ++s2) {
                uint4 w;
                w.x = pack2(q[8 * s2 + 0] * rstd * gq[32 * s2 + 0], q[8 * s2 + 1] * rstd * gq[32 * s2 + 1]);
                w.y = pack2(q[8 * s2 + 2] * rstd * gq[32 * s2 + 2], q[8 * s2 + 3] * rstd * gq[32 * s2 + 3]);
                w.z = pack2(q[8 * s2 + 4] * rstd * gq[32 * s2 + 4], q[8 * s2 + 5] * rstd * gq[32 * s2 + 5]);
                w.w = pack2(q[8 * s2 + 6] * rstd * gq[32 * s2 + 6], q[8 * s2 + 7] * rstd * gq[32 * s2 + 7]);
                qf[t][s2] = __builtin_bit_cast(bf16x8, w);
            }
        }
        const bf16_t* kvp = P + ((size_t)b * SEQ + skey) * DIN + h * 64 + sc8;
        uint4 kA0, kA1, vA0, vA1; float fA = 0.f;
#define FOX_LOAD(K0, K1, V0, V1, FF, st_) do { const bf16_t* np_ = kvp + (size_t)(st_) * 128 * DIN; \
            K0 = *(const uint4*)(np_ + C_FK); K1 = *(const uint4*)(np_ + (size_t)64 * DIN + C_FK); V0 = *(const uint4*)(np_ + C_FV); V1 = *(const uint4*)(np_ + (size_t)64 * DIN + C_FV); \
            if (tid < 128) FF = Fg[(st_) * 128 + tid]; } while (0)
        FOX_LOAD(kA0, kA1, vA0, vA1, fA, 0);
        float m[2] = {-INFINITY, -INFINITY}, lsum[2] = {0.f, 0.f};
        f32x4 oacc[2][4];
#pragma unroll
        for (int t = 0; t < 2; ++t)
#pragma unroll
            for (int dt = 0; dt < 4; ++dt) oacc[t][dt] = (f32x4){0.f, 0.f, 0.f, 0.f};
#define FOX_COMPUTE(st) do { \
            const bf16_t* Ks = (const bf16_t*)(lds + ((st) & 1) * BUFB); const bf16_t* Vs = Ks + 128 * LDK; const float* Fs = (const float*)(Vs + 128 * LDK); \
            if ((st) * 128 <= wrow + 31) {                         \
                f32x4 sacc[2][8]; \
                _Pragma("unroll") for (int n = 0; n < 8; ++n) { \
                    sacc[0][n] = *(const f32x4*)&Fs[n * 16 + 4 * g]; sacc[1][n] = sacc[0][n];            \
                    _Pragma("unroll") for (int s2 = 0; s2 < 2; ++s2) { \
                        const bf16x8 kfr = *(const bf16x8*)&Ks[(n * 16 + qi) * LDK + 32 * s2 + 8 * g]; \
                        sacc[0][n] = __builtin_amdgcn_mfma_f32_16x16x32_bf16(kfr, qf[0][s2], sacc[0][n], 0, 0, 0); \
                        sacc[1][n] = __builtin_amdgcn_mfma_f32_16x16x32_bf16(kfr, qf[1][s2], sacc[1][n], 0, 0, 0); \
                    } \
                } \
                const bool diag = ((st) * 128 + 127 > wrow);         \
                bf16x8 pf[2][4]; \
                _Pragma("unroll") for (int t = 0; t < 2; ++t) { \
                    const int trow = wrow + 16 * t + qi; \
                    float mx = -INFINITY; \
                    _Pragma("unroll") for (int n = 0; n < 8; ++n) { \
                        _Pragma("unroll") for (int j = 0; j < 4; ++j) { \
                            float v = sacc[t][n][j]; \
                            if (diag) v = ((st) * 128 + n * 16 + 4 * g + j <= trow) ? v : -INFINITY; \
                            sacc[t][n][j] = v; mx = fmaxf(mx, v); \
                        } \
                    } \
                    mx = fmaxf(mx, sx(mx, 16)); mx = fmaxf(mx, sx(mx, 32)); \
                    const float mn = fmaxf(m[t], mx); \
                    const float corr = __builtin_amdgcn_exp2f(m[t] - mn); \
                    m[t] = mn; \
                    float ps = 0.f; \
                    _Pragma("unroll") for (int n = 0; n < 8; ++n) \
                        _Pragma("unroll") for (int j = 0; j < 4; ++j) { const float e = __builtin_amdgcn_exp2f(sacc[t][n][j] - mn); sacc[t][n][j] = e; ps += e; } \
                    lsum[t] = lsum[t] * corr + ps; \
                    _Pragma("unroll") for (int dt = 0; dt < 4; ++dt) { oacc[t][dt][0] *= corr; oacc[t][dt][1] *= corr; oacc[t][dt][2] *= corr; oacc[t][dt][3] *= corr; } \
                    _Pragma("unroll") for (int ks = 0; ks < 4; ++ks) { \
                        uint4 w; \
                        w.x = pack2(sacc[t][2 * ks][0], sacc[t][2 * ks][1]); w.y = pack2(sacc[t][2 * ks][2], sacc[t][2 * ks][3]); \
                        w.z = pack2(sacc[t][2 * ks + 1][0], sacc[t][2 * ks + 1][1]); w.w = pack2(sacc[t][2 * ks + 1][2], sacc[t][2 * ks + 1][3]); \
                        pf[t][ks] = __builtin_bit_cast(bf16x8, w); \
                    } \
                } \
                _Pragma("unroll") for (int ks = 0; ks < 4; ++ks) \
                    _Pragma("unroll") for (int dt = 0; dt < 4; ++dt) { \
                        const v4i16_t lo = lds_tr(&Vs[((2 * ks) * 16 + 4 * g + tq) * LDK + dt * 16 + 4 * tp]); \
                        const v4i16_t hi = lds_tr(&Vs[((2 * ks + 1) * 16 + 4 * g + tq) * LDK + dt * 16 + 4 * tp]); \
                        const bf16x8 vfr = (bf16x8){lo[0], lo[1], lo[2], lo[3], hi[0], hi[1], hi[2], hi[3]}; \
                        oacc[0][dt] = __builtin_amdgcn_mfma_f32_16x16x32_bf16(vfr, pf[0][ks], oacc[0][dt], 0, 0, 0); \
                        oacc[1][dt] = __builtin_amdgcn_mfma_f32_16x16x32_bf16(vfr, pf[1][ks], oacc[1][dt], 0, 0, 0); \
                    } \
            } \
        } while (0)
#define FOX_STORE(K0, K1, V0, V1, FF, st_) do { bf16_t* Kw = (bf16_t*)(lds + ((st_) & 1) * BUFB); bf16_t* Vw = Kw + 128 * LDK; \
            *(uint4*)&Kw[skey * LDK + sc8] = K0; *(uint4*)&Kw[(skey + 64) * LDK + sc8] = K1; \
            *(uint4*)&Vw[skey * LDK + sc8] = V0; *(uint4*)&Vw[(skey + 64) * LDK + sc8] = V1; \
            if (tid < 128) ((float*)(Vw + 128 * LDK))[tid] = FF; } while (0)
        FOX_STORE(kA0, kA1, vA0, vA1, fA, 0);
        if (1 < nst) FOX_LOAD(kA0, kA1, vA0, vA1, fA, 1);
        __syncthreads();
#pragma unroll 1
        for (int st = 0; st < nst; ++st) {
            if (st + 1 < nst) { FOX_STORE(kA0, kA1, vA0, vA1, fA, st + 1); if (st + 2 < nst) FOX_LOAD(kA0, kA1, vA0, vA1, fA, st + 2); }
            FOX_COMPUTE(st);
            __syncthreads();
        }
#undef FOX_STORE
#undef FOX_LOAD
#undef FOX_COMPUTE
#pragma unroll
        for (int t = 0; t < 2; ++t) {
            float l = lsum[t];
            l += sx(l, 16); l += sx(l, 32);
            const float il = 1.f / l;
            const int trow = wrow + 16 * t + qi;
            bf16_t* op = DRY ? (bf16_t*)(p.ws + OFF_WIN) + ((size_t)b * SEQ + trow) * 128 + (h & 1) * 64 + 4 * g : P + ((size_t)b * SEQ + trow) * DIN + C_FQ + h * 64 + 4 * g;
#pragma unroll
            for (int dt = 0; dt < 4; ++dt) {
                uint2 o; o.x = pack2(oacc[t][dt][0] * il, oacc[t][dt][1] * il); o.y = pack2(oacc[t][dt][2] * il, oacc[t][dt][3] * il);
                *(uint2*)(op + dt * 16) = o;
            }
        }
    }
}

template <bool DRY = false>
DEV void phase_mlstm(const Params& p, int layer, char* lds) {
    constexpr int LDQ = 72, LDV = 136;
    bf16_t* Qs = (bf16_t*)lds;
    bf16_t* Ks = Qs + 64 * LDQ;
    bf16_t* QD = Ks + 64 * LDQ;
    bf16_t* KW = QD + 64 * LDQ;
    bf16_t* VV = KW + 64 * LDQ;
    bf16_t* PP = VV + 64 * LDV;
    float* GT = (float*)(PP + 64 * LDQ);
    float* ECs = GT + 256;
    float* OS = ECs + 4;
    bf16_t* P = (bf16_t*)(p.ws + OFF_PROJ);
    const int tid = tid_op(), lane = tid & 63, wid = tid >> 6, qi = lane & 15, g = lane >> 4, tq = qi >> 2, tp = lane & 3;
    const int row0 = tid >> 4, col0 = (tid & 15) * 8;
    const int prow = tid >> 3, pch = (tid & 7) * 8;
    const short one_bf = (qi == 0) ? (short)0x3F80 : (short)0;
    const bf16x8 ones = (bf16x8){one_bf, one_bf, one_bf, one_bf, one_bf, one_bf, one_bf, one_bf};
    for (int u = bid_op(); u < NB * 4; u += gridDim.x) {
        const int b = u >> 2, h = u & 3;
        lds_barrier();
        for (int i = tid; i < 64 * LDQ / 2; i += 512) ((unsigned*)PP)[i] = 0u;
        float gn[8];
#pragma unroll
        for (int j = 0; j < 8; ++j) gn[j] = p.in[I_MNG][layer * 512 + h * 128 + col0 + j];
        f32x4 Cst[4], Nst[4];
#pragma unroll
        for (int dt = 0; dt < 4; ++dt) { Cst[dt] = (f32x4){0.f, 0.f, 0.f, 0.f}; Nst[dt] = (f32x4){0.f, 0.f, 0.f, 0.f}; }
        const bf16_t* rowb = P + (size_t)b * SEQ * DIN;
        const bf16_t* mlb = (const bf16_t*)(p.ws + OFF_H) + (size_t)u * 32 * (4 * 64 * 64);
        const float* gbuf = (const float*)(p.ws + OFF_GBUF) + (size_t)u * SEQ * 4;
        const float* ecb = (const float*)(p.ws + OFF_ECBUF) + u * 32;
        const unsigned off_v = (unsigned)row0 * DIN + (unsigned)(C_MV + h * 128 + col0);
        const unsigned off_o = (unsigned)row0 * DIN + (unsigned)(C_MO + h * 128 + col0);
        const unsigned off_m = (unsigned)tid * 8u;
        uint4 m0, m1, m2, m3, rv0, rv1, rg0, rg1; f32x4 gt4 = (f32x4){0.f, 0.f, 0.f, 0.f}; float ecv = 0.f;
#define ML_PREFETCH(c_) do { const int c__ = (c_); const bf16_t* mb_ = mlb + (size_t)c__ * (4 * 64 * 64); const bf16_t* uv_ = rowb + (size_t)(c__ * 64) * DIN; \
            m0 = *(const uint4*)(mb_ + off_m); m1 = *(const uint4*)(mb_ + 4096 + off_m); m2 = *(const uint4*)(mb_ + 8192 + off_m); m3 = *(const uint4*)(mb_ + 12288 + off_m); \
            rv0 = *(const uint4*)(uv_ + off_v); rv1 = *(const uint4*)(uv_ + off_v + 32u * DIN); rg0 = *(const uint4*)(uv_ + off_o); rg1 = *(const uint4*)(uv_ + off_o + 32u * DIN); \
            if (tid < 64) gt4 = *(const f32x4*)(gbuf + (size_t)(c__ * 64 + tid) * 4); ecv = ecb[c__]; } while (0)
        ML_PREFETCH(0);
#pragma unroll 1
        for (int c = 0; c < SEQ / 64; ++c) {
            *(uint4*)&Qs[prow * LDQ + pch] = m0; *(uint4*)&Ks[prow * LDQ + pch] = m1; *(uint4*)&QD[prow * LDQ + pch] = m2; *(uint4*)&KW[prow * LDQ + pch] = m3;
            *(uint4*)&VV[row0 * LDV + col0] = rv0; *(uint4*)&VV[(row0 + 32) * LDV + col0] = rv1;
            if (tid < 64) *(f32x4*)&GT[tid * 4] = gt4;
            const float ec = ecv;
            const uint4 g0 = rg0, g1 = rg1;
            if (c + 1 < SEQ / 64) ML_PREFETCH(c + 1);
            lds_barrier();
#pragma unroll
            for (int rep = 0; rep < 2; ++rep) {
                const int idx = wid + 8 * rep;
                if (idx < 10) {
                    const int tt = (idx >= 6) ? 3 : (idx >= 3) ? 2 : (idx >= 1) ? 1 : 0, st = idx - tt * (tt + 1) / 2;
                    f32x4 acc = (f32x4){0.f, 0.f, 0.f, 0.f};
#pragma unroll
                    for (int ks = 0; ks < 2; ++ks) {
                        const bf16x8 a = *(const bf16x8*)&Ks[(st * 16 + qi) * LDQ + 32 * ks + 8 * g];
                        const bf16x8 bq = *(const bf16x8*)&Qs[(tt * 16 + qi) * LDQ + 32 * ks + 8 * g];
                        acc = __builtin_amdgcn_mfma_f32_16x16x32_bf16(a, bq, acc, 0, 0, 0);
                    }
                    const float bt = GT[(tt * 16 + qi) * 4];
#pragma unroll
                    for (int j = 0; j < 4; ++j) {
                        const f32x4 gs = *(const f32x4*)&GT[(st * 16 + 4 * g + j) * 4];
                        const bool valid = (st < tt) || (4 * g + j <= qi);
                        acc[j] = valid ? acc[j] * __expf(bt - gs[0] + gs[1]) : 0.f;
                    }
                    uint2 w; w.x = pack2(acc[0], acc[1]); w.y = pack2(acc[2], acc[3]);
                    *(uint2*)&PP[(tt * 16 + qi) * LDQ + st * 16 + 4 * g] = w;
                }
            }
            f32x4 o[4], dn[4];
            {
                bf16x8 cp[2], np[2];
#pragma unroll
                for (int k2 = 0; k2 < 2; ++k2) {
                    uint4 w;
                    w.x = pack2(Cst[2 * k2][0], Cst[2 * k2][1]); w.y = pack2(Cst[2 * k2][2], Cst[2 * k2][3]);
                    w.z = pack2(Cst[2 * k2 + 1][0], Cst[2 * k2 + 1][1]); w.w = pack2(Cst[2 * k2 + 1][2], Cst[2 * k2 + 1][3]);
                    cp[k2] = __builtin_bit_cast(bf16x8, w);
                    w.x = pack2(Nst[2 * k2][0], Nst[2 * k2][1]); w.y = pack2(Nst[2 * k2][2], Nst[2 * k2][3]);
                    w.z = pack2(Nst[2 * k2 + 1][0], Nst[2 * k2 + 1][1]); w.w = pack2(Nst[2 * k2 + 1][2], Nst[2 * k2 + 1][3]);
                    np[k2] = __builtin_bit_cast(bf16x8, w);
                }
#pragma unroll
                for (int tt = 0; tt < 4; ++tt) {
                    o[tt] = (f32x4){0.f, 0.f, 0.f, 0.f}; dn[tt] = (f32x4){0.f, 0.f, 0.f, 0.f};
#pragma unroll
                    for (int k2 = 0; k2 < 2; ++k2) {
                        const uint2 a0 = *(const uint2*)&QD[(tt * 16 + qi) * LDQ + (2 * k2) * 16 + 4 * g];
                        const uint2 a1 = *(const uint2*)&QD[(tt * 16 + qi) * LDQ + (2 * k2 + 1) * 16 + 4 * g];
                        const bf16x8 af = __builtin_bit_cast(bf16x8, make_uint4(a0.x, a0.y, a1.x, a1.y));
                        o[tt] = __builtin_amdgcn_mfma_f32_16x16x32_bf16(af, cp[k2], o[tt], 0, 0, 0);
                        dn[tt] = __builtin_amdgcn_mfma_f32_16x16x32_bf16(af, np[k2], dn[tt], 0, 0, 0);
                    }
                }
            }
            bf16x8 vf[2];
#pragma unroll
            for (int ks = 0; ks < 2; ++ks) {
                const v4i16_t lo = lds_tr(&VV[(32 * ks + 8 * g + tq) * LDV + 16 * wid + 4 * tp]);
                const v4i16_t hi = lds_tr(&VV[(32 * ks + 8 * g + 4 + tq) * LDV + 16 * wid + 4 * tp]);
                vf[ks] = (bf16x8){lo[0], lo[1], lo[2], lo[3], hi[0], hi[1], hi[2], hi[3]};
            }
#pragma unroll
            for (int dt = 0; dt < 4; ++dt) {
#pragma unroll
                for (int j = 0; j < 4; ++j) { Cst[dt][j] *= ec; Nst[dt][j] *= ec; }
#pragma unroll
                for (int ks = 0; ks < 2; ++ks) {
                    const v4i16_t lo = lds_tr(&KW[(32 * ks + 8 * g + tq) * LDQ + dt * 16 + 4 * tp]);
                    const v4i16_t hi = lds_tr(&KW[(32 * ks + 8 * g + 4 + tq) * LDQ + dt * 16 + 4 * tp]);
                    const bf16x8 kfr = (bf16x8){lo[0], lo[1], lo[2], lo[3], hi[0], hi[1], hi[2], hi[3]};
                    Cst[dt] = __builtin_amdgcn_mfma_f32_16x16x32_bf16(kfr, vf[ks], Cst[dt], 0, 0, 0);
                    Nst[dt] = __builtin_amdgcn_mfma_f32_16x16x32_bf16(kfr, ones, Nst[dt], 0, 0, 0);
                }
            }
            lds_barrier();
#pragma unroll
            for (int tt = 0; tt < 4; ++tt)
#pragma unroll
                for (int ks = 0; ks < 2; ++ks)
                    if (ks <= (tt >> 1)) {
                        const bf16x8 a = *(const bf16x8*)&PP[(tt * 16 + qi) * LDQ + 32 * ks + 8 * g];
                        o[tt] = __builtin_amdgcn_mfma_f32_16x16x32_bf16(a, vf[ks], o[tt], 0, 0, 0);
                        dn[tt] = __builtin_amdgcn_mfma_f32_16x16x32_bf16(a, ones, dn[tt], 0, 0, 0);
                    }
#pragma unroll
            for (int tt = 0; tt < 4; ++tt)
#pragma unroll
                for (int j = 0; j < 4; ++j) {
                    const float den = sfrom(dn[tt][j], lane & 48);
                    OS[(tt * 16 + 4 * g + j) * 128 + 16 * wid + qi] = o[tt][j] * __builtin_amdgcn_rcpf(fmaxf(fabsf(den), 1.f));
                }
            lds_barrier();
            bf16_t* uo = (bf16_t*)rowb + (size_t)(c * 64) * DIN;
#pragma unroll
            for (int i = 0; i < 2; ++i) {
                const int row = row0 + 32 * i;
                const f32x4 oa = *(const f32x4*)&OS[row * 128 + col0], ob = *(const f32x4*)&OS[row * 128 + col0 + 4];
                float ss = oa[0] * oa[0] + oa[1] * oa[1] + oa[2] * oa[2] + oa[3] * oa[3] + ob[0] * ob[0] + ob[1] * ob[1] + ob[2] * ob[2] + ob[3] * ob[3];
                ss += sx(ss, 1); ss += sx(ss, 2); ss += sx(ss, 4); ss += sx(ss, 8);
                const float rstd = rsqrtf(ss * (1.f / 128.f) + 1e-6f);
                float gg[8]; unpack8((i == 0) ? g0 : g1, gg);
#pragma unroll
                for (int j = 0; j < 8; ++j) gg[j] = fsigmoid(gg[j]) * gn[j];
                uint4 w;
                w.x = pack2(oa[0] * rstd * gg[0], oa[1] * rstd * gg[1]); w.y = pack2(oa[2] * rstd * gg[2], oa[3] * rstd * gg[3]);
                w.z = pack2(ob[0] * rstd * gg[4], ob[1] * rstd * gg[5]); w.w = pack2(ob[2] * rstd * gg[6], ob[3] * rstd * gg[7]);
                if constexpr (DRY) *(uint4*)((bf16_t*)(p.ws + OFF_WIN) + ((size_t)b * SEQ + c * 64 + row) * 128 + col0) = w;
                else *(uint4*)(uo + off_o + (unsigned)(32 * i) * DIN) = w;
            }
        }
#undef ML_PREFETCH
    }
}

template <bool DRY = false>
DEV void phase_hgrn(const Params& p, int layer, char* lds) {
    constexpr int LDA = 136, LDP = 72;
    bf16_t* QM = (bf16_t*)lds;
    bf16_t* KM = QM + 64 * LDA;
    bf16_t* VV = KM + 64 * LDA;
    bf16_t* PP = VV + 64 * LDA;
    float* EM = (float*)(PP + 64 * LDP);
    float* EC = EM + 128;
    float* EK = EC + 128;
    float* OS = EK + 128;
    bf16_t* P = (bf16_t*)(p.ws + OFF_PROJ);
    const int tid = tid_op(), lane = tid & 63, wid = tid >> 6, qi = lane & 15, g = lane >> 4, tq = qi >> 2, tp = lane & 3;
    const int row0 = tid >> 4, col0 = (tid & 15) * 8;
    for (int u = (bid_op() + (int)gridDim.x - 64) % (int)gridDim.x; u < NB * 4; u += gridDim.x) {
        const int b = u >> 2, h = u & 3;
        float gn[8];
#pragma unroll
        for (int j = 0; j < 8; ++j) gn[j] = p.in[I_HNG][layer * 512 + h * 128 + col0 + j];
        lds_barrier();
        for (int i = tid; i < 64 * LDP / 2; i += 512) ((unsigned*)PP)[i] = 0u;
        f32x4 S[8];
#pragma unroll
        for (int dt = 0; dt < 8; ++dt) S[dt] = (f32x4){0.f, 0.f, 0.f, 0.f};
        bf16_t* gbase = P + ((size_t)b * SEQ + row0) * DIN + h * 128 + col0;
        const float* evb = (const float*)(p.ws + OFF_EVBUF) + (size_t)u * 32 * 384;
        uint4 q0r, q1r, k0r, k1r, v0r, v1r, g0r, g1r; f32x4 ev4 = (f32x4){0.f, 0.f, 0.f, 0.f};
#define HG_PREFETCH(c_) do { const bf16_t* rp_ = gbase + (size_t)((c_) * 64) * DIN; \
            q0r = *(const uint4*)(rp_ + C_HQ); q1r = *(const uint4*)(rp_ + (size_t)32 * DIN + C_HQ); k0r = *(const uint4*)(rp_ + C_HF); k1r = *(const uint4*)(rp_ + (size_t)32 * DIN + C_HF); \
            v0r = *(const uint4*)(rp_ + C_HI); v1r = *(const uint4*)(rp_ + (size_t)32 * DIN + C_HI); g0r = *(const uint4*)(rp_ + C_HG); g1r = *(const uint4*)(rp_ + (size_t)32 * DIN + C_HG); \
            if (tid < 96) ev4 = *(const f32x4*)(evb + (size_t)(c_) * 384 + tid * 4); } while (0)
        HG_PREFETCH(0);
#pragma unroll 1
        for (int c = 0; c < SEQ / 64; ++c) {
            *(uint4*)&QM[row0 * LDA + col0] = q0r; *(uint4*)&QM[(row0 + 32) * LDA + col0] = q1r;
            *(uint4*)&KM[row0 * LDA + col0] = k0r; *(uint4*)&KM[(row0 + 32) * LDA + col0] = k1r;
            *(uint4*)&VV[row0 * LDA + col0] = v0r; *(uint4*)&VV[(row0 + 32) * LDA + col0] = v1r;
            if (tid < 96) *(f32x4*)&EM[tid * 4] = ev4;
            const uint4 rg0 = g0r, rg1 = g1r;
            if (c + 1 < SEQ / 64) HG_PREFETCH(c + 1);
            lds_barrier();
#pragma unroll
            for (int rep = 0; rep < 2; ++rep) {
                const int idx = wid + 8 * rep;
                if (idx < 10) {
                    const int tt = (idx >= 6) ? 3 : (idx >= 3) ? 2 : (idx >= 1) ? 1 : 0, st = idx - tt * (tt + 1) / 2;
                    f32x4 acc = (f32x4){0.f, 0.f, 0.f, 0.f};
#pragma unroll
                    for (int ks = 0; ks < 4; ++ks) {
                        const bf16x8 a = *(const bf16x8*)&KM[(st * 16 + qi) * LDA + 32 * ks + 8 * g];
                        const bf16x8 bq = *(const bf16x8*)&QM[(tt * 16 + qi) * LDA + 32 * ks + 8 * g];
                        acc = __builtin_amdgcn_mfma_f32_16x16x32_bf16(a, bq, acc, 0, 0, 0);
                    }
                    if (tt == st) {
#pragma unroll
                        for (int j = 0; j < 4; ++j) if (4 * g + j > qi) acc[j] = 0.f;
                    }
                    uint2 w; w.x = pack2(acc[0], acc[1]); w.y = pack2(acc[2], acc[3]);
                    *(uint2*)&PP[(tt * 16 + qi) * LDP + st * 16 + 4 * g] = w;
                }
            }
            f32x4 o[4];
            {
                bf16x8 sp[4];
#pragma unroll
                for (int k2 = 0; k2 < 4; ++k2) {
                    const f32x4 e0 = *(const f32x4*)&EM[(2 * k2) * 16 + 4 * g], e1 = *(const f32x4*)&EM[(2 * k2 + 1) * 16 + 4 * g];
                    uint4 w;
                    w.x = pack2(S[2 * k2][0] * e0[0], S[2 * k2][1] * e0[1]); w.y = pack2(S[2 * k2][2] * e0[2], S[2 * k2][3] * e0[3]);
                    w.z = pack2(S[2 * k2 + 1][0] * e1[0], S[2 * k2 + 1][1] * e1[1]); w.w = pack2(S[2 * k2 + 1][2] * e1[2], S[2 * k2 + 1][3] * e1[3]);
                    sp[k2] = __builtin_bit_cast(bf16x8, w);
                }
#pragma unroll
                for (int tt = 0; tt < 4; ++tt) {
                    o[tt] = (f32x4){0.f, 0.f, 0.f, 0.f};
#pragma unroll
                    for (int k2 = 0; k2 < 4; ++k2) {
                        const uint2 a0 = *(const uint2*)&QM[(tt * 16 + qi) * LDA + (2 * k2) * 16 + 4 * g];
                        const uint2 a1 = *(const uint2*)&QM[(tt * 16 + qi) * LDA + (2 * k2 + 1) * 16 + 4 * g];
                        const uint4 w = make_uint4(a0.x, a0.y, a1.x, a1.y);
                        o[tt] = __builtin_amdgcn_mfma_f32_16x16x32_bf16(__builtin_bit_cast(bf16x8, w), sp[k2], o[tt], 0, 0, 0);
                    }
                }
            }
            bf16x8 vf[2];
#pragma unroll
            for (int ks = 0; ks < 2; ++ks) {
                const v4i16_t lo = lds_tr(&VV[(32 * ks + 8 * g + tq) * LDA + 16 * wid + 4 * tp]);
                const v4i16_t hi = lds_tr(&VV[(32 * ks + 8 * g + 4 + tq) * LDA + 16 * wid + 4 * tp]);
                vf[ks] = (bf16x8){lo[0], lo[1], lo[2], lo[3], hi[0], hi[1], hi[2], hi[3]};
            }
#pragma unroll
            for (int dt = 0; dt < 8; ++dt) {
                f32x4 Tacc = (f32x4){0.f, 0.f, 0.f, 0.f};
#pragma unroll
                for (int ks = 0; ks < 2; ++ks) {
                    const v4i16_t lo = lds_tr(&KM[(32 * ks + 8 * g + tq) * LDA + dt * 16 + 4 * tp]);
                    const v4i16_t hi = lds_tr(&KM[(32 * ks + 8 * g + 4 + tq) * LDA + dt * 16 + 4 * tp]);
                    const bf16x8 kfr = (bf16x8){lo[0], lo[1], lo[2], lo[3], hi[0], hi[1], hi[2], hi[3]};
                    Tacc = __builtin_amdgcn_mfma_f32_16x16x32_bf16(kfr, vf[ks], Tacc, 0, 0, 0);
                }
                const f32x4 ec = *(const f32x4*)&EC[dt * 16 + 4 * g], ek = *(const f32x4*)&EK[dt * 16 + 4 * g];
#pragma unroll
                for (int j = 0; j < 4; ++j) S[dt][j] = ec[j] * S[dt][j] + ek[j] * Tacc[j];
            }
            lds_barrier();
#pragma unroll
            for (int tt = 0; tt < 4; ++tt)
#pragma unroll
                for (int ks = 0; ks < 2; ++ks)
                    if (ks <= (tt >> 1)) {
                        const bf16x8 a = *(const bf16x8*)&PP[(tt * 16 + qi) * LDP + 32 * ks + 8 * g];
                        o[tt] = __builtin_amdgcn_mfma_f32_16x16x32_bf16(a, vf[ks], o[tt], 0, 0, 0);
                    }
#pragma unroll
            for (int tt = 0; tt < 4; ++tt)
#pragma unroll
                for (int j = 0; j < 4; ++j) OS[(tt * 16 + 4 * g + j) * 128 + 16 * wid + qi] = o[tt][j];
            lds_barrier();
#pragma unroll
            for (int i = 0; i < 2; ++i) {
                const int row = row0 + 32 * i;
                const f32x4 oa = *(const f32x4*)&OS[row * 128 + col0], ob = *(const f32x4*)&OS[row * 128 + col0 + 4];
                float ss = oa[0] * oa[0] + oa[1] * oa[1] + oa[2] * oa[2] + oa[3] * oa[3] + ob[0] * ob[0] + ob[1] * ob[1] + ob[2] * ob[2] + ob[3] * ob[3];
                ss += sx(ss, 1); ss += sx(ss, 2); ss += sx(ss, 4); ss += sx(ss, 8);
                const float rstd = rsqrtf(ss * (1.f / 128.f) + 1e-6f);
                float gg[8]; unpack8((i == 0) ? rg0 : rg1, gg);
#pragma unroll
                for (int j = 0; j < 8; ++j) gg[j] = fsilu(gg[j]) * gn[j];
                uint4 w;
                w.x = pack2(oa[0] * rstd * gg[0], oa[1] * rstd * gg[1]); w.y = pack2(oa[2] * rstd * gg[2], oa[3] * rstd * gg[3]);
                w.z = pack2(ob[0] * rstd * gg[4], ob[1] * rstd * gg[5]); w.w = pack2(ob[2] * rstd * gg[6], ob[3] * rstd * gg[7]);
                if constexpr (DRY) *(uint4*)((bf16_t*)(p.ws + OFF_WIN) + ((size_t)b * SEQ + c * 64 + row) * 128 + col0) = w;
                else *(uint4*)(gbase + (size_t)(c * 64 + 32 * i) * DIN + C_HG) = w;
            }
        }
#undef HG_PREFETCH
    }
}

#define XB_TMO      128
#define XB_XCNT(j)  (256  + 64 * (j))
#define XB_XSUB(j)  (1280 + 64 * (j))
#define XB_XGEN(j)  (2304 + 64 * (j))
#define XB_TOP      3328
#define XB_TOPGEN   3392
#define XCD_BAR_WORDS 3456
#define XB_SPIN_CAP (1u << 18)
__device__ __forceinline__ unsigned xb_ld(unsigned* p)              { return __hip_atomic_load(p, __ATOMIC_RELAXED, __HIP_MEMORY_SCOPE_AGENT); }
__device__ __forceinline__ unsigned xb_add(unsigned* p, unsigned v) { return __hip_atomic_fetch_add(p, v, __ATOMIC_RELAXED, __HIP_MEMORY_SCOPE_AGENT); }
__device__ __forceinline__ unsigned xb_xcc_id() { return (unsigned)__builtin_amdgcn_s_getreg((3 << 11) | 20) & 0xFu; }
#define XB_SPIN(cond, bar) do { unsigned _sp = 0; while (cond) { __builtin_amdgcn_s_sleep(1); \
    if ((++_sp & 255u) == 0u) { if (xb_ld(&(bar)[XB_TMO])) break; if (_sp > XB_SPIN_CAP) { atomicAdd(&(bar)[XB_TMO], 1u); break; } } } } while (0)
struct XcdBarrier { unsigned* bar; unsigned x; volatile LAS unsigned* st; };
__device__ __forceinline__ XcdBarrier xcd_barrier_post(unsigned* bar, volatile LAS unsigned* st) {
    XcdBarrier b; b.bar = bar; b.x = xb_xcc_id(); b.st = st;
    if (threadIdx.x == 0) (void)xb_add(&bar[XB_XCNT(b.x)], 1u);
    return b;
}
__device__ __forceinline__ void xcd_barrier_complete(unsigned* bar, unsigned x, unsigned& nloc, unsigned& nx) {
    const unsigned G = gridDim.x * gridDim.y * gridDim.z;
    unsigned sum, cnt, mine, sp = 0u;
    for (;;) {
        sum = 0u; cnt = 0u; mine = 0u;
#pragma unroll
        for (unsigned j = 0; j < 16; ++j) { const unsigned c = xb_ld(&bar[XB_XCNT(j)]); sum += c; cnt += (c > 0u) ? 1u : 0u; mine = (j == x) ? c : mine; }
        if (sum == G) break;
        __builtin_amdgcn_s_sleep(1);
        if ((++sp & 255u) == 0u) { if (xb_ld(&bar[XB_TMO])) break; if (sp > XB_SPIN_CAP) { atomicAdd(&bar[XB_TMO], 1u); break; } }
    }
    nloc = mine > 0u ? mine : 1u; nx = cnt > 0u ? cnt : 1u;
}
__device__ __forceinline__ void xcd_barrier(const XcdBarrier& b) {
    asm volatile("s_waitcnt vmcnt(0)" ::: "memory");
    __syncthreads();
    if (threadIdx.x == 0) {
        unsigned* bar = b.bar;
        __builtin_amdgcn_s_waitcnt(0);
        unsigned nloc = b.st[0], nx = b.st[1];
        if (nloc == 0u) { xcd_barrier_complete(bar, b.x, nloc, nx); b.st[0] = nloc; b.st[1] = nx; }
        const unsigned old = xb_add(&bar[XB_XSUB(b.x)], 1u);
        const unsigned gen = old / nloc;
        if (old + 1u == (gen + 1u) * nloc) {
            __builtin_amdgcn_fence(__ATOMIC_RELEASE, "agent");
            asm volatile("s_waitcnt vmcnt(0)" ::: "memory");
            const unsigned og = xb_add(&bar[XB_TOP], 1u);
            const unsigned tg = og / nx;
            if (og + 1u == (tg + 1u) * nx) xb_add(&bar[XB_TOPGEN], 1u);
            else XB_SPIN(xb_ld(&bar[XB_TOPGEN]) == tg, bar);
            __builtin_amdgcn_fence(__ATOMIC_ACQUIRE, "agent");
            xb_add(&bar[XB_XGEN(b.x)], 1u);
            asm volatile("s_waitcnt vmcnt(0)" ::: "memory");
        } else {
            XB_SPIN(xb_ld(&bar[XB_XGEN(b.x)]) == gen, bar);
            __builtin_amdgcn_fence(__ATOMIC_ACQUIRE, "agent");
            asm volatile("s_waitcnt vmcnt(0)" ::: "memory");
        }
    }
    __syncthreads();
}

constexpr int LDS_BYTES = 131072 + 16 + TL_PAD * 4 + 2 * 256 * 4;
__global__ void __launch_bounds__(512, 2) mega_fwd(Params p) {
    extern __shared__ __attribute__((aligned(16))) char lds_all[];
    char* lds = lds_all + 16;
    if (threadIdx.x == 0) *(uint4*)lds_all = make_uint4(0u, 0u, 0u, 0u);
    __syncthreads();
    (void)xcd_barrier_post((unsigned*)(p.ws + OFF_CTL), (volatile LAS unsigned*)lds_all);
#define GRID_BAR() do { XcdBarrier b_; b_.bar = (unsigned*)(p.ws + OFF_CTL); b_.x = xb_xcc_id(); b_.st = (volatile LAS unsigned*)lds_all; xcd_barrier(b_); } while (0)
    bf16_t* Hb = (bf16_t*)(p.ws + OFF_H);
    phase_convert_mix(p, 0, lds);
    phase_ada(p, lds);
    GRID_BAR();
    phase_norm(p, p.in[I_X], 0, 0, Hb);
    GRID_BAR();
#pragma unroll 1
    for (int layer = 0; layer < 2; ++layer) {
        phase_inproj(p, lds);
        GRID_BAR();
        phase_prep(p, layer, lds);
        GRID_BAR();
        phase_mlstm(p, layer, lds);
        phase_hgrn(p, layer, lds);
        phase_fox(p, layer, lds);
        GRID_BAR();
        phase_merge(p, lds);
        GRID_BAR();
        phase_out(p, layer, lds);
        GRID_BAR();
        phase_front(p, layer, lds);
        GRID_BAR();
        phase_scatter(p, layer, lds);
        GRID_BAR();
#pragma unroll 1
        for (int half = 0; half < NHALF; ++half) {
            phase_moe_up(p, half, lds);
            GRID_BAR();
            phase_moe_down(p, half, lds);
            GRID_BAR();
            phase_combine(p, layer, half);
            if (layer == 0 && half == NHALF - 1) phase_convert_mix(p, 1, lds);
            GRID_BAR();
        }
    }
}

extern "C" void kernel_launch(void* const* d_in, const int* in_sizes, int n_in, void* d_out, int out_size, void* d_ws, size_t ws_size, hipStream_t stream) {
    (void)in_sizes; (void)n_in; (void)out_size; (void)ws_size;
    Params p{};
    for (int i = 0; i < 26; ++i) p.in[i] = (const float*)d_in[i];
    p.out = (float*)d_out;
    p.ws = (unsigned char*)d_ws;
    static int grid = 0;
    if (!grid) {
        int dev = 0, cus = 0, per_cu = 0;
        (void)hipGetDevice(&dev);
        (void)hipDeviceGetAttribute(&cus, hipDeviceAttributeMultiprocessorCount, dev);
        (void)hipFuncSetAttribute((const void*)mega_fwd, hipFuncAttributeMaxDynamicSharedMemorySize, LDS_BYTES);
        (void)hipOccupancyMaxActiveBlocksPerMultiprocessor(&per_cu, mega_fwd, 512, LDS_BYTES);
        if (cus <= 0) cus = 256;
        grid = cus * (per_cu < 1 ? per_cu : 1);
        if (grid <= 0) grid = cus;
        if (grid > 256) grid = 256;
    }
    (void)hipMemsetAsync(d_ws, 0, CTL_BYTES, stream);
    hipLaunchKernelGGL(mega_fwd, dim3(grid), dim3(512), LDS_BYTES, stream, p);
}
```

```cpp
#include <hip/hip_runtime.h>
#include <stdint.h>
#include <stddef.h>

#define DEV __device__ __forceinline__
typedef unsigned short bf16_t;
typedef short bf16x8 __attribute__((ext_vector_type(8)));
typedef float f32x4 __attribute__((ext_vector_type(4)));
typedef float f32x2 __attribute__((ext_vector_type(2)));
typedef __bf16 bf16x2_t __attribute__((ext_vector_type(2)));

constexpr int T = 32768, DM = 1024, NB = 16, SEQ = 2048, NIN = 8208;
constexpr int O_FQ = 0, O_FK = 512, O_FV = 1024, O_FF = 1536, O_MQK = 1544, O_MV = 2056, O_MI = 2568, O_MF = 2572, O_MO = 2576,
              O_HF = 3088, O_HQ = 3600, O_HI = 4112, O_HG = 4624, O_GATES = 5136;
constexpr int DIN = 8256;
constexpr int C_FQ = 0, C_FK = 512, C_FV = 1024, C_MQK = 1536, C_MV = 2048, C_MO = 2560, C_HF = 3072, C_HQ = 3584, C_HI = 4096, C_HG = 4608, C_GATES = 5120,
              C_FF = 8192, C_MI = 8200, C_MF = 8204;
static_assert((DIN * 2) % 128 == 0 && C_MF + 4 <= DIN && C_GATES * 2 + 3072 <= C_FF * 2, "proj row layout");
constexpr int C_MERGED = 512;
constexpr int NEXP = 64, TOPK = 8, NLIST = 65, NHALF = 1, HALF_T = T / NHALF, NSLOT = 9;
constexpr int ROWCAP = 311296;
constexpr int TILECAP = ROWCAP / 256;
constexpr int TL_PAD = (TILECAP + 63) / 64 * 64;

constexpr size_t AL(size_t x) { return (x + 255) & ~(size_t)255; }
constexpr size_t OFF_CTL = 0;
constexpr size_t OFF_CNT = 32768;
constexpr int CNT_STRIDE = 32;
constexpr size_t OFF_QCTR = 65536;
constexpr size_t CTL_BYTES = 131072;
constexpr size_t OFF_MOD = CTL_BYTES;
constexpr size_t OFF_GS = AL(OFF_MOD + (size_t)2 * 16 * 6144 * 4);
constexpr size_t OFF_IDX = AL(OFF_GS + (size_t)T * 16 * 4);
constexpr size_t OFF_WTS = AL(OFF_IDX + (size_t)T * 8 * 4);
constexpr size_t OFF_RANK = AL(OFF_WTS + (size_t)T * 8 * 4);
constexpr size_t OFF_POS = AL(OFF_RANK + (size_t)T * 8 * 4);
constexpr size_t OFF_TILEL = AL(OFF_POS + (size_t)T * NSLOT * 4);
constexpr size_t OFF_WIN = AL(OFF_TILEL + (size_t)NHALF * (TILECAP + 16) * 4);
constexpr size_t OFF_WG8 = AL(OFF_WIN + (size_t)2816 * 1024 * 2);
constexpr size_t OFF_WBR = AL(OFF_WG8 + (size_t)5632 * 1024);
constexpr size_t OFF_WOUT = AL(OFF_WBR + (size_t)3 * 1024 * 512 * 2);
constexpr size_t OFF_WRT = AL(OFF_WOUT + (size_t)1024 * 1024 * 2);
constexpr size_t OFF_H = AL(OFF_WRT + (size_t)256 * 1024 * 2);
constexpr size_t OFF_H2F8 = OFF_H + (size_t)T * 1024;
constexpr size_t OFF_PROJ = AL(OFF_H + (size_t)T * 1024 * 2);
constexpr size_t OFF_END = AL(OFF_PROJ + (size_t)T * DIN * 2);
constexpr size_t OFF_W13 = OFF_PROJ;
constexpr size_t OFF_HID = AL(OFF_W13 + (size_t)NLIST * 512 * 1024);
constexpr size_t OFF_OUTA = AL(OFF_HID + (size_t)ROWCAP * 256);
constexpr size_t OFF_MOE_END = AL(OFF_OUTA + (size_t)ROWCAP * 1024);
constexpr size_t OFF_XB = OFF_MOE_END;
constexpr size_t OFF_W2 = OFF_MOE_END + (size_t)T * 2048;
static_assert(OFF_XB + (size_t)T * 2048 + (size_t)NEXP * 1024 * 256 <= OFF_END, "x1 rows and the routed down weights must fit behind the MoE overlay");
constexpr size_t OFF_FBUF = OFF_END;
constexpr size_t OFF_GBUF = AL(OFF_FBUF + (size_t)128 * SEQ * 4);
constexpr size_t OFF_ECBUF = AL(OFF_GBUF + (size_t)64 * SEQ * 16);
constexpr size_t OFF_EVBUF = AL(OFF_ECBUF + (size_t)64 * 32 * 4);
constexpr size_t OFF_H8 = AL(OFF_EVBUF + (size_t)64 * 32 * 384 * 4);
constexpr size_t OFF_W2S = AL(OFF_H8 + (size_t)T * 1024);
constexpr size_t OFF_EROW = AL(OFF_W2S + (size_t)1024 * 256 * 2);
constexpr size_t OFF_END2 = AL(OFF_EROW + (size_t)NLIST * T * 4);
static_assert((size_t)NEXP * 1024 * 256 * 2 <= (size_t)T * 1024, "routed W2 fits the lower half of H");
static_assert(OFF_MOE_END <= OFF_END, "MoE overlay must fit inside proj region");
static_assert(OFF_END2 <= (size_t)682 * 1000 * 1000, "workspace too large");
static_assert((size_t)64 * 32 * 4 * 64 * 64 * 2 <= (size_t)T * 1024 * 2, "mLSTM operand blocks fit the H region");

struct Params {
    const float* in[26];
    float* out;
    unsigned char* ws;
};
enum { I_X = 0, I_C, I_ADAW, I_ADAB, I_N1G, I_N2G, I_WIN, I_FOXBF, I_FOXQG, I_FOXKG, I_MCONV, I_MBI, I_MBF, I_MNG, I_HLB, I_HNG,
       I_WBR, I_WOUT, I_RW, I_RB, I_EW1, I_EW3, I_EW2, I_SW1, I_SW3, I_SW2 };

DEV int tid_op() { int t = threadIdx.x; asm volatile("" : "+v"(t)); return t; }
DEV int bid_op() { int b = blockIdx.x; asm volatile("" : "+s"(b)); return b; }
DEV float bf2f(bf16_t v) { return __uint_as_float((unsigned)v << 16); }
DEV unsigned pack2(float lo, float hi) { f32x2 v = {lo, hi}; bf16x2_t b = __builtin_convertvector(v, bf16x2_t); return __builtin_bit_cast(unsigned, b); }
DEV bf16_t f2bf(float f) { return (bf16_t)(pack2(f, 0.f) & 0xffffu); }
DEV float sigmoid_f(float x) { return 1.f / (1.f + __expf(-x)); }
DEV float silu_f(float x) { return x / (1.f + __expf(-x)); }
DEV float fsigmoid(float x) { return __builtin_amdgcn_rcpf(1.f + __expf(-x)); }
DEV float fsilu(float x) { return x * __builtin_amdgcn_rcpf(1.f + __expf(-x)); }
DEV unsigned pack4_fp8(float a, float b, float c, float d) {
    a = __builtin_amdgcn_fmed3f(a, -448.f, 448.f); b = __builtin_amdgcn_fmed3f(b, -448.f, 448.f); c = __builtin_amdgcn_fmed3f(c, -448.f, 448.f); d = __builtin_amdgcn_fmed3f(d, -448.f, 448.f);
    int v = __builtin_amdgcn_cvt_pk_fp8_f32(a, b, 0, false); v = __builtin_amdgcn_cvt_pk_fp8_f32(c, d, v, true); return (unsigned)v;
}
constexpr float F8_ACT_SCALE = 8.f, F8_W_SCALE = 64.f;
DEV float logsigmoid_f(float x) { return fminf(x, 0.f) - log1pf(__expf(-fabsf(x))); }
DEV int lane_op() { int l = (int)__builtin_amdgcn_mbcnt_hi(~0u, __builtin_amdgcn_mbcnt_lo(~0u, 0u)); asm volatile("" : "+v"(l)); return l; }
DEV float sx(float v, int o) { return __builtin_bit_cast(float, __builtin_amdgcn_ds_bpermute((lane_op() ^ o) << 2, __builtin_bit_cast(int, v))); }
DEV float sfrom(float v, int src) { return __builtin_bit_cast(float, __builtin_amdgcn_ds_bpermute(src << 2, __builtin_bit_cast(int, v))); }
DEV float sup(float v, int o) { const int l = lane_op(); return __builtin_bit_cast(float, __builtin_amdgcn_ds_bpermute(((l >= o) ? l - o : l) << 2, __builtin_bit_cast(int, v))); }
typedef unsigned u32x2v __attribute__((ext_vector_type(2)));
#define DPPF(v, ctrl) __builtin_bit_cast(float, __builtin_amdgcn_update_dpp(0, __builtin_bit_cast(int, (v)), (ctrl), 0xF, 0xF, true))
DEV float sum4(float v) { v += DPPF(v, 0xB1); v += DPPF(v, 0x4E); return v; }
DEV float sum8(float v) { v = sum4(v); v += DPPF(v, 0x141); return v; }
DEV float sum16(float v) { v = sum8(v); v += DPPF(v, 0x140); return v; }
DEV float max8(float v) { v = fmaxf(v, DPPF(v, 0xB1)); v = fmaxf(v, DPPF(v, 0x4E)); v = fmaxf(v, DPPF(v, 0x141)); return v; }
#define SWAP_RED(NAME, INS, OP) DEV float NAME(float v) { float a = v, b = v; asm volatile("s_nop 1\n\t" INS " %0, %1" : "+v"(a), "+v"(b)); return OP; }
SWAP_RED(red16_sum, "v_permlane16_swap_b32", a + b)
SWAP_RED(red32_sum, "v_permlane32_swap_b32", a + b)
SWAP_RED(red16_max, "v_permlane16_swap_b32", fmaxf(a, b))
SWAP_RED(red32_max, "v_permlane32_swap_b32", fmaxf(a, b))
#undef SWAP_RED
DEV float wave_sum(float v) { return red32_sum(red16_sum(sum16(v))); }
DEV void unpack8(uint4 u, float* f) {
    f[0] = __uint_as_float(u.x << 16); f[1] = __uint_as_float(u.x & 0xffff0000u);
    f[2] = __uint_as_float(u.y << 16); f[3] = __uint_as_float(u.y & 0xffff0000u);
    f[4] = __uint_as_float(u.z << 16); f[5] = __uint_as_float(u.z & 0xffff0000u);
    f[6] = __uint_as_float(u.w << 16); f[7] = __uint_as_float(u.w & 0xffff0000u);
}


constexpr int VB_COLS = 2576, VF_VALS = 2560, VF_COLS = 5632;
DEV int vb_to_proj(int vc) { const int blk = vc >> 9; return ((blk == 0) ? C_FQ : (blk == 1) ? C_FK : (blk == 2) ? C_MQK : (blk == 3) ? C_HF : C_HQ) + (vc & 511); }
DEV int vf_to_proj(int vc) { if (vc >= VF_VALS) return C_GATES + (vc - VF_VALS); const int blk = vc >> 9; return ((blk == 0) ? C_FV : (blk == 1) ? C_MV : (blk == 2) ? C_MO : (blk == 3) ? C_HI : C_HG) + (vc & 511); }
DEV int inproj_vrow(int n, bool& f8) {
    f8 = false;
    if (n < O_FV) return n;
    if (n < O_FF) { f8 = true; return n - O_FV; }
    if (n < O_MQK) return 2560 + (n - O_FF);
    if (n < O_MV) return 1024 + (n - O_MQK);
    if (n < O_MI) { f8 = true; return 512 + (n - O_MV); }
    if (n < O_MO) return 2568 + (n - O_MI);
    if (n < O_HF) { f8 = true; return 1024 + (n - O_MO); }
    if (n < O_HQ) return 1536 + (n - O_HF);
    if (n < O_HI) return 2048 + (n - O_HQ);
    if (n < O_HG) { f8 = true; return 1536 + (n - O_HI); }
    if (n < O_GATES) { f8 = true; return 2048 + (n - O_HG); }
    f8 = true; return VF_VALS + (n - O_GATES);
}
DEV void lds_barrier() { asm volatile("s_waitcnt lgkmcnt(0)\n\ts_barrier" ::: "memory"); }
DEV const float* arg_in(int idx) {
    typedef const float* fptr_t;
    const __attribute__((address_space(4))) char* ka = (const __attribute__((address_space(4))) char*)__builtin_amdgcn_kernarg_segment_ptr();
    return *(const __attribute__((address_space(4))) fptr_t*)(ka + idx * 8);
}
struct MB { const float* src; unsigned char* dst; int ld; bool ok, f8; };
DEV MB mix_cb(const Params& p, int layer, int u, int lane, int wid) {
    MB c;
    int job, kb, nb, b = 0;
    if (u < 1032) { job = 0; kb = u & 7; nb = u >> 3; }
    else if (u < 1224) { const int r = (u - 1032) & 63; job = 1; b = (u - 1032) >> 6; kb = r & 3; nb = r >> 2; }
    else if (u < 1352) { job = 2; kb = (u - 1224) & 7; nb = (u - 1224) >> 3; }
    else { job = 3; kb = u - 1352; nb = 0; }
    const int N = (job == 0) ? NIN : (job == 3) ? 64 : 1024, K = (job == 1) ? 512 : 1024;
    const float* base = arg_in((job == 0) ? (int)I_WIN : (int)I_WBR + job - 1);
    const int n = nb * 64 + lane, k0 = kb * 128 + 16 * wid;
    c.ok = n < N; c.ld = N;
    c.src = base + ((size_t)layer * (job == 1 ? 3 : 1) + b) * (size_t)K * N + (size_t)k0 * N + (c.ok ? n : 0);
    bool f8 = false; int nm = n;
    if (job == 0) nm = inproj_vrow(c.ok ? n : 0, f8);
    c.f8 = f8;
    const size_t doff = (job == 0) ? (f8 ? OFF_WG8 : OFF_WIN) : (job == 1) ? OFF_WBR + (size_t)b * 1024 * 512 * 2 : (job == 2) ? OFF_WOUT : OFF_WRT;
    c.dst = p.ws + doff + (f8 ? (size_t)nm * 1024 + k0 : ((size_t)nm * K + k0) * 2);
    return c;
}
constexpr int MIX_CBLOCKS = 1032 + 192 + 128 + 8;
DEV void phase_convert_mix(const Params& p, int layer, char* lds) {
    const int t = tid_op(), lane = t & 63, wid = t >> 6, G = gridDim.x;
    int u = bid_op();
    if (u >= MIX_CBLOCKS) return;
    MB c = mix_cb(p, layer, u, lane, wid);
    float v[16];
#pragma unroll
    for (int i = 0; i < 16; ++i) v[i] = c.src[(size_t)i * c.ld];
#pragma unroll 1
    for (; u < MIX_CBLOCKS; u += G) {
        const bool more = u + G < MIX_CBLOCKS;
        const MB cn = mix_cb(p, layer, more ? u + G : u, lane, wid);
        float nx[16];
#pragma unroll
        for (int i = 0; i < 16; ++i) nx[i] = cn.src[(size_t)i * cn.ld];
        if (c.ok) {
            if (c.f8) { const float sc = F8_W_SCALE;
                *(uint4*)c.dst = make_uint4(pack4_fp8(v[0] * sc, v[1] * sc, v[2] * sc, v[3] * sc), pack4_fp8(v[4] * sc, v[5] * sc, v[6] * sc, v[7] * sc),
                                            pack4_fp8(v[8] * sc, v[9] * sc, v[10] * sc, v[11] * sc), pack4_fp8(v[12] * sc, v[13] * sc, v[14] * sc, v[15] * sc)); }
            else { *(uint4*)c.dst = make_uint4(pack2(v[0], v[1]), pack2(v[2], v[3]), pack2(v[4], v[5]), pack2(v[6], v[7]));
                   *(uint4*)(c.dst + 16) = make_uint4(pack2(v[8], v[9]), pack2(v[10], v[11]), pack2(v[12], v[13]), pack2(v[14], v[15])); }
        }
        c = cn;
#pragma unroll
        for (int i = 0; i < 16; ++i) v[i] = nx[i];
    }
}
struct CU4 { const f32x4* src; unsigned char* dst; int ld4, pitch; };
DEV CU4 moe_cu(const Params& p, int layer, int u, int lane, int wid) {
    CU4 c;
    const int e = u / 24, r = u % 24, which = r >> 3, t = r & 7;
    const float* base = arg_in((int)I_EW1 + (e < NEXP ? 0 : 3) + which);
    const float* w = base + (size_t)(e < NEXP ? layer * NEXP + e : layer) * 262144;
    if (which < 2) { const int kb = t, nm = (lane >> 1) * 16 + (lane & 1) * 8 + (which ? 4 : 0);
        c.src = (const f32x4*)(w + (size_t)(kb * 128 + 16 * wid) * 256 + 4 * lane); c.ld4 = 64; c.pitch = 1024;
        c.dst = p.ws + OFF_W13 + (size_t)e * 512 * 1024 + (size_t)nm * 1024 + kb * 128 + 16 * wid; }
    else { const int kb = t & 1, nb = t >> 1, n = nb * 256 + 4 * lane;
        c.src = (const f32x4*)(w + (size_t)(kb * 128 + 16 * wid) * 1024 + n); c.ld4 = 256; c.pitch = 256;
        c.dst = p.ws + (e < NEXP ? OFF_W2 + (size_t)e * 1024 * 256 : OFF_W2S) + (size_t)n * 256 + kb * 128 + 16 * wid; }
    return c;
}
constexpr int MOE_CUNITS = NLIST * 24;
DEV unsigned pk4s(float a, float b, float c, float d) { const float sc = F8_W_SCALE; return pack4_fp8(a * sc, b * sc, c * sc, d * sc); }
DEV void conv_moe_all(const Params& p, int layer) {
    const int t = tid_op(), lane = t & 63, wid = t >> 6, G = gridDim.x;
    int u = bid_op();
    if (u >= MOE_CUNITS) return;
    CU4 c = moe_cu(p, layer, u, lane, wid);
    f32x4 A[8], B[8];
#pragma unroll
    for (int i = 0; i < 8; ++i) A[i] = c.src[(size_t)i * c.ld4];
#pragma unroll
    for (int i = 0; i < 8; ++i) B[i] = c.src[(size_t)(8 + i) * c.ld4];
#pragma unroll 1
    for (; u < MOE_CUNITS; u += G) {
        const bool more = u + G < MOE_CUNITS;
        const CU4 cn = moe_cu(p, layer, more ? u + G : u, lane, wid);
        unsigned lo[4][2];
#pragma unroll
        for (int j = 0; j < 4; ++j) { lo[j][0] = pk4s(A[0][j], A[1][j], A[2][j], A[3][j]); lo[j][1] = pk4s(A[4][j], A[5][j], A[6][j], A[7][j]); }
#pragma unroll
        for (int i = 0; i < 8; ++i) A[i] = cn.src[(size_t)i * cn.ld4];
#pragma unroll
        for (int j = 0; j < 4; ++j)
            *(uint4*)(c.dst + (size_t)j * c.pitch) = make_uint4(lo[j][0], lo[j][1], pk4s(B[0][j], B[1][j], B[2][j], B[3][j]), pk4s(B[4][j], B[5][j], B[6][j], B[7][j]));
#pragma unroll
        for (int i = 0; i < 8; ++i) B[i] = cn.src[(size_t)(8 + i) * cn.ld4];
        c = cn;
    }
}

DEV void phase_ada(const Params& p, char* lds) {
    float* condT = (float*)lds;
    float* red = condT + 1024 * 16;
    const int t = tid_op();
    for (int i = t; i < 16 * 1024; i += 512) { const int b = i >> 10, k = i & 1023; condT[k * 16 + b] = silu_f(p.in[I_C][i]); }
    __syncthreads();
    float* mod = (float*)(p.ws + OFF_MOD);
    for (int u = bid_op(); u < 2 * 96; u += gridDim.x) {
        const int l = u / 96, j0 = (u % 96) * 64, col = t & 63, kg = t >> 6;
        const float* w = p.in[I_ADAW] + (size_t)l * 1024 * 6144 + j0 + col;
        float acc[16];
#pragma unroll
        for (int b = 0; b < 16; ++b) acc[b] = 0.f;
        for (int k0 = kg * 128; k0 < kg * 128 + 128; k0 += 8) {
            float wv8[8];
#pragma unroll
            for (int uu = 0; uu < 8; ++uu) wv8[uu] = w[(size_t)(k0 + uu) * 6144];
#pragma unroll
            for (int uu = 0; uu < 8; ++uu) {
                const float wv = wv8[uu];
                const f32x4* cp = (const f32x4*)(condT + (k0 + uu) * 16);
#pragma unroll
                for (int q = 0; q < 4; ++q) { const f32x4 c4 = cp[q]; acc[q * 4 + 0] += c4[0] * wv; acc[q * 4 + 1] += c4[1] * wv; acc[q * 4 + 2] += c4[2] * wv; acc[q * 4 + 3] += c4[3] * wv; }
            }
        }
        __syncthreads();
#pragma unroll
        for (int b = 0; b < 16; ++b) red[(kg * 16 + b) * 64 + col] = acc[b];
        __syncthreads();
        for (int i = t; i < 16 * 64; i += 512) {
            const int b = i >> 6, c = i & 63;
            float s = p.in[I_ADAB][l * 6144 + j0 + c];
#pragma unroll
            for (int g = 0; g < 8; ++g) s += red[(g * 16 + b) * 64 + c];
            mod[((size_t)l * 16 + b) * 6144 + j0 + c] = s;
        }
    }
}

DEV void phase_norm(const Params& p, const float* xin, int layer, int which, bf16_t* hout) {
    const int lane = tid_op() & 63, wid = tid_op() >> 6;
    const float* g = p.in[which ? I_N2G : I_N1G] + layer * 1024;
    const float* mod = (const float*)(p.ws + OFF_MOD) + (size_t)layer * 16 * 6144;
    for (int row = bid_op() * 8 + wid; row < T; row += gridDim.x * 8) {
        const float* xr = xin + (size_t)row * 1024;
        f32x4 v[4]; float ss = 0.f;
#pragma unroll
        for (int i = 0; i < 4; ++i) { v[i] = *(const f32x4*)(xr + i * 256 + lane * 4); ss += v[i][0] * v[i][0] + v[i][1] * v[i][1] + v[i][2] * v[i][2] + v[i][3] * v[i][3]; }
        ss = wave_sum(ss);
        const float rstd = rsqrtf(ss * (1.f / 1024.f) + 1e-6f);
        const int b = row >> 11;
        const float* sh = mod + (size_t)b * 6144 + (which ? 3 : 0) * 1024;
        const float* sc = sh + 1024;
#pragma unroll
        for (int i = 0; i < 4; ++i) {
            const int c = i * 256 + lane * 4;
            const f32x4 g4 = *(const f32x4*)(g + c), sc4 = *(const f32x4*)(sc + c), sh4 = *(const f32x4*)(sh + c);
            float h0 = v[i][0] * rstd * g4[0] * (1.f + sc4[0]) + sh4[0];
            float h1 = v[i][1] * rstd * g4[1] * (1.f + sc4[1]) + sh4[1];
            float h2 = v[i][2] * rstd * g4[2] * (1.f + sc4[2]) + sh4[2];
            float h3 = v[i][3] * rstd * g4[3] * (1.f + sc4[3]) + sh4[3];
            uint2 o; o.x = pack2(h0, h1); o.y = pack2(h2, h3);
            *(uint2*)(hout + (size_t)row * 1024 + c) = o;
            if (which == 0) *(unsigned*)(p.ws + OFF_H8 + (size_t)row * 1024 + c) = pack4_fp8(h0 * F8_ACT_SCALE, h1 * F8_ACT_SCALE, h2 * F8_ACT_SCALE, h3 * F8_ACT_SCALE);
        }
    }
}

#define LAS __attribute__((address_space(3)))
namespace g8 {
typedef unsigned u32x4 __attribute__((ext_vector_type(4)));
constexpr int BM = 256, BK = 64, HALF = 128, HTB = HALF * BK * 2, STAGE_BYTES = 8 * HTB;
DEV int lds_byte(int r, int c) { const int st = (r >> 4) * 2 + (c >> 5), rr = r & 15, cc = c & 31, ob = rr * 64 + cc * 2; return st * 1024 + (ob ^ (((ob >> 9) & 1) << 5)); }
DEV void stage_rc(int b, int& R, int& C) { const int st = b / 1024, sb = b % 1024, swz = sb ^ (((sb >> 9) & 1) << 5); R = (st >> 1) * 16 + swz / 64; C = (st & 1) * 32 + (swz % 64) / 2; }
DEV int perm32(int rho) { const int n = rho >> 4, i = rho & 15; return 8 * (i >> 2) + 4 * n + (i & 3); }

struct GUnit { const char* A; const char* B; const int* rows; int pm, pn, aux; };

typedef int v8i_t __attribute__((ext_vector_type(8)));
typedef int v4i_t __attribute__((ext_vector_type(4)));
DEV v8i_t cat8(bf16x8 a, bf16x8 b) { const v4i_t x = __builtin_bit_cast(v4i_t, a), y = __builtin_bit_cast(v4i_t, b); return (v8i_t){x[0], x[1], x[2], x[3], y[0], y[1], y[2], y[3]}; }
template <bool PERM, bool GATHER, bool F8, int SEXP = 0, class Gen, class Epi>
DEV void gemm8(LAS unsigned char* lds, const int lda_b, const int ldb_b, const int K, const Gen& S, const Epi& E) {
    int tid_ = tid_op();
    const int tid = tid_, wid = __builtin_amdgcn_readfirstlane(tid >> 6), lane = tid & 63, wr = wid >> 2, wc = wid & 3, fr = lane & 15, fq = lane >> 4;
    const int nt = K / BK;
    int Rs[2], Cb[2];
    unsigned voffB[2];
#pragma unroll
    for (int i = 0; i < 2; ++i) { int R, C; stage_rc(tid * 16 + i * 8192, R, C); const int Rb = PERM ? (64 * (R >> 5) + 16 * ((R & 15) >> 2) + 4 * ((R >> 4) & 1) + (R & 3)) : R;
        Rs[i] = R; Cb[i] = C * 2; voffB[i] = (unsigned)Rb * (unsigned)ldb_b + (unsigned)C * 2u; }
    const size_t kstep = (size_t)(BK * 2);
    const size_t hstepB = (size_t)(PERM ? 8 : HALF) * ldb_b;
    const unsigned ldsw = (unsigned)wid * 1024u;
    const int aoff = lds_byte(wr * 64 + fr, fq * 8), boff = lds_byte(wc * 32 + fr, fq * 8);
#define PG8_SA(b, h) (((b) * 2 + (h)) * HTB)
#define PG8_SB(b, h) ((4 + (b) * 2 + (h)) * HTB)
#define PG8_STAGE(bufoff, gbase, voff) do { _Pragma("unroll") for (int _i = 0; _i < 2; ++_i) \
        __builtin_amdgcn_global_load_lds((const unsigned*)((const char*)(gbase) + (voff)[_i]), (LAS unsigned*)(lds + (bufoff) + ldsw + _i * 8192), 16, 0, 0); } while (0)
#define PG8_LDA(dst, b, h) do { _Pragma("unroll") for (int m = 0; m < 4; ++m) { if constexpr (F8) dst##8[m] = cat8(*(const LAS bf16x8*)(lds + PG8_SA(b, h) + aoff + m * 2048), *(const LAS bf16x8*)(lds + PG8_SA(b, h) + aoff + m * 2048 + 1024)); \
        else { _Pragma("unroll") for (int k = 0; k < 2; ++k) dst[m][k] = *(const LAS bf16x8*)(lds + PG8_SA(b, h) + aoff + m * 2048 + k * 1024); } } } while (0)
#define PG8_LDB(dst, b, h) do { _Pragma("unroll") for (int n = 0; n < 2; ++n) { if constexpr (F8) dst##8[n] = cat8(*(const LAS bf16x8*)(lds + PG8_SB(b, h) + boff + n * 2048), *(const LAS bf16x8*)(lds + PG8_SB(b, h) + boff + n * 2048 + 1024)); \
        else { _Pragma("unroll") for (int k = 0; k < 2; ++k) dst[n][k] = *(const LAS bf16x8*)(lds + PG8_SB(b, h) + boff + n * 2048 + k * 1024); } } } while (0)
#define PG8_MMA(ai, bj, At, Bt) do { __builtin_amdgcn_s_setprio(1); _Pragma("unroll") for (int m = 0; m < 4; ++m) _Pragma("unroll") for (int n = 0; n < 2; ++n) { \
        if constexpr (F8) asm volatile("v_mfma_scale_f32_16x16x128_f8f6f4 %0, %1, %2, %0, %3, %4 op_sel_hi:[0,0,0]" : "+v"(acc[ai][bj][m][n]) : "v"(Bt##8[n]), "v"(At##8[m]), "v"(0x7f7f7f7f), "v"(0x01010101 * (127 + SEXP))); \
        else { _Pragma("unroll") for (int k = 0; k < 2; ++k) acc[ai][bj][m][n] = __builtin_amdgcn_mfma_f32_16x16x32_bf16(Bt[n][k], At[m][k], acc[ai][bj][m][n], 0, 0, 0); } } \
        __builtin_amdgcn_s_setprio(0); } while (0)
#define PG8_WAIT_V(n) asm volatile("s_waitcnt vmcnt(" #n ")" ::: "memory")
#define PG8_WAIT_L(n) asm volatile("s_waitcnt lgkmcnt(" #n ")" ::: "memory")
#define PG8_BAR __builtin_amdgcn_s_barrier()
#define PG8_SCHED __builtin_amdgcn_sched_barrier(0)
    GUnit cur, nxt; int ui = 0;
    if (!S.next(0, cur)) return;
    unsigned cOff[2][2], nOff[2][2];
    auto mkoff = [&](unsigned (&o)[2][2], int buf) {
#pragma unroll
        for (int h = 0; h < 2; ++h)
#pragma unroll
            for (int i = 0; i < 2; ++i) {
                if constexpr (GATHER) { const unsigned r = (unsigned)S.rb[buf * 256 + h * HALF + Rs[i]]; o[h][i] = (r < (unsigned)T ? r : 0u) * (unsigned)lda_b + (unsigned)Cb[i]; }

                else o[h][i] = (unsigned)(h * HALF + Rs[i]) * (unsigned)lda_b + (unsigned)Cb[i];
            }
    };
    auto rows_dma = [&](const int* rows, int buf) {
        if constexpr (GATHER) __builtin_amdgcn_global_load_lds((const unsigned*)(rows + lane * 4), (LAS unsigned*)(S.rb + buf * 256), 16, 0, 0);
    };
    if constexpr (GATHER) {
        if (wid == 0) { rows_dma(cur.rows, 0); GUnit t1; if (S.next(1, t1)) rows_dma(t1.rows, 1); }
        asm volatile("s_waitcnt vmcnt(0)" ::: "memory");
        __builtin_amdgcn_s_barrier();
    }
    mkoff(cOff, 0);
    f32x4 acc[2][2][4][2];
#pragma unroll
    for (int a = 0; a < 2; ++a)
#pragma unroll
        for (int b = 0; b < 2; ++b)
#pragma unroll
            for (int m = 0; m < 4; ++m)
#pragma unroll
                for (int n = 0; n < 2; ++n) acc[a][b][m][n] = (f32x4){0.f, 0.f, 0.f, 0.f};
    bf16x8 At[4][2], B0[2][2], B1[2][2];
    v8i_t At8[4], B08[2], B18[2];
    const char* cA = cur.A; const char* cB = cur.B;
    PG8_STAGE(PG8_SB(0, 0), cB, voffB); PG8_STAGE(PG8_SB(0, 1), cB + hstepB, voffB); PG8_STAGE(PG8_SA(0, 0), cA, cOff[0]); PG8_STAGE(PG8_SA(0, 1), cA, cOff[1]);
    if (wr == 1) PG8_BAR;
    PG8_WAIT_V(2); PG8_BAR;
    PG8_STAGE(PG8_SB(1, 0), cB + kstep, voffB); PG8_STAGE(PG8_SA(1, 0), cA + kstep, cOff[0]); PG8_STAGE(PG8_SB(1, 1), cB + hstepB + kstep, voffB);
    PG8_WAIT_V(6); PG8_BAR;
    for (;;) {
        const bool has_next = S.next(ui + 1, nxt);
        if constexpr (GATHER) {
            { GUnit t2; if (S.next(ui + 2, t2) && wid == 0) rows_dma(t2.rows, ui & 1); }
            if (has_next) mkoff(nOff, (ui + 1) & 1);
            else {
#pragma unroll
                for (int h = 0; h < 2; ++h)
#pragma unroll
                    for (int i = 0; i < 2; ++i) nOff[h][i] = cOff[h][i];
            }
        }
        const char* nA = has_next ? nxt.A : cA; const char* nB = has_next ? nxt.B : cB;
#pragma unroll 1
        for (int t = 0; t < nt; t += 2) {
            const bool last = (t == nt - 2);
            const char* a1 = cA + (size_t)(t + 1) * kstep;
            const char* a2 = last ? nA : cA + (size_t)(t + 2) * kstep; const char* b2 = last ? nB : cB + (size_t)(t + 2) * kstep;
            const char* a3 = a2 + kstep; const char* b3 = b2 + kstep;
            unsigned o2[2][2];
#pragma unroll
            for (int h = 0; h < 2; ++h)
#pragma unroll
                for (int i = 0; i < 2; ++i) { if constexpr (GATHER) o2[h][i] = last ? nOff[h][i] : cOff[h][i]; else o2[h][i] = cOff[h][i]; }
            PG8_LDB(B0, 0, 0); PG8_LDB(B1, 0, 1); PG8_SCHED; PG8_LDA(At, 0, 0); PG8_STAGE(PG8_SA(1, 1), a1, cOff[1]);
            PG8_WAIT_V(8); PG8_WAIT_L(0); PG8_BAR; PG8_MMA(0, 0, At, B0); PG8_MMA(0, 1, At, B1); PG8_BAR; PG8_SCHED;
            PG8_LDA(At, 0, 1); PG8_STAGE(PG8_SB(0, 0), b2, voffB); PG8_STAGE(PG8_SB(0, 1), b2 + hstepB, voffB); PG8_STAGE(PG8_SA(0, 0), a2, o2[0]);
            PG8_WAIT_V(8); PG8_WAIT_L(0); PG8_BAR; PG8_MMA(1, 0, At, B0); PG8_MMA(1, 1, At, B1); PG8_BAR; PG8_SCHED;
            PG8_LDB(B0, 1, 0); PG8_LDB(B1, 1, 1); PG8_SCHED; PG8_LDA(At, 1, 0); PG8_STAGE(PG8_SA(0, 1), a2, o2[1]);
            PG8_WAIT_V(8); PG8_WAIT_L(0); PG8_BAR; PG8_MMA(0, 0, At, B0); PG8_MMA(0, 1, At, B1); PG8_BAR; PG8_SCHED;
            PG8_LDA(At, 1, 1); PG8_STAGE(PG8_SB(1, 0), b3, voffB); PG8_STAGE(PG8_SB(1, 1), b3 + hstepB, voffB); PG8_STAGE(PG8_SA(1, 0), a3, o2[0]);
            PG8_WAIT_V(8); PG8_WAIT_L(0); PG8_BAR; PG8_MMA(1, 0, At, B0); PG8_MMA(1, 1, At, B1); PG8_BAR; PG8_SCHED;
        }
        if (wr == 0) PG8_BAR;
        if constexpr (F8) asm volatile("s_nop 15\n\ts_nop 15" ::: "memory");
        { int pm_ = cur.pm, pn_ = cur.pn; asm volatile("" : "+s"(pm_), "+s"(pn_)); cur.pm = pm_; cur.pn = pn_; }
        E(acc, cur, wr, wc, fr, fq);
        if (!has_next) break;
        if (!(nxt.aux & 256)) {
#pragma unroll
            for (int a = 0; a < 2; ++a)
#pragma unroll
                for (int b = 0; b < 2; ++b)
#pragma unroll
                    for (int m = 0; m < 4; ++m)
#pragma unroll
                        for (int n = 0; n < 2; ++n) acc[a][b][m][n] = (f32x4){0.f, 0.f, 0.f, 0.f};
        }
        cur = nxt; cA = nA; cB = nB; ++ui;
        if constexpr (GATHER) {
#pragma unroll
            for (int h = 0; h < 2; ++h)
#pragma unroll
                for (int i = 0; i < 2; ++i) cOff[h][i] = nOff[h][i];
        }
        if (wr == 1) PG8_BAR;
    }
    PG8_WAIT_V(0);
    PG8_BAR;
#undef PG8_SA
#undef PG8_SB
#undef PG8_STAGE
#undef PG8_LDA
#undef PG8_LDB
#undef PG8_MMA
#undef PG8_WAIT_V
#undef PG8_WAIT_L
#undef PG8_BAR
#undef PG8_SCHED
}

struct TileOrder {
    int nM, nN, nwg;
    DEV void init(int nM_, int nN_) { nM = nM_; nN = nN_; nwg = nM * nN; }
    DEV bool get(int L, int& pm, int& pn) const {
        if (L >= nwg) return false;
        constexpr int NXCD = 8, WGM = 8;
        int wgid = L; { const int q = nwg / NXCD, r = nwg % NXCD, xcd = wgid % NXCD, off = wgid / NXCD; wgid = (xcd < r ? xcd * (q + 1) : r * (q + 1) + (xcd - r) * q) + off; }
        const int nig = WGM * nN, gid = wgid / nig, fm = gid * WGM, gsz = (nM - fm) < WGM ? (nM - fm) : WGM;
        pm = fm + ((wgid % nig) % gsz); pn = (wgid % nig) / gsz; return true;
    }
};
}

DEV unsigned ldsaddr_dummy() { return 0; }


DEV uint4 dpp_swap1(uint4 v) {
    uint4 r;
    r.x = (unsigned)__builtin_amdgcn_update_dpp(0, (int)v.x, 0xB1, 0xF, 0xF, true); r.y = (unsigned)__builtin_amdgcn_update_dpp(0, (int)v.y, 0xB1, 0xF, 0xF, true);
    r.z = (unsigned)__builtin_amdgcn_update_dpp(0, (int)v.z, 0xB1, 0xF, 0xF, true); r.w = (unsigned)__builtin_amdgcn_update_dpp(0, (int)v.w, 0xB1, 0xF, 0xF, true);
    return r;
}
DEV uint4 sel4(bool c, uint4 a, uint4 b) { uint4 r; r.x = c ? a.x : b.x; r.y = c ? a.y : b.y; r.z = c ? a.z : b.z; r.w = c ? a.w : b.w; return r; }
DEV void store_wide32(char* base, unsigned off, unsigned pitch, int fr, uint4 p0, uint4 p1) {
    const bool odd = fr & 1;
    const uint4 got = dpp_swap1(sel4(odd, p0, p1));
    *(uint4*)(base + (odd ? off - pitch + 16u : off)) = sel4(odd, got, p0);
    *(uint4*)(base + (odd ? off + 16u : off + pitch)) = sel4(odd, p1, got);
}

DEV void phase_inproj(const Params& p, char* lds) {
    bf16_t* P = (bf16_t*)(p.ws + OFF_PROJ);
    float* GS = (float*)(p.ws + OFF_GS);
    const int odd = bid_op() & 1;
#pragma unroll 1
    for (int pass = 0; pass < 3; ++pass) {
    const bool isbf = odd ? (pass != 1) : (pass == 1);
    const int i0 = (odd && pass == 2) ? 1 : 0;
    const int icnt = odd ? ((pass == 0) ? 1 : 0x7fffffff) : ((pass < 2) ? 0x7fffffff : 0);
    if (isbf) {
        struct Gen { g8::TileOrder o; const char* H; const char* W; int G, c, i0, cnt;
            DEV bool next(int i_, g8::GUnit& u) const { int pm, pn; if (i_ >= cnt) return false; const int i = i_ + i0; if (!o.get(i * G + c, pm, pn)) return false; u.pm = pm; u.pn = pn; u.aux = 0; u.rows = nullptr;
                u.A = H + (size_t)pm * 256 * 2048; u.B = W + (size_t)pn * 256 * 2048; return true; } } gen;
        gen.o.init(T / 256, 11); gen.H = (const char*)(p.ws + OFF_H); gen.W = (const char*)(p.ws + OFF_WIN); gen.G = gridDim.x; gen.c = bid_op(); gen.i0 = i0; gen.cnt = icnt;
        auto epi = [&](const f32x4 (&acc)[2][2][4][2], const g8::GUnit& u, int wr, int wc, int fr, int fq) {
            const int vc0 = u.pn * 256 + 64 * wc + 16 * fq;
            if (vc0 < 2560) {
                const unsigned pc0 = (unsigned)vb_to_proj(vc0);
#pragma unroll
                for (int ai = 0; ai < 2; ++ai)
#pragma unroll
                    for (int m = 0; m < 4; ++m) {
                        const int row = u.pm * 256 + ai * 128 + wr * 64 + m * 16 + fr;
                        const f32x4 a0 = acc[ai][0][m][0], a1 = acc[ai][0][m][1], b0 = acc[ai][1][m][0], b1 = acc[ai][1][m][1];
                        uint4 p0, p1;
                        p0.x = pack2(a0[0], a0[1]); p0.y = pack2(a0[2], a0[3]); p0.z = pack2(a1[0], a1[1]); p0.w = pack2(a1[2], a1[3]);
                        p1.x = pack2(b0[0], b0[1]); p1.y = pack2(b0[2], b0[3]); p1.z = pack2(b1[0], b1[1]); p1.w = pack2(b1[2], b1[3]);
                        store_wide32((char*)P, ((unsigned)row * DIN + pc0) * 2u, (unsigned)DIN * 2u, fr, p0, p1);
                    }
            } else if (vc0 == 2560) {
#pragma unroll
                for (int ai = 0; ai < 2; ++ai)
#pragma unroll
                    for (int m = 0; m < 4; ++m) {
                        const int row = u.pm * 256 + ai * 128 + wr * 64 + m * 16 + fr;
                        const f32x4 a0 = acc[ai][0][m][0], a1 = acc[ai][0][m][1], b0 = acc[ai][1][m][0], b1 = acc[ai][1][m][1];
                        uint4 p0, p1;
                        p0.x = pack2(a0[0], a0[1]); p0.y = pack2(a0[2], a0[3]); p0.z = pack2(a1[0], a1[1]); p0.w = pack2(a1[2], a1[3]);
                        p1.x = pack2(b0[0], b0[1]); p1.y = pack2(b0[2], b0[3]); p1.z = pack2(b1[0], b1[1]); p1.w = pack2(b1[2], b1[3]);
                        *(uint4*)(P + (size_t)row * DIN + C_FF) = p0; *(uint4*)(P + (size_t)row * DIN + C_MI) = p1;
                        *(f32x4*)(GS + (size_t)row * 16) = a0; *(f32x4*)(GS + (size_t)row * 16 + 4) = a1;
                        *(f32x4*)(GS + (size_t)row * 16 + 8) = b0; *(f32x4*)(GS + (size_t)row * 16 + 12) = b1;
                    }
            }
        };
        g8::gemm8<true, false, false>((LAS unsigned char*)lds, 2048, 2048, 1024, gen, epi);
    } else {
        struct Gen { g8::TileOrder o; const char* H; const char* W; int G, c, i0, cnt;
            DEV bool next(int i_, g8::GUnit& u) const { int pm, pn; if (i_ >= cnt) return false; const int i = i_ + i0;
                int L = i * G + c;
                if (G == 256) { if (i >= 10) { if (c < 128 || i >= 12) return false; L = 2560 + (i - 10) * 128 + (c - 128); } }
                if (!o.get(L, pm, pn)) return false; u.pm = pm; u.pn = pn; u.aux = 0; u.rows = nullptr;
                u.A = H + (size_t)pm * 256 * 1024; u.B = W + (size_t)pn * 256 * 1024; return true; } } gen;
        gen.o.init(T / 256, 22); gen.H = (const char*)(p.ws + OFF_H8); gen.W = (const char*)(p.ws + OFF_WG8); gen.G = gridDim.x; gen.c = bid_op(); gen.i0 = i0; gen.cnt = icnt;
        auto epi = [&](const f32x4 (&acc)[2][2][4][2], const g8::GUnit& u, int wr, int wc, int fr, int fq) {
            const int vc0 = u.pn * 256 + 64 * wc + 16 * fq;
            const unsigned pc0 = (unsigned)vf_to_proj(vc0);
            const bool gate = u.pn >= 10;
#pragma unroll
            for (int ai = 0; ai < 2; ++ai)
#pragma unroll
                for (int m = 0; m < 4; ++m) {
                    const int row = u.pm * 256 + ai * 128 + wr * 64 + m * 16 + fr;
                    f32x4 a0 = acc[ai][0][m][0], a1 = acc[ai][0][m][1], b0 = acc[ai][1][m][0], b1 = acc[ai][1][m][1];
                    if (gate) {
                        unsigned w4[4];
#pragma unroll
                        for (int q = 0; q < 4; ++q) {
                            const f32x4 v = (q == 0) ? a0 : (q == 1) ? a1 : (q == 2) ? b0 : b1;
                            unsigned w = 0u;
#pragma unroll
                            for (int j = 0; j < 4; ++j) w = __builtin_amdgcn_cvt_pk_u8_f32(fmaxf(fsigmoid(v[j]) * 255.f, 1.f), j, w);
                            w4[q] = w;
                        }
                        *(uint4*)((unsigned char*)P + (size_t)row * (DIN * 2) + C_GATES * 2 + (vc0 - VF_VALS)) = make_uint4(w4[0], w4[1], w4[2], w4[3]);
                        continue;
                    }
                    uint4 p0, p1;
                    p0.x = pack2(a0[0], a0[1]); p0.y = pack2(a0[2], a0[3]); p0.z = pack2(a1[0], a1[1]); p0.w = pack2(a1[2], a1[3]);
                    p1.x = pack2(b0[0], b0[1]); p1.y = pack2(b0[2], b0[3]); p1.z = pack2(b1[0], b1[1]); p1.w = pack2(b1[2], b1[3]);
                    store_wide32((char*)P, ((unsigned)row * DIN + pc0) * 2u, (unsigned)DIN * 2u, fr, p0, p1);
                }
        };
        g8::gemm8<true, false, true, -9>((LAS unsigned char*)lds, 1024, 1024, 512, gen, epi);
    }
    }
}

DEV void phase_merge(const Params& p, char* lds) {
    bf16_t* P = (bf16_t*)(p.ws + OFF_PROJ);
    const char* W = (const char*)(p.ws + OFF_WBR);
    struct Gen { g8::TileOrder o; const char* P; const char* W; int G, c;
        DEV bool next(int i, g8::GUnit& u) const { int pm, pn; const int ti = i / 3, b = i - ti * 3; if (!o.get(ti * G + c, pm, pn)) return false; u.pm = pm; u.pn = pn; u.aux = b | (b > 0 ? 256 : 0); u.rows = nullptr;
            const int ycol = (b == 0) ? C_FQ : (b == 1) ? C_MO : C_HG;
            u.A = P + ((size_t)pm * 256 * DIN + ycol) * 2; u.B = W + ((size_t)b * 1024 + pn * 256) * 512 * 2; return true; } } gen;
    gen.o.init(T / 256, 4); gen.P = (const char*)P; gen.W = W; gen.G = gridDim.x; gen.c = bid_op();
    auto epi = [&](f32x4 (&acc)[2][2][4][2], const g8::GUnit& u, int wr, int wc, int fr, int fq) {
        const int b = u.aux & 3;
#pragma unroll
        for (int ai = 0; ai < 2; ++ai) {
            uint4 gq[4], hq[4];
            const unsigned char* rp = (const unsigned char*)P + (size_t)(u.pm * 256 + ai * 128 + wr * 64 + fr) * (DIN * 2) + C_GATES * 2 + b * 1024 + u.pn * 256 + 64 * wc + 16 * fq;
#pragma unroll
            for (int m = 0; m < 4; ++m) {
                gq[m] = *(const uint4*)(rp + (size_t)(m * 16) * (DIN * 2));
                if (b < 2) hq[m] = *(const uint4*)(rp + (size_t)(m * 16) * (DIN * 2) + 1024);
            }
#pragma unroll
            for (int m = 0; m < 4; ++m) {
#pragma unroll
                for (int bj = 0; bj < 2; ++bj) {
                    const unsigned g0 = bj ? gq[m].z : gq[m].x, g1 = bj ? gq[m].w : gq[m].y;
                    float g[8] = {(float)(g0 & 0xffu), (float)((g0 >> 8) & 0xffu), (float)((g0 >> 16) & 0xffu), (float)(g0 >> 24),
                                  (float)(g1 & 0xffu), (float)((g1 >> 8) & 0xffu), (float)((g1 >> 16) & 0xffu), (float)(g1 >> 24)};
                    if (b < 2) {
                        const unsigned h0 = bj ? hq[m].z : hq[m].x, h1 = bj ? hq[m].w : hq[m].y;
                        const float gn[8] = {(float)(h0 & 0xffu), (float)((h0 >> 8) & 0xffu), (float)((h0 >> 16) & 0xffu), (float)(h0 >> 24),
                                             (float)(h1 & 0xffu), (float)((h1 >> 8) & 0xffu), (float)((h1 >> 16) & 0xffu), (float)(h1 >> 24)};
#pragma unroll
                        for (int j = 0; j < 8; ++j) g[j] *= __builtin_amdgcn_rcpf(gn[j]);
                    } else {
#pragma unroll
                        for (int j = 0; j < 8; ++j) g[j] *= (1.f / 255.f);
                    }
#pragma unroll
                    for (int j = 0; j < 4; ++j) { acc[ai][bj][m][0][j] *= g[j]; acc[ai][bj][m][1][j] *= g[4 + j]; }
                }
                if (b == 2) {
                    const f32x4 a0 = acc[ai][0][m][0], a1 = acc[ai][0][m][1], b0 = acc[ai][1][m][0], b1 = acc[ai][1][m][1];
                    uint4 p0, p1;
                    p0.x = pack2(a0[0], a0[1]); p0.y = pack2(a0[2], a0[3]); p0.z = pack2(a1[0], a1[1]); p0.w = pack2(a1[2], a1[3]);
                    p1.x = pack2(b0[0], b0[1]); p1.y = pack2(b0[2], b0[3]); p1.z = pack2(b1[0], b1[1]); p1.w = pack2(b1[2], b1[3]);
                    store_wide32((char*)(p.ws + OFF_H), ((unsigned)(u.pm * 256 + ai * 128 + wr * 64 + m * 16 + fr) * 1024u + (unsigned)(u.pn * 256 + 64 * wc + 16 * fq)) * 2u, 2048u, fr, p0, p1);
                }
            }
        }
    };
    g8::gemm8<true, false, false>((LAS unsigned char*)lds, DIN * 2, 1024, 512, gen, epi);
}

DEV void phase_out(const Params& p, int layer, char* lds) {
    const char* M = (const char*)(p.ws + OFF_H);
    const char* W = (const char*)(p.ws + OFF_WOUT);
    const float* mod = (const float*)(p.ws + OFF_MOD) + (size_t)layer * 16 * 6144;
    struct Gen { g8::TileOrder o; const char* M; const char* W; int G, c;
        DEV bool next(int i, g8::GUnit& u) const { int pm, pn; if (!o.get(i * G + c, pm, pn)) return false; u.pm = pm; u.pn = pn; u.aux = i; u.rows = nullptr;
            u.A = M + (size_t)pm * 256 * 2048; u.B = W + (size_t)pn * 256 * 2048; return true; } } gen;
    gen.o.init(T / 256, 4); gen.M = M; gen.W = W; gen.G = gridDim.x; gen.c = bid_op();
    const float* xf = p.in[I_X];
    const bf16_t* xh = (const bf16_t*)p.out;
    const int skew = gen.c & 1;
    auto epi = [&](const f32x4 (&acc)[2][2][4][2], const g8::GUnit& u, int wr, int wc, int fr, int fq) {
        const int bb = (u.pm * 256) >> 11;
        const int c0 = u.pn * 256 + 64 * wc + 16 * fq;
        f32x4 g1[4];
#pragma unroll
        for (int q = 0; q < 4; ++q) g1[q] = *(const f32x4*)(mod + (size_t)bb * 6144 + 2 * 1024 + c0 + 4 * q);
#pragma unroll
        for (int ai = 0; ai < 2; ++ai) {
            const unsigned r0 = (unsigned)(u.pm * 256 + ai * 128 + wr * 64 + fr);
            if (layer == 0) {
#pragma unroll
                for (int mh = 0; mh < 2; ++mh) {
                    f32x4 xr[2][4];
#pragma unroll
                    for (int m = 0; m < 2; ++m)
#pragma unroll
                        for (int q = 0; q < 4; ++q) xr[m][q] = *(const f32x4*)(xf + (size_t)(r0 + (mh * 2 + m) * 16) * 1024 + c0 + 4 * q);
#pragma unroll
                    for (int m2 = 0; m2 < 2; ++m2) {
                        const int m = mh * 2 + m2;
                        float o[16];
#pragma unroll
                        for (int bj = 0; bj < 2; ++bj)
#pragma unroll
                            for (int n = 0; n < 2; ++n)
#pragma unroll
                                for (int j = 0; j < 4; ++j) o[8 * bj + 4 * n + j] = xr[m2][2 * bj + n][j] + g1[2 * bj + n][j] * acc[ai][bj][m][n][j];
                        uint4 p0, p1;
                        p0.x = pack2(o[0], o[1]); p0.y = pack2(o[2], o[3]); p0.z = pack2(o[4], o[5]); p0.w = pack2(o[6], o[7]);
                        p1.x = pack2(o[8], o[9]); p1.y = pack2(o[10], o[11]); p1.z = pack2(o[12], o[13]); p1.w = pack2(o[14], o[15]);
                        store_wide32((char*)(p.ws + OFF_XB), ((r0 + m * 16) * 1024u + (unsigned)c0) * 2u, 2048u, fr, p0, p1);
                    }
                }
            } else {
                uint4 xr[4][2];
#pragma unroll
                for (int m = 0; m < 4; ++m)
#pragma unroll
                    for (int q = 0; q < 2; ++q) xr[m][q] = *(const uint4*)(xh + (size_t)(r0 + m * 16) * 1024 + c0 + 8 * q);
#pragma unroll
                for (int m = 0; m < 4; ++m) {
                    float o[16];
#pragma unroll
                    for (int bj = 0; bj < 2; ++bj) {
                        float xv[8]; unpack8(xr[m][bj], xv);
#pragma unroll
                        for (int n = 0; n < 2; ++n)
#pragma unroll
                            for (int j = 0; j < 4; ++j) o[8 * bj + 4 * n + j] = xv[4 * n + j] + g1[2 * bj + n][j] * acc[ai][bj][m][n][j];
                    }
                    uint4 p0, p1;
                    p0.x = pack2(o[0], o[1]); p0.y = pack2(o[2], o[3]); p0.z = pack2(o[4], o[5]); p0.w = pack2(o[6], o[7]);
                    p1.x = pack2(o[8], o[9]); p1.y = pack2(o[10], o[11]); p1.z = pack2(o[12], o[13]); p1.w = pack2(o[14], o[15]);
                    store_wide32((char*)(p.ws + OFF_XB), ((r0 + m * 16) * 1024u + (unsigned)c0) * 2u, 2048u, fr, p0, p1);
                }
            }
        }
    };
    if (skew) conv_moe_all(p, layer);
    g8::gemm8<true, false, false>((LAS unsigned char*)lds, 2048, 2048, 1024, gen, epi);
    if (!skew) conv_moe_all(p, layer);
}

DEV void phase_front(const Params& p, int layer, char* lds) {
    constexpr int LDH = 1032;
    bf16_t* HT = (bf16_t*)lds;
    float* LG = (float*)(HT + 32 * LDH);
    int* cntl = (int*)(LG + 32 * 64);
    int* basel = cntl + 128;
    int* sel = basel + 128;
    const int tid = tid_op(), lane = tid & 63, wid = tid >> 6, qi = lane & 15, g = lane >> 4;
    const float* gam = p.in[I_N2G] + layer * 1024;
    const float* mod = (const float*)(p.ws + OFF_MOD) + (size_t)layer * 16 * 6144;
    const bf16_t* WrT = (const bf16_t*)(p.ws + OFF_WRT);
    bf16_t* Hb = (bf16_t*)(p.ws + OFF_H);
    const float bias = p.in[I_RB][layer * 64 + lane];
    float* wts = (float*)(p.ws + OFF_WTS);
    int* cnt = (int*)(p.ws + OFF_CNT) + layer * 128 * CNT_STRIDE;
    lds_barrier();
    if (tid < 128) cntl[tid] = 0;
    const int ntok = T / (int)gridDim.x, tbase = bid_op() * ntok;
    const int grp = lane >> 3;
    bf16x8 bw[16];
    const bf16_t* wp = WrT + (size_t)((wid & 3) * 16 + qi) * 1024 + 8 * g;
#pragma unroll
    for (int kk = 0; kk < 16; ++kk) bw[kk] = *(const bf16x8*)(wp + 32 * kk);
    uint2 xq[4][4];
#pragma unroll
    for (int rr = 0; rr < 4; ++rr)
#pragma unroll
        for (int i = 0; i < 4; ++i) xq[rr][i] = *(const uint2*)((const bf16_t*)(p.ws + OFF_XB) + (size_t)(tbase + wid * 4 + rr) * 1024 + i * 256 + lane * 4);
#pragma unroll 1
    for (int sub = 0; sub < ntok / 32; ++sub) {
        const int t0 = tbase + sub * 32;
        {
            f32x4 v[4][4];
#pragma unroll
            for (int rr = 0; rr < 4; ++rr)
#pragma unroll
                for (int i = 0; i < 4; ++i) { const uint2 q = xq[rr][i];
                    v[rr][i] = (f32x4){__uint_as_float(q.x << 16), __uint_as_float(q.x & 0xffff0000u), __uint_as_float(q.y << 16), __uint_as_float(q.y & 0xffff0000u)}; }
            if (sub + 1 < ntok / 32) {
#pragma unroll
                for (int rr = 0; rr < 4; ++rr)
#pragma unroll
                    for (int i = 0; i < 4; ++i) xq[rr][i] = *(const uint2*)((const bf16_t*)(p.ws + OFF_XB) + (size_t)(t0 + 32 + wid * 4 + rr) * 1024 + i * 256 + lane * 4);
            }
            const int b = t0 >> 11;
            const float* sh = mod + (size_t)b * 6144 + 3 * 1024;
            const float* sc = sh + 1024;
#pragma unroll
            for (int rr = 0; rr < 4; ++rr) {
                float ss = 0.f;
#pragma unroll
                for (int i = 0; i < 4; ++i) ss += v[rr][i][0] * v[rr][i][0] + v[rr][i][1] * v[rr][i][1] + v[rr][i][2] * v[rr][i][2] + v[rr][i][3] * v[rr][i][3];
                ss = wave_sum(ss);
                const float rstd = rsqrtf(ss * (1.f / 1024.f) + 1e-6f);
                const int row = t0 + wid * 4 + rr;
#pragma unroll
                for (int i = 0; i < 4; ++i) {
                    const int c = i * 256 + lane * 4;
                    const f32x4 g4 = *(const f32x4*)(gam + c), sc4 = *(const f32x4*)(sc + c), sh4 = *(const f32x4*)(sh + c);
                    const float y0 = v[rr][i][0] * rstd * g4[0] * (1.f + sc4[0]) + sh4[0], y1 = v[rr][i][1] * rstd * g4[1] * (1.f + sc4[1]) + sh4[1];
                    const float y2 = v[rr][i][2] * rstd * g4[2] * (1.f + sc4[2]) + sh4[2], y3 = v[rr][i][3] * rstd * g4[3] * (1.f + sc4[3]) + sh4[3];
                    uint2 o; o.x = pack2(y0, y1); o.y = pack2(y2, y3);
                    *(unsigned*)(p.ws + OFF_H2F8 + (size_t)row * 1024 + c) = pack4_fp8(y0 * F8_ACT_SCALE, y1 * F8_ACT_SCALE, y2 * F8_ACT_SCALE, y3 * F8_ACT_SCALE);
                    *(uint2*)&HT[(wid * 4 + rr) * LDH + c] = o;
                }
            }
        }
        lds_barrier();
        {
            const int mt = wid >> 2, nt = wid & 3;
            f32x4 acc = (f32x4){0.f, 0.f, 0.f, 0.f}, acc2 = acc;
            const bf16_t* hp = HT + (mt * 16 + qi) * LDH + 8 * g;
            bf16x8 bw2[16];
#pragma unroll
            for (int kk = 0; kk < 16; ++kk) bw2[kk] = *(const bf16x8*)(wp + 32 * (16 + kk));
#pragma unroll
            for (int kk = 0; kk < 16; kk += 2) {
                acc = __builtin_amdgcn_mfma_f32_16x16x32_bf16(*(const bf16x8*)(hp + 32 * kk), bw[kk], acc, 0, 0, 0);
                acc2 = __builtin_amdgcn_mfma_f32_16x16x32_bf16(*(const bf16x8*)(hp + 32 * (kk + 1)), bw[kk + 1], acc2, 0, 0, 0);
            }
#pragma unroll
            for (int kk = 0; kk < 16; kk += 2) {
                acc = __builtin_amdgcn_mfma_f32_16x16x32_bf16(*(const bf16x8*)(hp + 32 * (16 + kk)), bw2[kk], acc, 0, 0, 0);
                acc2 = __builtin_amdgcn_mfma_f32_16x16x32_bf16(*(const bf16x8*)(hp + 32 * (17 + kk)), bw2[kk + 1], acc2, 0, 0, 0);
            }
#pragma unroll
            for (int j = 0; j < 4; ++j) LG[(mt * 16 + 4 * g + j) * 64 + nt * 16 + qi] = acc[j] + acc2[j];
        }
        lds_barrier();
#pragma unroll 1
        for (int rr = 0; rr < 4; ++rr) {
            const int k = sub * 32 + wid * 4 + rr, t = tbase + k;
            const float s = fsigmoid(LG[(wid * 4 + rr) * 64 + lane]);
            const float c = s + bias;
            float m1 = c;
            m1 = max8(m1);
            const unsigned long long bal = __ballot(c == m1);
            const unsigned gb = (unsigned)((bal >> (grp * 8)) & 0xffull);
            const int first = __ffs(gb) - 1;
            float c2 = ((lane & 7) == first) ? -INFINITY : c;
            c2 = max8(c2);
            const float gs = m1 + c2;
            int cg = 0;
#pragma unroll
            for (int gg = 0; gg < 8; ++gg) { const float v = __builtin_bit_cast(float, __builtin_amdgcn_readlane(__builtin_bit_cast(int, gs), gg * 8)); cg += (v > gs || (v == gs && gg < grp)) ? 1 : 0; }
            const float masked = (cg < 4) ? c : -INFINITY;
            int r = 0;
#pragma unroll
            for (int j = 0; j < 64; ++j) { const float v = __builtin_bit_cast(float, __builtin_amdgcn_readlane(__builtin_bit_cast(int, masked), j)); r += (v > masked || (v == masked && j < lane)) ? 1 : 0; }
            const bool selb = (r < 8) && (cg < 4);
            const float wsum = wave_sum(selb ? s : 0.f);
            if (selb) {
                const int half = t / HALF_T;
                wts[(size_t)t * 8 + r] = s / wsum * 2.5f;
                const int lr = atomicAdd(&cntl[half * 64 + lane], 1);
                sel[k * 8 + r] = (lane << 16) | lr;
            }
        }
    }
    lds_barrier();
    if (tid < 128) basel[tid] = atomicAdd(&cnt[tid * CNT_STRIDE], cntl[tid]);
    lds_barrier();
    int* erow = (int*)(p.ws + OFF_EROW); int* prel = (int*)(p.ws + OFF_POS);
    for (int i = tid; i < ntok * 8; i += 512) {
        const int t = tbase + (i >> 3), v = sel[i], e = v >> 16, r = basel[e] + (v & 0xffff);
        erow[(size_t)e * T + r] = t; prel[t * NSLOT + (i & 7)] = (e << 16) | r;
    }
    for (int i = tid; i < ntok; i += 512) { const int t = tbase + i; erow[(size_t)NEXP * T + t] = t; prel[t * NSLOT + 8] = (NEXP << 16) | t; }
}

DEV void moe_tables(const Params& p, int layer, char* lds) {
    LAS int* TL = (LAS int*)(lds + 131072);
    LAS int* TS = TL + TL_PAD + 512;
    const int* cnt = (const int*)(p.ws + OFF_CNT) + layer * 128 * CNT_STRIDE;
    const int tid = tid_op(), lane = tid & 63;
    __syncthreads();
    if (tid < 64) {
        const int nt = (cnt[tid * CNT_STRIDE] + 255) >> 8;
        int inc = nt;
#pragma unroll
        for (int o = 1; o < 64; o <<= 1) { const int n = __builtin_bit_cast(int, sup(__builtin_bit_cast(float, inc), o)); if (lane >= o) inc += n; }
        TS[tid] = inc - nt;
        if (tid == 63) { TS[64] = inc; TS[65] = inc + T / 256; }
    }
    __syncthreads();
    const int ntiles = TS[65];
    for (int tile = tid; tile < ntiles; tile += 512) {
        int l = 0;
#pragma unroll
        for (int st = 64; st > 0; st >>= 1) { const int q = l + st; if (q <= 64 && TS[q] <= tile) l = q; }
        TL[tile] = l;
    }
    __syncthreads();
}

DEV void phase_moe_up(const Params& p, int layer, int half, char* lds) {
    const char* H = (const char*)(p.ws + OFF_H2F8);
    const char* W13 = (const char*)(p.ws + OFF_W13);
    bf16_t* HID = (bf16_t*)(p.ws + OFF_HID);
    moe_tables(p, layer, lds);
    LAS int* TL = (LAS int*)(lds + 131072);
    struct Gen { const char* H; const char* W; const int* erow; LAS const int* tl; LAS const int* ts; LAS int* rb; int nun, G, c;
        DEV bool next(int i, g8::GUnit& u) const { const int L = i * G + c; if (L >= nun) return false; const int tile = L >> 1, pn = L & 1, l = __builtin_amdgcn_readfirstlane(tl[tile]), t0 = __builtin_amdgcn_readfirstlane(ts[l]);
            u.pm = tile; u.pn = pn; u.aux = l; u.rows = erow + (size_t)l * T + (tile - t0) * 256; u.A = H; u.B = W + ((size_t)l * 512 + pn * 256) * 1024; return true; } } gen;
    gen.H = H; gen.W = W13; gen.erow = (const int*)(p.ws + OFF_EROW); gen.tl = TL; gen.ts = TL + TL_PAD + 512; gen.rb = TL + TL_PAD; gen.nun = __builtin_amdgcn_readfirstlane(TL[TL_PAD + 512 + 65]) * 2; gen.G = gridDim.x; gen.c = bid_op();
    auto epi = [&](const f32x4 (&acc)[2][2][4][2], const g8::GUnit& u, int wr, int wc, int fr, int fq) {
#pragma unroll
        for (int ai = 0; ai < 2; ++ai)
#pragma unroll
            for (int m = 0; m < 4; ++m) {
                const int row = u.pm * 256 + ai * 128 + wr * 64 + m * 16 + fr;
                uint2 o;
#pragma unroll
                for (int bj = 0; bj < 2; ++bj) {
                    const f32x4 v1 = acc[ai][bj][m][0], v3 = acc[ai][bj][m][1];
                    const unsigned w = pack4_fp8(fsilu(v1[0]) * v3[0] * F8_ACT_SCALE, fsilu(v1[1]) * v3[1] * F8_ACT_SCALE, fsilu(v1[2]) * v3[2] * F8_ACT_SCALE, fsilu(v1[3]) * v3[3] * F8_ACT_SCALE);
                    if (bj == 0) o.x = w; else o.y = w;
                }
                *(uint2*)((unsigned char*)HID + (size_t)row * 256 + u.pn * 128 + 32 * wc + 8 * fq) = o;
            }
    };
    g8::gemm8<true, true, true, -9>((LAS unsigned char*)lds, 1024, 1024, 512, gen, epi);
}
DEV void phase_moe_down(const Params& p, int half, char* lds) {
    const char* HID = (const char*)(p.ws + OFF_HID);
    const char* W2 = (const char*)(p.ws + OFF_W2);
    unsigned char* OA = (unsigned char*)(p.ws + OFF_OUTA);
    LAS int* TL = (LAS int*)(lds + 131072);
    struct Gen { const char* HID; const char* W; const char* WS; LAS const int* tl; int nun, G, c;
        DEV bool next(int i, g8::GUnit& u) const { const int L = i * G + c; if (L >= nun) return false; const int tile = L >> 2, pn = L & 3, l = __builtin_amdgcn_readfirstlane(tl[tile]);
            u.pm = tile; u.pn = pn; u.aux = l; u.rows = nullptr; u.A = HID + (size_t)tile * 256 * 256; u.B = (l < NEXP ? W + (size_t)l * 1024 * 256 : WS) + (size_t)pn * 256 * 256; return true; } } gen;
    if (bid_op() & 1) __builtin_amdgcn_s_sleep(127);
    gen.HID = HID; gen.W = W2; gen.WS = (const char*)(p.ws + OFF_W2S); gen.tl = TL; gen.nun = __builtin_amdgcn_readfirstlane(TL[TL_PAD + 512 + 65]) * 4; gen.G = gridDim.x; gen.c = bid_op();
    auto epi = [&](const f32x4 (&acc)[2][2][4][2], const g8::GUnit& u, int wr, int wc, int fr, int fq) {
#pragma unroll
        for (int ai = 0; ai < 2; ++ai)
#pragma unroll
            for (int m = 0; m < 4; ++m) {
                const int row = u.pm * 256 + ai * 128 + wr * 64 + m * 16 + fr;
                unsigned w4[4];
#pragma unroll
                for (int bj = 0; bj < 2; ++bj) {
                    const f32x4 v0 = acc[ai][bj][m][0], v1 = acc[ai][bj][m][1];
                    w4[2 * bj] = pack4_fp8(v0[0], v0[1], v0[2], v0[3]); w4[2 * bj + 1] = pack4_fp8(v1[0], v1[1], v1[2], v1[3]);
                }
                *(uint4*)(OA + (size_t)row * 1024 + u.pn * 256 + 64 * wc + 16 * fq) = make_uint4(w4[0], w4[1], w4[2], w4[3]);
            }
    };
    g8::gemm8<true, false, true, -5>((LAS unsigned char*)lds, 256, 256, 128, gen, epi);
}
DEV void phase_combine(const Params& p, int layer, int half, char* lds) {
    const LAS int* TS = (const LAS int*)(lds + 131072) + TL_PAD + 512;
    const unsigned char* OA = (const unsigned char*)(p.ws + OFF_OUTA);
    const float* mod = (const float*)(p.ws + OFF_MOD) + (size_t)layer * 16 * 6144;
    const float* modn = (const float*)(p.ws + OFF_MOD) + (size_t)(layer + 1) * 16 * 6144;
    const float* gnx = p.in[I_N1G] + (layer + 1) * 1024;
    bf16_t* Hb = (bf16_t*)(p.ws + OFF_H);
    const int tid = tid_op(), lane = tid & 63, wid = tid >> 6;
    typedef float f32x2v __attribute__((ext_vector_type(2)));
    for (int tl0 = bid_op() * 8 + wid; tl0 < HALF_T; tl0 += gridDim.x * 8) {
        const int tok = __builtin_amdgcn_readfirstlane(half * HALF_T + tl0), b = tok >> 11;
        const float* wt = (const float*)(p.ws + OFF_WTS) + (size_t)tok * 8;
        const int* ps = (const int*)(p.ws + OFF_POS) + (size_t)tok * NSLOT;
        uint4 rw[NSLOT];
#pragma unroll
        for (int k = 0; k < NSLOT; ++k) { const int v = ps[k]; rw[k] = *(const uint4*)(OA + (size_t)(TS[v >> 16] * 256 + (v & 0xffff)) * 1024 + lane * 16); }
        float* o = p.out + (size_t)tok * 1024 + lane * 16;
        float x[16];
        { const bf16_t* xb = (const bf16_t*)(p.ws + OFF_XB) + (size_t)tok * 1024 + lane * 16;
          const uint4 q0 = *(const uint4*)xb, q1 = *(const uint4*)(xb + 8); unpack8(q0, x); unpack8(q1, x + 8); }
        float a[16];
#pragma unroll
        for (int j = 0; j < 16; ++j) a[j] = 0.f;
#pragma unroll
        for (int k = 0; k < NSLOT; ++k) {
            const float w = ((k < 8) ? wt[k] : 1.f) * (1.f / 16.f);
            const unsigned uu[4] = {rw[k].x, rw[k].y, rw[k].z, rw[k].w};
#pragma unroll
            for (int q = 0; q < 4; ++q) {
                const f32x2v f0 = __builtin_amdgcn_cvt_pk_f32_fp8((int)uu[q], false), f1 = __builtin_amdgcn_cvt_pk_f32_fp8((int)uu[q], true);
                a[4 * q] += w * f0[0]; a[4 * q + 1] += w * f0[1]; a[4 * q + 2] += w * f1[0]; a[4 * q + 3] += w * f1[1];
            }
        }
        const float* g2 = mod + (size_t)b * 6144 + 5 * 1024 + lane * 16;
        float xn[16]; float ss = 0.f;
#pragma unroll
        for (int q = 0; q < 4; ++q) {
            const f32x4 gq = *(const f32x4*)(g2 + 4 * q);
#pragma unroll
            for (int j = 0; j < 4; ++j) { xn[4 * q + j] = x[4 * q + j] + gq[j] * a[4 * q + j]; ss += xn[4 * q + j] * xn[4 * q + j]; }
            if (layer != 0) *(f32x4*)(o + 4 * q) = (f32x4){xn[4 * q], xn[4 * q + 1], xn[4 * q + 2], xn[4 * q + 3]};
        }
        if (layer == 0) {
            {
                bf16_t* ob = (bf16_t*)p.out + (size_t)tok * 1024 + lane * 16; uint4 w;
                w.x = pack2(xn[0], xn[1]); w.y = pack2(xn[2], xn[3]); w.z = pack2(xn[4], xn[5]); w.w = pack2(xn[6], xn[7]); *(uint4*)ob = w;
                w.x = pack2(xn[8], xn[9]); w.y = pack2(xn[10], xn[11]); w.z = pack2(xn[12], xn[13]); w.w = pack2(xn[14], xn[15]); *(uint4*)(ob + 8) = w;
            }
            ss = wave_sum(ss);
            const float rstd = rsqrtf(ss * (1.f / 1024.f) + 1e-6f);
            const float* sh = modn + (size_t)b * 6144 + lane * 16;
            const float* sc = sh + 1024;
            float h[16];
#pragma unroll
            for (int j = 0; j < 16; ++j) h[j] = xn[j] * rstd * gnx[lane * 16 + j] * (1.f + sc[j]) + sh[j];
            uint4 w;
            w.x = pack2(h[0], h[1]); w.y = pack2(h[2], h[3]); w.z = pack2(h[4], h[5]); w.w = pack2(h[6], h[7]);
            *(uint4*)(Hb + (size_t)tok * 1024 + lane * 16) = w;
            w.x = pack2(h[8], h[9]); w.y = pack2(h[10], h[11]); w.z = pack2(h[12], h[13]); w.w = pack2(h[14], h[15]);
            *(uint4*)(Hb + (size_t)tok * 1024 + lane * 16 + 8) = w;
            const float s8 = F8_ACT_SCALE;
            *(uint4*)(p.ws + OFF_H8 + (size_t)tok * 1024 + lane * 16) = make_uint4(pack4_fp8(h[0] * s8, h[1] * s8, h[2] * s8, h[3] * s8), pack4_fp8(h[4] * s8, h[5] * s8, h[6] * s8, h[7] * s8),
                                                                                   pack4_fp8(h[8] * s8, h[9] * s8, h[10] * s8, h[11] * s8), pack4_fp8(h[12] * s8, h[13] * s8, h[14] * s8, h[15] * s8));
        }
    }
}

typedef short v4i16_t __attribute__((ext_vector_type(4)));
DEV v4i16_t lds_tr(const bf16_t* ptr) { return __builtin_amdgcn_ds_read_tr16_b64_v4i16((LAS v4i16_t*)ptr); }

DEV void prep_hgrn(const Params& p, int layer, int u, char* lds, int tid, uint4 rf0, uint4 rf1, uint4 rq0, uint4 rq1) {
    float* LF = (float*)lds;
    float* OFFS = LF + 64 * 128;
    bf16_t* P = (bf16_t*)(p.ws + OFF_PROJ);
    const int bh = u >> 5, c = u & 31, b = bh >> 2, h = bh & 3;
    const int row0 = tid >> 4, col0 = (tid & 15) * 8;
    bf16_t* gb = P + ((size_t)b * SEQ + c * 64 + row0) * DIN + h * 128 + col0;
    float kk[2][8], qq[2][8];
    float lbv[8];
#pragma unroll
    for (int j = 0; j < 8; ++j) { lbv[j] = 0.f; if (layer == 1) { const float p0 = p.in[I_HLB][h * 128 + col0 + j], p1 = p.in[I_HLB][512 + h * 128 + col0 + j]; lbv[j] = 1.f / (1.f + __expf(p0 - p1)); } }
    lds_barrier();
#pragma unroll
    for (int i = 0; i < 2; ++i) {
        const int row = row0 + 32 * i;
        float z[8], qv[8], lf[8];
        unpack8(i == 0 ? rf0 : rf1, z); unpack8(i == 0 ? rq0 : rq1, qv);
#pragma unroll
        for (int j = 0; j < 8; ++j) {
            const float lb = lbv[j];
            const float sg = fsigmoid(z[j]);
            lf[j] = __logf(lb + (1.f - lb) * sg);
            kk[i][j] = (1.f - lb) * (1.f - sg);
            qq[i][j] = fsilu(qv[j]);
        }
        *(f32x4*)&LF[row * 128 + col0] = (f32x4){lf[0], lf[1], lf[2], lf[3]};
        *(f32x4*)&LF[row * 128 + col0 + 4] = (f32x4){lf[4], lf[5], lf[6], lf[7]};
    }
    lds_barrier();
    {
        const int d = tid & 127, part = tid >> 7;
        float v[16];
#pragma unroll
        for (int t = 0; t < 16; ++t) v[t] = LF[(part * 16 + t) * 128 + d];
#pragma unroll
        for (int t = 1; t < 16; ++t) v[t] += v[t - 1];
#pragma unroll
        for (int t = 0; t < 16; ++t) LF[(part * 16 + t) * 128 + d] = v[t];
        OFFS[part * 128 + d] = v[15];
    }
    lds_barrier();
#pragma unroll
    for (int i = 0; i < 2; ++i) {
        const int row = row0 + 32 * i, part = row >> 4;
        float qm[8], km[8];
#pragma unroll
        for (int j = 0; j < 8; ++j) {
            const int d = col0 + j;
            const float o0 = OFFS[d], o1 = OFFS[128 + d], o2 = OFFS[256 + d];
            const float off = (part > 0 ? o0 : 0.f) + (part > 1 ? o1 : 0.f) + (part > 2 ? o2 : 0.f);
            const float At = LF[row * 128 + d] + off, Am = LF[31 * 128 + d] + o0;
            qm[j] = qq[i][j] * __expf(At - Am);
            km[j] = kk[i][j] * __expf(fminf(Am - At, 60.f));
        }
        uint4 w; w.x = pack2(qm[0], qm[1]); w.y = pack2(qm[2], qm[3]); w.z = pack2(qm[4], qm[5]); w.w = pack2(qm[6], qm[7]);
        *(uint4*)(gb + (size_t)(32 * i) * DIN + C_HQ) = w;
        w.x = pack2(km[0], km[1]); w.y = pack2(km[2], km[3]); w.z = pack2(km[4], km[5]); w.w = pack2(km[6], km[7]);
        *(uint4*)(gb + (size_t)(32 * i) * DIN + C_HF) = w;
    }
    if (tid < 128) {
        const float o0 = OFFS[tid], o1 = OFFS[128 + tid], o2 = OFFS[256 + tid];
        const float Am = LF[31 * 128 + tid] + o0, Ac = LF[63 * 128 + tid] + o0 + o1 + o2;
        float* ev = (float*)(p.ws + OFF_EVBUF) + (size_t)u * 384;
        ev[tid] = __expf(Am); ev[128 + tid] = __expf(Ac); ev[256 + tid] = __expf(Ac - Am);
    }
}

DEV void prep_mlstm(const Params& p, int layer, int u, char* lds, int tid, uint4 rr0, uint4 rr1, uint4 rr2, float gmi, float gmf) {
    bf16_t* RAW = (bf16_t*)lds;
    float* EQ = (float*)(RAW + 67 * 128 + 64);
    float* EW = EQ + 64;
    float* CW = EW + 64;
    const int lane = tid & 63, wid = tid >> 6;
    const int bh = u >> 5, c = u & 31, h = bh & 3, t0 = c * 64;
    const int pr = tid >> 4, pc8 = (tid & 15) * 8;
    lds_barrier();
    *(uint4*)&RAW[pr * 128 + pc8] = rr0;
    *(uint4*)&RAW[(pr + 32) * 128 + pc8] = rr1;
    if (tid < 48) *(uint4*)&RAW[(pr + 64) * 128 + pc8] = rr2;
    {
        const int j = tid >> 7, cc = tid & 127;
        const int ch = (cc < 64) ? (h * 64 + cc) : (256 + h * 64 + (cc - 64));
        CW[j * 128 + cc] = p.in[I_MCONV][(size_t)layer * 4 * 512 + j * 512 + ch];
    }
    if (wid == 0) {
        const float ip = gmi + p.in[I_MBI][layer * 4 + h];
        float bc = logsigmoid_f(gmf + p.in[I_MBF][layer * 4 + h]);
#pragma unroll
        for (int o = 1; o < 64; o <<= 1) { const float n = sup(bc, o); if (lane >= o) bc += n; }
        const float bcC = sfrom(bc, 63);
        const float eq = __expf(bc), ew = __expf(bcC - bc + ip);
        EQ[lane] = eq; EW[lane] = ew;
        *(f32x4*)((float*)(p.ws + OFF_GBUF) + ((size_t)bh * SEQ + t0 + lane) * 4) = (f32x4){bc, ip, eq, ew};
        if (lane == 0) ((float*)(p.ws + OFF_ECBUF))[u] = __expf(bcC);
    }
    lds_barrier();
    bf16_t* blk = (bf16_t*)(p.ws + OFF_H) + (size_t)u * (4 * 64 * 64);
#pragma unroll 1
    for (int hh = 0; hh < 2; ++hh) {
        const int row = tid >> 3, c8 = (tid & 7) * 16 + hh * 8;
        float a[8];
#pragma unroll
        for (int e = 0; e < 8; ++e) a[e] = 0.f;
#pragma unroll
        for (int j = 0; j < 4; ++j) {
            float x[8];
            unpack8(*(const uint4*)&RAW[(row + j) * 128 + c8], x);
            const f32x4 w0 = *(const f32x4*)&CW[j * 128 + c8], w1 = *(const f32x4*)&CW[j * 128 + c8 + 4];
            a[0] += w0[0] * x[0]; a[1] += w0[1] * x[1]; a[2] += w0[2] * x[2]; a[3] += w0[3] * x[3];
            a[4] += w1[0] * x[4]; a[5] += w1[1] * x[5]; a[6] += w1[2] * x[6]; a[7] += w1[3] * x[7];
        }
        const bool isq = c8 < 64;
        const float sc = isq ? 1.f : 0.125f;
        const float ex = isq ? EQ[row] : EW[row];
        float y[8], ys[8];
#pragma unroll
        for (int e = 0; e < 8; ++e) { y[e] = fsilu(a[e]) * sc; ys[e] = y[e] * ex; }
        bf16_t* d0 = blk + (isq ? 0 : 4096) + row * 64 + (c8 & 63);
        uint4 w;
        w.x = pack2(y[0], y[1]); w.y = pack2(y[2], y[3]); w.z = pack2(y[4], y[5]); w.w = pack2(y[6], y[7]); *(uint4*)d0 = w;
        w.x = pack2(ys[0], ys[1]); w.y = pack2(ys[2], ys[3]); w.z = pack2(ys[4], ys[5]); w.w = pack2(ys[6], ys[7]); *(uint4*)(d0 + 8192) = w;
    }
}

DEV void prep_foxk(const Params& p, int layer, int u, int tid, uint4 kr0, uint4 kr1, uint4 kr2, uint4 kr3) {
    bf16_t* P = (bf16_t*)(p.ws + OFF_PROJ);
    const int bh = u >> 3, rb = u & 7, b = bh >> 3, h = bh & 7;
    const int r = tid >> 3, c8 = (tid & 7) * 8;
    bf16_t* kp = P + ((size_t)b * SEQ + rb * 256 + r) * DIN + C_FK + h * 64 + c8;
    float gk[8];
#pragma unroll
    for (int d = 0; d < 8; ++d) gk[d] = p.in[I_FOXKG][layer * 64 + c8 + d];
#pragma unroll
    for (int i = 0; i < 4; ++i) {
        float kf[8]; unpack8(i == 0 ? kr0 : i == 1 ? kr1 : i == 2 ? kr2 : kr3, kf);
        float ss = 0.f;
#pragma unroll
        for (int d = 0; d < 8; ++d) ss += kf[d] * kf[d];
        ss = sum8(ss);
        const float rstd = rsqrtf(ss * (1.f / 64.f) + 1e-6f);
        uint4 w;
        w.x = pack2(kf[0] * rstd * gk[0], kf[1] * rstd * gk[1]); w.y = pack2(kf[2] * rstd * gk[2], kf[3] * rstd * gk[3]);
        w.z = pack2(kf[4] * rstd * gk[4], kf[5] * rstd * gk[5]); w.w = pack2(kf[6] * rstd * gk[6], kf[7] * rstd * gk[7]);
        *(uint4*)(kp + (size_t)(64 * i) * DIN) = w;
    }
}
DEV void prep_foxf(const Params& p, int layer, int bh, char* lds, int tid) {
    float* wsum = (float*)lds;
    const float* GS = (const float*)(p.ws + OFF_GS);
    const int lane = tid & 63, wid = tid >> 6, b = bh >> 3, h = bh & 7;
    const float bfv = p.in[I_FOXBF][layer * 8 + h];
    float v[4]; float loc = 0.f;
#pragma unroll
    for (int i = 0; i < 4; ++i) { const int s = tid * 4 + i; v[i] = logsigmoid_f(GS[((size_t)b * SEQ + s) * 16 + h] + bfv); loc += v[i]; v[i] = loc; }
    float inc = loc;
#pragma unroll
    for (int o = 1; o < 64; o <<= 1) { const float n = sup(inc, o); if (lane >= o) inc += n; }
    lds_barrier();
    if (lane == 63) wsum[wid] = inc;
    lds_barrier();
    float base = inc - loc;
    for (int w = 0; w < wid; ++w) base += wsum[w];
    constexpr float L2E = 1.4426950408889634f;
    *(f32x4*)((float*)(p.ws + OFF_FBUF) + (size_t)bh * SEQ + tid * 4) = (f32x4){-(base + v[0]) * L2E, -(base + v[1]) * L2E, -(base + v[2]) * L2E, -(base + v[3]) * L2E};
}
DEV void phase_prep(const Params& p, int layer, char* lds) {
    const int tid = tid_op(), G = gridDim.x, bid = bid_op();
    const bf16_t* P = (const bf16_t*)(p.ws + OFF_PROJ);
    const float* GS = (const float*)(p.ws + OFF_GS);
    {
        const int row0 = tid >> 4, col0 = (tid & 15) * 8;
        uint4 a0, a1, a2, a3, n0 = make_uint4(0u, 0u, 0u, 0u), n1 = n0, n2 = n0, n3 = n0;
#define HGP_LOAD(r0_, r1_, r2_, r3_, u_) do { const int bh_ = (u_) >> 5, c_ = (u_) & 31; const bf16_t* gb_ = P + ((size_t)(bh_ >> 2) * SEQ + c_ * 64 + row0) * DIN + (bh_ & 3) * 128 + col0; \
            r0_ = *(const uint4*)(gb_ + C_HF); r1_ = *(const uint4*)(gb_ + (size_t)32 * DIN + C_HF); r2_ = *(const uint4*)(gb_ + C_HQ); r3_ = *(const uint4*)(gb_ + (size_t)32 * DIN + C_HQ); } while (0)
        int u = bid;
        if (u < 2048) HGP_LOAD(a0, a1, a2, a3, u);
        for (; u < 2048; u += G) {
            if (u + G < 2048) HGP_LOAD(n0, n1, n2, n3, u + G);
            prep_hgrn(p, layer, u, lds, tid, a0, a1, a2, a3);
            a0 = n0; a1 = n1; a2 = n2; a3 = n3;
        }
#undef HGP_LOAD
    }
    {
        const int pr = tid >> 4, pc8 = (tid & 15) * 8;
        uint4 a0, a1, a2, n0 = make_uint4(0u, 0u, 0u, 0u), n1 = n0, n2 = n0; float g0 = 0.f, g1 = 0.f, m0 = 0.f, m1 = 0.f;
#define MLP_LOAD(r0_, r1_, r2_, gi_, gf_, u_) do { const int bh_ = (u_) >> 5, t0_ = ((u_) & 31) * 64, h_ = bh_ & 3; const bf16_t* rowb_ = P + (size_t)(bh_ >> 2) * SEQ * DIN; \
            const unsigned off_ = (unsigned)pr * DIN + (unsigned)((pc8 < 64) ? (C_MQK + h_ * 64 + pc8) : (C_MQK + 256 + h_ * 64 + (pc8 - 64))); \
            const bf16_t* ub_ = rowb_ + (ptrdiff_t)(t0_ - 3) * DIN; const bool ok_ = (t0_ - 3 + pr >= 0); \
            r0_ = *(const uint4*)(ok_ ? ub_ + off_ : rowb_); if (!ok_) r0_ = make_uint4(0u, 0u, 0u, 0u); \
            r1_ = *(const uint4*)(ub_ + off_ + 32u * DIN); r2_ = *(const uint4*)((tid < 48) ? ub_ + off_ + 64u * DIN : rowb_); \
            const float* gp_ = GS + ((size_t)(bh_ >> 2) * SEQ + t0_ + (tid & 63)) * 16 + 8; gi_ = gp_[h_]; gf_ = gp_[4 + h_]; } while (0)
        int u = bid;
        if (u < 2048) MLP_LOAD(a0, a1, a2, g0, g1, u);
        for (; u < 2048; u += G) {
            if (u + G < 2048) MLP_LOAD(n0, n1, n2, m0, m1, u + G);
            prep_mlstm(p, layer, u, lds, tid, a0, a1, a2, g0, g1);
            a0 = n0; a1 = n1; a2 = n2; g0 = m0; g1 = m1;
        }
#undef MLP_LOAD
    }
    {
        const int r = tid >> 3, c8 = (tid & 7) * 8;
        uint4 a0, a1, a2, a3, n0 = make_uint4(0u, 0u, 0u, 0u), n1 = n0, n2 = n0, n3 = n0;
#define FKP_LOAD(r0_, r1_, r2_, r3_, u_) do { const int bh_ = (u_) >> 3, rb_ = (u_) & 7; const bf16_t* kp_ = P + ((size_t)(bh_ >> 3) * SEQ + rb_ * 256 + r) * DIN + C_FK + (bh_ & 7) * 64 + c8; \
            r0_ = *(const uint4*)kp_; r1_ = *(const uint4*)(kp_ + (size_t)64 * DIN); r2_ = *(const uint4*)(kp_ + (size_t)128 * DIN); r3_ = *(const uint4*)(kp_ + (size_t)192 * DIN); } while (0)
        int u = bid;
        if (u < 1024) FKP_LOAD(a0, a1, a2, a3, u);
        for (; u < 1024; u += G) {
            if (u + G < 1024) FKP_LOAD(n0, n1, n2, n3, u + G);
            prep_foxk(p, layer, u, tid, a0, a1, a2, a3);
            a0 = n0; a1 = n1; a2 = n2; a3 = n3;
        }
#undef FKP_LOAD
    }
    for (int u = (bid + G - 128 % G) % G; u < 128; u += G) prep_foxf(p, layer, u, lds, tid);
}

template <bool DRY = false>
DEV void phase_fox(const Params& p, int layer, char* lds) {
    constexpr int LDK = 72;
    constexpr float LOG2E = 1.4426950408889634f;
    constexpr int BUFB = 2 * 128 * LDK * 2 + 512;
    int* qsh = (int*)(lds + 2 * BUFB);
    bf16_t* P = (bf16_t*)(p.ws + OFF_PROJ);
    const int tid = tid_op(), lane = tid & 63, wid = tid >> 6, qi = lane & 15, g = lane >> 4, tq = qi >> 2, tp = lane & 3;
    int* qctr = (int*)(p.ws + OFF_QCTR) + layer * 64 + (DRY ? 32 : 0);
    const int skey = tid >> 3, sc8 = (tid & 7) * 8;
    for (;;) {
        __syncthreads();
        if (tid == 0) qsh[0] = atomicAdd(qctr, 1);
        __syncthreads();
        const int u = qsh[0];
        if (u >= NB * 8 * 8) break;
        const int qb = 7 - (u / (NB * 8)), bh = u % (NB * 8), b = bh >> 3, h = bh & 7;
        const int q0 = qb * 256, nst = 2 * qb + 2;
        const float* Fg = (const float*)(p.ws + OFF_FBUF) + (size_t)bh * SEQ;
        const int wrow = q0 + wid * 32;
        bf16x8 qf[2][2];
#pragma unroll
        for (int t = 0; t < 2; ++t) {
            const int trow = wrow + 16 * t + qi;
            const bf16_t* qp = P + ((size_t)b * SEQ + trow) * DIN + C_FQ + h * 64 + 8 * g;
            float q[16];
            unpack8(*(const uint4*)qp, q); unpack8(*(const uint4*)(qp + 32), q + 8);
            float ss = 0.f;
#pragma unroll
            for (int d = 0; d < 16; ++d) ss += q[d] * q[d];
            ss = red32_sum(red16_sum(ss));
            const float rstd = rsqrtf(ss * (1.f / 64.f) + 1e-6f) * (0.125f * LOG2E);
            const float* gq = p.in[I_FOXQG] + layer * 64 + 8 * g;
#pragma unroll
            for (int s2 = 0; s2 < 2; ++s2) {
                uint4 w;
                w.x = pack2(q[8 * s2 + 0] * rstd * gq[32 * s2 + 0], q[8 * s2 + 1] * rstd * gq[32 * s2 + 1]);
                w.y = pack2(q[8 * s2 + 2] * rstd * gq[32 * s2 + 2], q[8 * s2 + 3] * rstd * gq[32 * s2 + 3]);
                w.z = pack2(q[8 * s2 + 4] * rstd * gq[32 * s2 + 4], q[8 * s2 + 5] * rstd * gq[32 * s2 + 5]);
                w.w = pack2(q[8 * s2 + 6] * rstd * gq[32 * s2 + 6], q[8 * s2 + 7] * rstd * gq[32 * s2 + 7]);
                qf[t][s2] = __builtin_bit_cast(bf16x8, w);
            }
        }
        const bf16_t* kvp = P + ((size_t)b * SEQ + skey) * DIN + h * 64 + sc8;
        uint4 kA0, kA1, vA0, vA1; float fA = 0.f;
#define FOX_LOAD(K0, K1, V0, V1, FF, st_) do { const bf16_t* np_ = kvp + (size_t)(st_) * 128 * DIN; \
            K0 = *(const uint4*)(np_ + C_FK); K1 = *(const uint4*)(np_ + (size_t)64 * DIN + C_FK); V0 = *(const uint4*)(np_ + C_FV); V1 = *(const uint4*)(np_ + (size_t)64 * DIN + C_FV); \
            if (tid < 128) FF = Fg[(st_) * 128 + tid]; } while (0)
        FOX_LOAD(kA0, kA1, vA0, vA1, fA, 0);
        float m[2] = {-INFINITY, -INFINITY}, lsum[2] = {0.f, 0.f};
        f32x4 oacc[2][4];
#pragma unroll
        for (int t = 0; t < 2; ++t)
#pragma unroll
            for (int dt = 0; dt < 4; ++dt) oacc[t][dt] = (f32x4){0.f, 0.f, 0.f, 0.f};
#define FOX_COMPUTE(st) do { \
            const bf16_t* Ks = (const bf16_t*)(lds + ((st) & 1) * BUFB); const bf16_t* Vs = Ks + 128 * LDK; const float* Fs = (const float*)(Vs + 128 * LDK); \
            if ((st) * 128 <= wrow + 31) {                         \
                f32x4 sacc[2][8]; \
                _Pragma("unroll") for (int n = 0; n < 8; ++n) { \
                    sacc[0][n] = *(const f32x4*)&Fs[n * 16 + 4 * g]; sacc[1][n] = sacc[0][n];            \
                    _Pragma("unroll") for (int s2 = 0; s2 < 2; ++s2) { \
                        const bf16x8 kfr = *(const bf16x8*)&Ks[(n * 16 + qi) * LDK + 32 * s2 + 8 * g]; \
                        sacc[0][n] = __builtin_amdgcn_mfma_f32_16x16x32_bf16(kfr, qf[0][s2], sacc[0][n], 0, 0, 0); \
                        sacc[1][n] = __builtin_amdgcn_mfma_f32_16x16x32_bf16(kfr, qf[1][s2], sacc[1][n], 0, 0, 0); \
                    } \
                } \
                const bool diag = ((st) * 128 + 127 > wrow);         \
                bf16x8 pf[2][4]; \
                _Pragma("unroll") for (int t = 0; t < 2; ++t) { \
                    const int trow = wrow + 16 * t + qi; \
                    float mx = -INFINITY; \
                    _Pragma("unroll") for (int n = 0; n < 8; ++n) { \
                        _Pragma("unroll") for (int j = 0; j < 4; ++j) { \
                            float v = sacc[t][n][j]; \
                            if (diag) v = ((st) * 128 + n * 16 + 4 * g + j <= trow) ? v : -INFINITY; \
                            sacc[t][n][j] = v; mx = fmaxf(mx, v); \
                        } \
                    } \
                    mx = red32_max(red16_max(mx)); \
                    const float mn = fmaxf(m[t], mx); \
                    const float corr = __builtin_amdgcn_exp2f(m[t] - mn); \
                    m[t] = mn; \
                    float ps = 0.f; \
                    _Pragma("unroll") for (int n = 0; n < 8; ++n) \
                        _Pragma("unroll") for (int j = 0; j < 4; ++j) { const float e = __builtin_amdgcn_exp2f(sacc[t][n][j] - mn); sacc[t][n][j] = e; ps += e; } \
                    lsum[t] = lsum[t] * corr + ps; \
                    _Pragma("unroll") for (int dt = 0; dt < 4; ++dt) { oacc[t][dt][0] *= corr; oacc[t][dt][1] *= corr; oacc[t][dt][2] *= corr; oacc[t][dt][3] *= corr; } \
                    _Pragma("unroll") for (int ks = 0; ks < 4; ++ks) { \
                        uint4 w; \
                        w.x = pack2(sacc[t][2 * ks][0], sacc[t][2 * ks][1]); w.y = pack2(sacc[t][2 * ks][2], sacc[t][2 * ks][3]); \
                        w.z = pack2(sacc[t][2 * ks + 1][0], sacc[t][2 * ks + 1][1]); w.w = pack2(sacc[t][2 * ks + 1][2], sacc[t][2 * ks + 1][3]); \
                        pf[t][ks] = __builtin_bit_cast(bf16x8, w); \
                    } \
                } \
                _Pragma("unroll") for (int ks = 0; ks < 4; ++ks) \
                    _Pragma("unroll") for (int dt = 0; dt < 4; ++dt) { \
                        const v4i16_t lo = lds_tr(&Vs[((2 * ks) * 16 + 4 * g + tq) * LDK + dt * 16 + 4 * tp]); \
                        const v4i16_t hi = lds_tr(&Vs[((2 * ks + 1) * 16 + 4 * g + tq) * LDK + dt * 16 + 4 * tp]); \
                        const bf16x8 vfr = (bf16x8){lo[0], lo[1], lo[2], lo[3], hi[0], hi[1], hi[2], hi[3]}; \
                        oacc[0][dt] = __builtin_amdgcn_mfma_f32_16x16x32_bf16(vfr, pf[0][ks], oacc[0][dt], 0, 0, 0); \
                        oacc[1][dt] = __builtin_amdgcn_mfma_f32_16x16x32_bf16(vfr, pf[1][ks], oacc[1][dt], 0, 0, 0); \
                    } \
            } \
        } while (0)
#define FOX_STORE(K0, K1, V0, V1, FF, st_) do { bf16_t* Kw = (bf16_t*)(lds + ((st_) & 1) * BUFB); bf16_t* Vw = Kw + 128 * LDK; \
            *(uint4*)&Kw[skey * LDK + sc8] = K0; *(uint4*)&Kw[(skey + 64) * LDK + sc8] = K1; \
            *(uint4*)&Vw[skey * LDK + sc8] = V0; *(uint4*)&Vw[(skey + 64) * LDK + sc8] = V1; \
            if (tid < 128) ((float*)(Vw + 128 * LDK))[tid] = FF; } while (0)
        FOX_STORE(kA0, kA1, vA0, vA1, fA, 0);
        if (1 < nst) FOX_LOAD(kA0, kA1, vA0, vA1, fA, 1);
        __syncthreads();
#pragma unroll 1
        for (int st = 0; st < nst; ++st) {
            if (st + 1 < nst) { FOX_STORE(kA0, kA1, vA0, vA1, fA, st + 1); if (st + 2 < nst) FOX_LOAD(kA0, kA1, vA0, vA1, fA, st + 2); }
            FOX_COMPUTE(st);
            __syncthreads();
        }
#undef FOX_STORE
#undef FOX_LOAD
#undef FOX_COMPUTE
#pragma unroll
        for (int t = 0; t < 2; ++t) {
            float l = lsum[t];
            l = red32_sum(red16_sum(l));
            const float il = 1.f / l;
            const int trow = wrow + 16 * t + qi;
            bf16_t* op = DRY ? (bf16_t*)(p.ws + OFF_WIN) + ((size_t)b * SEQ + trow) * 128 + (h & 1) * 64 + 4 * g : P + ((size_t)b * SEQ + trow) * DIN + C_FQ + h * 64 + 4 * g;
#pragma unroll
            for (int dt = 0; dt < 4; ++dt) {
                uint2 o; o.x = pack2(oacc[t][dt][0] * il, oacc[t][dt][1] * il); o.y = pack2(oacc[t][dt][2] * il, oacc[t][dt][3] * il);
                *(uint2*)(op + dt * 16) = o;
            }
        }
    }
}

template <bool DRY = false>
DEV void phase_mlstm(const Params& p, int layer, char* lds) {
    constexpr int LDQ = 72, LDV = 136, LDO = 132;
    bf16_t* Qs = (bf16_t*)lds;
    bf16_t* Ks = Qs + 64 * LDQ;
    bf16_t* QD = Ks + 64 * LDQ;
    bf16_t* KW = QD + 64 * LDQ;
    bf16_t* VV = KW + 64 * LDQ;
    bf16_t* PP = VV + 64 * LDV;
    float* GT = (float*)(PP + 64 * LDQ);
    float* ECs = GT + 256;
    float* OS = ECs + 4;
    bf16_t* P = (bf16_t*)(p.ws + OFF_PROJ);
    const int tid = tid_op(), lane = tid & 63, wid = tid >> 6, qi = lane & 15, g = lane >> 4, tq = qi >> 2, tp = lane & 3;
    const int row0 = tid >> 4, col0 = (tid & 15) * 8;
    const int prow = tid >> 3, pch = (tid & 7) * 8;
    const short one_bf = (short)0x3F80;
    const bf16x8 ones = (bf16x8){one_bf, one_bf, one_bf, one_bf, one_bf, one_bf, one_bf, one_bf};
    for (int u = bid_op(); u < NB * 4; u += gridDim.x) {
        const int b = u >> 2, h = u & 3;
        lds_barrier();
        for (int i = tid; i < 64 * LDQ / 2; i += 512) ((unsigned*)PP)[i] = 0u;
        float gn[8];
#pragma unroll
        for (int j = 0; j < 8; ++j) gn[j] = p.in[I_MNG][layer * 512 + h * 128 + col0 + j];
        f32x4 Cst[4], Nst[4];
#pragma unroll
        for (int dt = 0; dt < 4; ++dt) { Cst[dt] = (f32x4){0.f, 0.f, 0.f, 0.f}; Nst[dt] = (f32x4){0.f, 0.f, 0.f, 0.f}; }
        const bf16_t* rowb = P + (size_t)b * SEQ * DIN;
        const bf16_t* mlb = (const bf16_t*)(p.ws + OFF_H) + (size_t)u * 32 * (4 * 64 * 64);
        const float* gbuf = (const float*)(p.ws + OFF_GBUF) + (size_t)u * SEQ * 4;
        const float* ecb = (const float*)(p.ws + OFF_ECBUF) + u * 32;
        const unsigned off_v = (unsigned)row0 * DIN + (unsigned)(C_MV + h * 128 + col0);
        const unsigned off_o = (unsigned)row0 * DIN + (unsigned)(C_MO + h * 128 + col0);
        const unsigned off_m = (unsigned)tid * 8u;
        uint4 m0, m1, m2, m3, rv0, rv1, rg0, rg1; f32x4 gt4 = (f32x4){0.f, 0.f, 0.f, 0.f}; float ecv = 0.f;
#define ML_PREFETCH(c_) do { const int c__ = (c_); const bf16_t* mb_ = mlb + (size_t)c__ * (4 * 64 * 64); const bf16_t* uv_ = rowb + (size_t)(c__ * 64) * DIN; \
            m0 = *(const uint4*)(mb_ + off_m); m1 = *(const uint4*)(mb_ + 4096 + off_m); m2 = *(const uint4*)(mb_ + 8192 + off_m); m3 = *(const uint4*)(mb_ + 12288 + off_m); \
            rv0 = *(const uint4*)(uv_ + off_v); rv1 = *(const uint4*)(uv_ + off_v + 32u * DIN); rg0 = *(const uint4*)(uv_ + off_o); rg1 = *(const uint4*)(uv_ + off_o + 32u * DIN); \
            if (tid < 64) gt4 = *(const f32x4*)(gbuf + (size_t)(c__ * 64 + tid) * 4); ecv = ecb[c__]; } while (0)
        ML_PREFETCH(0);
#pragma unroll 1
        for (int c = 0; c < SEQ / 64; ++c) {
            *(uint4*)&Qs[prow * LDQ + pch] = m0; *(uint4*)&Ks[prow * LDQ + pch] = m1; *(uint4*)&QD[prow * LDQ + pch] = m2; *(uint4*)&KW[prow * LDQ + pch] = m3;
            *(uint4*)&VV[row0 * LDV + col0] = rv0; *(uint4*)&VV[(row0 + 32) * LDV + col0] = rv1;
            if (tid < 64) *(f32x4*)&GT[tid * 4] = gt4;
            const float ec = ecv;
            const uint4 g0 = rg0, g1 = rg1;
            if (c + 1 < SEQ / 64) ML_PREFETCH(c + 1);
            lds_barrier();
            uint2 qa[4][2][2];
#pragma unroll
            for (int tt = 0; tt < 4; ++tt)
#pragma unroll
                for (int k2 = 0; k2 < 2; ++k2) {
                    qa[tt][k2][0] = *(const uint2*)&QD[(tt * 16 + qi) * LDQ + (2 * k2) * 16 + 4 * g];
                    qa[tt][k2][1] = *(const uint2*)&QD[(tt * 16 + qi) * LDQ + (2 * k2 + 1) * 16 + 4 * g];
                }
            bf16x8 vf[2];
#pragma unroll
            for (int ks = 0; ks < 2; ++ks) {
                const v4i16_t lo = lds_tr(&VV[(32 * ks + 8 * g + tq) * LDV + 16 * wid + 4 * tp]);
                const v4i16_t hi = lds_tr(&VV[(32 * ks + 8 * g + 4 + tq) * LDV + 16 * wid + 4 * tp]);
                vf[ks] = (bf16x8){lo[0], lo[1], lo[2], lo[3], hi[0], hi[1], hi[2], hi[3]};
            }
            asm volatile("" ::: "memory");
#pragma unroll
            for (int rep = 0; rep < 2; ++rep) {
                const int idx = wid + 8 * rep;
                if (idx < 10) {
                    const int tt = (idx >= 6) ? 3 : (idx >= 3) ? 2 : (idx >= 1) ? 1 : 0, st = idx - tt * (tt + 1) / 2;
                    f32x4 acc = (f32x4){0.f, 0.f, 0.f, 0.f};
                    const bf16x8 a0 = *(const bf16x8*)&Ks[(st * 16 + qi) * LDQ + 8 * g], a1 = *(const bf16x8*)&Ks[(st * 16 + qi) * LDQ + 32 + 8 * g];
                    const bf16x8 b0 = *(const bf16x8*)&Qs[(tt * 16 + qi) * LDQ + 8 * g], b1 = *(const bf16x8*)&Qs[(tt * 16 + qi) * LDQ + 32 + 8 * g];
                    const float bt = GT[(tt * 16 + qi) * 4];
                    f32x2 gsv[4];
#pragma unroll
                    for (int j = 0; j < 4; ++j) gsv[j] = *(const f32x2*)&GT[(st * 16 + 4 * g + j) * 4];
                    asm volatile("" ::: "memory");
                    acc = __builtin_amdgcn_mfma_f32_16x16x32_bf16(a0, b0, acc, 0, 0, 0);
                    acc = __builtin_amdgcn_mfma_f32_16x16x32_bf16(a1, b1, acc, 0, 0, 0);
#pragma unroll
                    for (int j = 0; j < 4; ++j) {
                        const bool valid = (st < tt) || (4 * g + j <= qi);
                        acc[j] = valid ? acc[j] * __expf(bt - gsv[j][0] + gsv[j][1]) : 0.f;
                    }
                    uint2 w; w.x = pack2(acc[0], acc[1]); w.y = pack2(acc[2], acc[3]);
                    *(uint2*)&PP[(tt * 16 + qi) * LDQ + st * 16 + 4 * g] = w;
                }
            }
            bf16x8 kfa[4][2];
#pragma unroll
            for (int dt = 0; dt < 4; ++dt)
#pragma unroll
                for (int ks = 0; ks < 2; ++ks) {
                    const v4i16_t lo = lds_tr(&KW[(32 * ks + 8 * g + tq) * LDQ + dt * 16 + 4 * tp]);
                    const v4i16_t hi = lds_tr(&KW[(32 * ks + 8 * g + 4 + tq) * LDQ + dt * 16 + 4 * tp]);
                    kfa[dt][ks] = (bf16x8){lo[0], lo[1], lo[2], lo[3], hi[0], hi[1], hi[2], hi[3]};
                }
            asm volatile("" ::: "memory");
            f32x4 o[4], dn[4];
            {
                bf16x8 cp[2], np[2];
#pragma unroll
                for (int k2 = 0; k2 < 2; ++k2) {
                    uint4 w;
                    w.x = pack2(Cst[2 * k2][0], Cst[2 * k2][1]); w.y = pack2(Cst[2 * k2][2], Cst[2 * k2][3]);
                    w.z = pack2(Cst[2 * k2 + 1][0], Cst[2 * k2 + 1][1]); w.w = pack2(Cst[2 * k2 + 1][2], Cst[2 * k2 + 1][3]);
                    cp[k2] = __builtin_bit_cast(bf16x8, w);
                    w.x = pack2(Nst[2 * k2][0], Nst[2 * k2][1]); w.y = pack2(Nst[2 * k2][2], Nst[2 * k2][3]);
                    w.z = pack2(Nst[2 * k2 + 1][0], Nst[2 * k2 + 1][1]); w.w = pack2(Nst[2 * k2 + 1][2], Nst[2 * k2 + 1][3]);
                    np[k2] = __builtin_bit_cast(bf16x8, w);
                }
#pragma unroll
                for (int tt = 0; tt < 4; ++tt) {
                    o[tt] = (f32x4){0.f, 0.f, 0.f, 0.f}; dn[tt] = (f32x4){0.f, 0.f, 0.f, 0.f};
#pragma unroll
                    for (int k2 = 0; k2 < 2; ++k2) {
                        const uint2 a0 = qa[tt][k2][0], a1 = qa[tt][k2][1];
                        const bf16x8 af = __builtin_bit_cast(bf16x8, make_uint4(a0.x, a0.y, a1.x, a1.y));
                        o[tt] = __builtin_amdgcn_mfma_f32_16x16x32_bf16(af, cp[k2], o[tt], 0, 0, 0);
                        dn[tt] = __builtin_amdgcn_mfma_f32_16x16x32_bf16(af, np[k2], dn[tt], 0, 0, 0);
                    }
                }
            }
#pragma unroll
            for (int dt = 0; dt < 4; ++dt) {
#pragma unroll
                for (int j = 0; j < 4; ++j) { Cst[dt][j] *= ec; Nst[dt][j] *= ec; }
#pragma unroll
                for (int ks = 0; ks < 2; ++ks) {
                    const bf16x8 kfr = kfa[dt][ks];
                    Cst[dt] = __builtin_amdgcn_mfma_f32_16x16x32_bf16(kfr, vf[ks], Cst[dt], 0, 0, 0);
                    Nst[dt] = __builtin_amdgcn_mfma_f32_16x16x32_bf16(kfr, ones, Nst[dt], 0, 0, 0);
                }
            }
            lds_barrier();
            bf16x8 pa[4][2];
#pragma unroll
            for (int tt = 0; tt < 4; ++tt)
#pragma unroll
                for (int ks = 0; ks < 2; ++ks)
                    if (ks <= (tt >> 1)) pa[tt][ks] = *(const bf16x8*)&PP[(tt * 16 + qi) * LDQ + 32 * ks + 8 * g];
            asm volatile("" ::: "memory");
#pragma unroll
            for (int tt = 0; tt < 4; ++tt)
#pragma unroll
                for (int ks = 0; ks < 2; ++ks)
                    if (ks <= (tt >> 1)) {
                        o[tt] = __builtin_amdgcn_mfma_f32_16x16x32_bf16(pa[tt][ks], vf[ks], o[tt], 0, 0, 0);
                        dn[tt] = __builtin_amdgcn_mfma_f32_16x16x32_bf16(pa[tt][ks], ones, dn[tt], 0, 0, 0);
                    }
#pragma unroll
            for (int tt = 0; tt < 4; ++tt)
#pragma unroll
                for (int j = 0; j < 4; ++j) {
                    const float den = dn[tt][j];
                    OS[(tt * 16 + 4 * g + j) * LDO + 16 * wid + qi] = o[tt][j] * __builtin_amdgcn_rcpf(fmaxf(fabsf(den), 1.f));
                }
            lds_barrier();
            bf16_t* uo = (bf16_t*)rowb + (size_t)(c * 64) * DIN;
#pragma unroll
            for (int i = 0; i < 2; ++i) {
                const int row = row0 + 32 * i;
                const f32x4 oa = *(const f32x4*)&OS[row * LDO + col0], ob = *(const f32x4*)&OS[row * LDO + col0 + 4];
                float ss = oa[0] * oa[0] + oa[1] * oa[1] + oa[2] * oa[2] + oa[3] * oa[3] + ob[0] * ob[0] + ob[1] * ob[1] + ob[2] * ob[2] + ob[3] * ob[3];
                ss = sum16(ss);
                const float rstd = rsqrtf(ss * (1.f / 128.f) + 1e-6f);
                float gg[8]; unpack8((i == 0) ? g0 : g1, gg);
#pragma unroll
                for (int j = 0; j < 8; ++j) gg[j] = fsigmoid(gg[j]) * gn[j];
                uint4 w;
                w.x = pack2(oa[0] * rstd * gg[0], oa[1] * rstd * gg[1]); w.y = pack2(oa[2] * rstd * gg[2], oa[3] * rstd * gg[3]);
                w.z = pack2(ob[0] * rstd * gg[4], ob[1] * rstd * gg[5]); w.w = pack2(ob[2] * rstd * gg[6], ob[3] * rstd * gg[7]);
                if constexpr (DRY) *(uint4*)((bf16_t*)(p.ws + OFF_WIN) + ((size_t)b * SEQ + c * 64 + row) * 128 + col0) = w;
                else *(uint4*)(uo + off_o + (unsigned)(32 * i) * DIN) = w;
            }
        }
#undef ML_PREFETCH
    }
}

template <bool DRY = false>
DEV void phase_hgrn(const Params& p, int layer, char* lds) {
    constexpr int LDA = 136, LDP = 72, LDO = 132;
    bf16_t* QM = (bf16_t*)lds;
    bf16_t* KM = QM + 64 * LDA;
    bf16_t* VV = KM + 64 * LDA;
    bf16_t* PP = VV + 64 * LDA;
    float* EM = (float*)(PP + 64 * LDP);
    float* EC = EM + 128;
    float* EK = EC + 128;
    float* OS = EK + 128;
    bf16_t* P = (bf16_t*)(p.ws + OFF_PROJ);
    const int tid = tid_op(), lane = tid & 63, wid = tid >> 6, qi = lane & 15, g = lane >> 4, tq = qi >> 2, tp = lane & 3;
    const int row0 = tid >> 4, col0 = (tid & 15) * 8;
    for (int u = (bid_op() + (int)gridDim.x - 64) % (int)gridDim.x; u < NB * 4; u += gridDim.x) {
        const int b = u >> 2, h = u & 3;
        float gn[8];
#pragma unroll
        for (int j = 0; j < 8; ++j) gn[j] = p.in[I_HNG][layer * 512 + h * 128 + col0 + j];
        lds_barrier();
        for (int i = tid; i < 64 * LDP / 2; i += 512) ((unsigned*)PP)[i] = 0u;
        f32x4 S[8];
#pragma unroll
        for (int dt = 0; dt < 8; ++dt) S[dt] = (f32x4){0.f, 0.f, 0.f, 0.f};
        bf16_t* gbase = P + ((size_t)b * SEQ + row0) * DIN + h * 128 + col0;
        const float* evb = (const float*)(p.ws + OFF_EVBUF) + (size_t)u * 32 * 384;
        uint4 q0r, q1r, k0r, k1r, v0r, v1r, g0r, g1r; f32x4 ev4 = (f32x4){0.f, 0.f, 0.f, 0.f};
#define HG_PREFETCH(c_) do { const bf16_t* rp_ = gbase + (size_t)((c_) * 64) * DIN; \
            q0r = *(const uint4*)(rp_ + C_HQ); q1r = *(const uint4*)(rp_ + (size_t)32 * DIN + C_HQ); k0r = *(const uint4*)(rp_ + C_HF); k1r = *(const uint4*)(rp_ + (size_t)32 * DIN + C_HF); \
            v0r = *(const uint4*)(rp_ + C_HI); v1r = *(const uint4*)(rp_ + (size_t)32 * DIN + C_HI); g0r = *(const uint4*)(rp_ + C_HG); g1r = *(const uint4*)(rp_ + (size_t)32 * DIN + C_HG); \
            if (tid < 96) ev4 = *(const f32x4*)(evb + (size_t)(c_) * 384 + tid * 4); } while (0)
        HG_PREFETCH(0);
#pragma unroll 1
        for (int c = 0; c < SEQ / 64; ++c) {
            *(uint4*)&QM[row0 * LDA + col0] = q0r; *(uint4*)&QM[(row0 + 32) * LDA + col0] = q1r;
            *(uint4*)&KM[row0 * LDA + col0] = k0r; *(uint4*)&KM[(row0 + 32) * LDA + col0] = k1r;
            *(uint4*)&VV[row0 * LDA + col0] = v0r; *(uint4*)&VV[(row0 + 32) * LDA + col0] = v1r;
            if (tid < 96) *(f32x4*)&EM[tid * 4] = ev4;
            const uint4 rg0 = g0r, rg1 = g1r;
            if (c + 1 < SEQ / 64) HG_PREFETCH(c + 1);
            lds_barrier();
            f32x4 emv[8];
#pragma unroll
            for (int k = 0; k < 8; ++k) emv[k] = *(const f32x4*)&EM[k * 16 + 4 * g];
            uint2 qa[4][4][2];
#pragma unroll
            for (int tt = 0; tt < 4; ++tt)
#pragma unroll
                for (int k2 = 0; k2 < 4; ++k2) {
                    qa[tt][k2][0] = *(const uint2*)&QM[(tt * 16 + qi) * LDA + (2 * k2) * 16 + 4 * g];
                    qa[tt][k2][1] = *(const uint2*)&QM[(tt * 16 + qi) * LDA + (2 * k2 + 1) * 16 + 4 * g];
                }
            bf16x8 sp[4];
#pragma unroll
            for (int k2 = 0; k2 < 4; ++k2) {
                const f32x4 e0 = emv[2 * k2], e1 = emv[2 * k2 + 1];
                uint4 w;
                w.x = pack2(S[2 * k2][0] * e0[0], S[2 * k2][1] * e0[1]); w.y = pack2(S[2 * k2][2] * e0[2], S[2 * k2][3] * e0[3]);
                w.z = pack2(S[2 * k2 + 1][0] * e1[0], S[2 * k2 + 1][1] * e1[1]); w.w = pack2(S[2 * k2 + 1][2] * e1[2], S[2 * k2 + 1][3] * e1[3]);
                sp[k2] = __builtin_bit_cast(bf16x8, w);
            }
            asm volatile("" ::: "memory");
#pragma unroll
            for (int rep = 0; rep < 2; ++rep) {
                const int idx = wid + 8 * rep;
                if (idx < 10) {
                    const int tt = (idx >= 6) ? 3 : (idx >= 3) ? 2 : (idx >= 1) ? 1 : 0, st = idx - tt * (tt + 1) / 2;
                    f32x4 acc = (f32x4){0.f, 0.f, 0.f, 0.f};
#pragma unroll
                    for (int ks = 0; ks < 4; ++ks) {
                        const bf16x8 a = *(const bf16x8*)&KM[(st * 16 + qi) * LDA + 32 * ks + 8 * g];
                        const bf16x8 bq = *(const bf16x8*)&QM[(tt * 16 + qi) * LDA + 32 * ks + 8 * g];
                        acc = __builtin_amdgcn_mfma_f32_16x16x32_bf16(a, bq, acc, 0, 0, 0);
                    }
                    if (tt == st) {
#pragma unroll
                        for (int j = 0; j < 4; ++j) if (4 * g + j > qi) acc[j] = 0.f;
                    }
                    uint2 w; w.x = pack2(acc[0], acc[1]); w.y = pack2(acc[2], acc[3]);
                    *(uint2*)&PP[(tt * 16 + qi) * LDP + st * 16 + 4 * g] = w;
                }
            }
            bf16x8 vf[2];
#pragma unroll
            for (int ks = 0; ks < 2; ++ks) {
                const v4i16_t lo = lds_tr(&VV[(32 * ks + 8 * g + tq) * LDA + 16 * wid + 4 * tp]);
                const v4i16_t hi = lds_tr(&VV[(32 * ks + 8 * g + 4 + tq) * LDA + 16 * wid + 4 * tp]);
                vf[ks] = (bf16x8){lo[0], lo[1], lo[2], lo[3], hi[0], hi[1], hi[2], hi[3]};
            }
            bf16x8 kfa[4][2]; f32x4 ecv[4], ekv[4];
#define HG_LOADK(h_) do { _Pragma("unroll") for (int d4 = 0; d4 < 4; ++d4) { const int dt = (h_) * 4 + d4; \
                _Pragma("unroll") for (int ks = 0; ks < 2; ++ks) { \
                    const v4i16_t lo = lds_tr(&KM[(32 * ks + 8 * g + tq) * LDA + dt * 16 + 4 * tp]); \
                    const v4i16_t hi = lds_tr(&KM[(32 * ks + 8 * g + 4 + tq) * LDA + dt * 16 + 4 * tp]); \
                    kfa[d4][ks] = (bf16x8){lo[0], lo[1], lo[2], lo[3], hi[0], hi[1], hi[2], hi[3]}; } \
                ecv[d4] = *(const f32x4*)&EC[dt * 16 + 4 * g]; ekv[d4] = *(const f32x4*)&EK[dt * 16 + 4 * g]; } } while (0)
#define HG_UPD(h_) do { f32x4 Ta[4]; _Pragma("unroll") for (int d4 = 0; d4 < 4; ++d4) Ta[d4] = (f32x4){0.f, 0.f, 0.f, 0.f}; \
                _Pragma("unroll") for (int ks = 0; ks < 2; ++ks) _Pragma("unroll") for (int d4 = 0; d4 < 4; ++d4) Ta[d4] = __builtin_amdgcn_mfma_f32_16x16x32_bf16(kfa[d4][ks], vf[ks], Ta[d4], 0, 0, 0); \
                _Pragma("unroll") for (int d4 = 0; d4 < 4; ++d4) _Pragma("unroll") for (int j = 0; j < 4; ++j) S[(h_) * 4 + d4][j] = ecv[d4][j] * S[(h_) * 4 + d4][j] + ekv[d4][j] * Ta[d4][j]; } while (0)
            HG_LOADK(0);
            asm volatile("" ::: "memory");
            f32x4 o[4] = {{0.f,0.f,0.f,0.f},{0.f,0.f,0.f,0.f},{0.f,0.f,0.f,0.f},{0.f,0.f,0.f,0.f}};
            {
#pragma unroll
                for (int k2 = 0; k2 < 4; ++k2)
#pragma unroll
                    for (int tt = 0; tt < 4; ++tt) {
                        const uint2 a0 = qa[tt][k2][0], a1 = qa[tt][k2][1];
                        const uint4 w = make_uint4(a0.x, a0.y, a1.x, a1.y);
                        o[tt] = __builtin_amdgcn_mfma_f32_16x16x32_bf16(__builtin_bit_cast(bf16x8, w), sp[k2], o[tt], 0, 0, 0);
                    }
            }
            { HG_UPD(0); HG_LOADK(1); asm volatile("" ::: "memory"); HG_UPD(1); }
#undef HG_LOADK
#undef HG_UPD
            lds_barrier();
#pragma unroll
            for (int tt = 0; tt < 4; ++tt)
#pragma unroll
                for (int ks = 0; ks < 2; ++ks)
                    if (ks <= (tt >> 1)) {
                        const bf16x8 a = *(const bf16x8*)&PP[(tt * 16 + qi) * LDP + 32 * ks + 8 * g];
                        o[tt] = __builtin_amdgcn_mfma_f32_16x16x32_bf16(a, vf[ks], o[tt], 0, 0, 0);
                    }
#pragma unroll
            for (int tt = 0; tt < 4; ++tt)
#pragma unroll
                for (int j = 0; j < 4; ++j) OS[(tt * 16 + 4 * g + j) * LDO + 16 * wid + qi] = o[tt][j];
            lds_barrier();
#pragma unroll
            for (int i = 0; i < 2; ++i) {
                const int row = row0 + 32 * i;
                const f32x4 oa = *(const f32x4*)&OS[row * LDO + col0], ob = *(const f32x4*)&OS[row * LDO + col0 + 4];
                float ss = oa[0] * oa[0] + oa[1] * oa[1] + oa[2] * oa[2] + oa[3] * oa[3] + ob[0] * ob[0] + ob[1] * ob[1] + ob[2] * ob[2] + ob[3] * ob[3];
                ss = sum16(ss);
                const float rstd = rsqrtf(ss * (1.f / 128.f) + 1e-6f);
                float gg[8]; unpack8((i == 0) ? rg0 : rg1, gg);
#pragma unroll
                for (int j = 0; j < 8; ++j) gg[j] = fsilu(gg[j]) * gn[j];
                uint4 w;
                w.x = pack2(oa[0] * rstd * gg[0], oa[1] * rstd * gg[1]); w.y = pack2(oa[2] * rstd * gg[2], oa[3] * rstd * gg[3]);
                w.z = pack2(ob[0] * rstd * gg[4], ob[1] * rstd * gg[5]); w.w = pack2(ob[2] * rstd * gg[6], ob[3] * rstd * gg[7]);
                if constexpr (DRY) *(uint4*)((bf16_t*)(p.ws + OFF_WIN) + ((size_t)b * SEQ + c * 64 + row) * 128 + col0) = w;
                else *(uint4*)(gbase + (size_t)(c * 64 + 32 * i) * DIN + C_HG) = w;
            }
        }
#undef HG_PREFETCH
    }
}

#define XB_TMO      128
#define XB_XCNT(j)  (256  + 64 * (j))
#define XB_XSUB(j)  (1280 + 64 * (j))
#define XB_XGEN(j)  (2304 + 64 * (j))
#define XB_TOP      3328
#define XB_TOPGEN   3392
#define XCD_BAR_WORDS 3456
#define XB_SPIN_CAP (1u << 18)
__device__ __forceinline__ unsigned xb_ld(unsigned* p)              { return __hip_atomic_load(p, __ATOMIC_RELAXED, __HIP_MEMORY_SCOPE_AGENT); }
__device__ __forceinline__ unsigned xb_add(unsigned* p, unsigned v) { return __hip_atomic_fetch_add(p, v, __ATOMIC_RELAXED, __HIP_MEMORY_SCOPE_AGENT); }
__device__ __forceinline__ unsigned xb_xcc_id() { return (unsigned)__builtin_amdgcn_s_getreg((3 << 11) | 20) & 0xFu; }
#define XB_SPIN(cond, bar) do { unsigned _sp = 0; while (cond) { __builtin_amdgcn_s_sleep(1); \
    if ((++_sp & 255u) == 0u) { if (xb_ld(&(bar)[XB_TMO])) break; if (_sp > XB_SPIN_CAP) { atomicAdd(&(bar)[XB_TMO], 1u); break; } } } } while (0)
struct XcdBarrier { unsigned* bar; unsigned x; volatile LAS unsigned* st; };
__device__ __forceinline__ XcdBarrier xcd_barrier_post(unsigned* bar, volatile LAS unsigned* st) {
    XcdBarrier b; b.bar = bar; b.x = xb_xcc_id(); b.st = st;
    if (threadIdx.x == 0) (void)xb_add(&bar[XB_XCNT(b.x)], 1u);
    return b;
}
__device__ __forceinline__ void xcd_barrier_complete(unsigned* bar, unsigned x, unsigned& nloc, unsigned& nx) {
    const unsigned G = gridDim.x * gridDim.y * gridDim.z;
    unsigned sum, cnt, mine, sp = 0u;
    for (;;) {
        sum = 0u; cnt = 0u; mine = 0u;
#pragma unroll
        for (unsigned j = 0; j < 16; ++j) { const unsigned c = xb_ld(&bar[XB_XCNT(j)]); sum += c; cnt += (c > 0u) ? 1u : 0u; mine = (j == x) ? c : mine; }
        if (sum == G) break;
        __builtin_amdgcn_s_sleep(1);
        if ((++sp & 255u) == 0u) { if (xb_ld(&bar[XB_TMO])) break; if (sp > XB_SPIN_CAP) { atomicAdd(&bar[XB_TMO], 1u); break; } }
    }
    nloc = mine > 0u ? mine : 1u; nx = cnt > 0u ? cnt : 1u;
}
__device__ __forceinline__ void xcd_barrier(const XcdBarrier& b) {
    asm volatile("s_waitcnt vmcnt(0)" ::: "memory");
    __syncthreads();
    if (threadIdx.x == 0) {
        unsigned* bar = b.bar;
        __builtin_amdgcn_s_waitcnt(0);
        unsigned nloc = b.st[0], nx = b.st[1];
        if (nloc == 0u) { xcd_barrier_complete(bar, b.x, nloc, nx); b.st[0] = nloc; b.st[1] = nx; }
        const unsigned old = xb_add(&bar[XB_XSUB(b.x)], 1u);
        const unsigned gen = old / nloc;
        if (old + 1u == (gen + 1u) * nloc) {
            __builtin_amdgcn_fence(__ATOMIC_RELEASE, "agent");
            asm volatile("s_waitcnt vmcnt(0)" ::: "memory");
            const unsigned og = xb_add(&bar[XB_TOP], 1u);
            const unsigned tg = og / nx;
            if (og + 1u == (tg + 1u) * nx) xb_add(&bar[XB_TOPGEN], 1u);
            else XB_SPIN(xb_ld(&bar[XB_TOPGEN]) == tg, bar);
            __builtin_amdgcn_fence(__ATOMIC_ACQUIRE, "agent");
            xb_add(&bar[XB_XGEN(b.x)], 1u);
            asm volatile("s_waitcnt vmcnt(0)" ::: "memory");
        } else {
            XB_SPIN(xb_ld(&bar[XB_XGEN(b.x)]) == gen, bar);
            __builtin_amdgcn_fence(__ATOMIC_ACQUIRE, "agent");
            asm volatile("s_waitcnt vmcnt(0)" ::: "memory");
        }
    }
    __syncthreads();
}

constexpr int LDS_BYTES = 131072 + 16 + TL_PAD * 4 + 2 * 256 * 4 + 512;
__global__ void __launch_bounds__(512, 2) mega_fwd(Params p) {
    extern __shared__ __attribute__((aligned(16))) char lds_all[];
    char* lds = lds_all + 16;
    if (threadIdx.x == 0) *(uint4*)lds_all = make_uint4(0u, 0u, 0u, 0u);
    __syncthreads();
    (void)xcd_barrier_post((unsigned*)(p.ws + OFF_CTL), (volatile LAS unsigned*)lds_all);
#define GRID_BAR() do { XcdBarrier b_; b_.bar = (unsigned*)(p.ws + OFF_CTL); b_.x = xb_xcc_id(); b_.st = (volatile LAS unsigned*)lds_all; xcd_barrier(b_); } while (0)
    bf16_t* Hb = (bf16_t*)(p.ws + OFF_H);
    phase_convert_mix(p, 0, lds);
    phase_ada(p, lds);
    GRID_BAR();
    phase_norm(p, p.in[I_X], 0, 0, Hb);
    GRID_BAR();
#pragma unroll 1
    for (int layer = 0; layer < 2; ++layer) {
        phase_inproj(p, lds);
        GRID_BAR();
        phase_prep(p, layer, lds);
        GRID_BAR();
        phase_mlstm(p, layer, lds);
        phase_hgrn(p, layer, lds);
        phase_fox(p, layer, lds);
        GRID_BAR();
        phase_merge(p, lds);
        GRID_BAR();
        phase_out(p, layer, lds);
        GRID_BAR();
        phase_front(p, layer, lds);
        GRID_BAR();
#pragma unroll 1
        for (int half = 0; half < NHALF; ++half) {
            phase_moe_up(p, layer, half, lds);
            GRID_BAR();
            phase_moe_down(p, half, lds);
            GRID_BAR();
            phase_combine(p, layer, half, lds);
            if (layer == 0 && half == NHALF - 1) phase_convert_mix(p, 1, lds);
            GRID_BAR();
        }
    }
}

extern "C" void kernel_launch(void* const* d_in, const int* in_sizes, int n_in, void* d_out, int out_size, void* d_ws, size_t ws_size, hipStream_t stream) {
    (void)in_sizes; (void)n_in; (void)out_size; (void)ws_size;
    Params p{};
    for (int i = 0; i < 26; ++i) p.in[i] = (const float*)d_in[i];
    p.out = (float*)d_out;
    p.ws = (unsigned char*)d_ws;
    static int grid = 0;
    if (!grid) {
        int dev = 0, cus = 0, per_cu = 0;
        (void)hipGetDevice(&dev);
        (void)hipDeviceGetAttribute(&cus, hipDeviceAttributeMultiprocessorCount, dev);
        (void)hipFuncSetAttribute((const void*)mega_fwd, hipFuncAttributeMaxDynamicSharedMemorySize, LDS_BYTES);
        (void)hipOccupancyMaxActiveBlocksPerMultiprocessor(&per_cu, mega_fwd, 512, LDS_BYTES);
        if (cus <= 0) cus = 256;
        grid = cus * (per_cu < 1 ? per_cu : 1);
        if (grid <= 0) grid = cus;
        if (grid > 256) grid = 256;
    }
    (void)hipMemsetAsync(d_ws, 0, CTL_BYTES, stream);
    hipLaunchKernelGGL(mega_fwd, dim3(grid), dim3(512), LDS_BYTES, stream, p);
}
```

```cpp
#include <hip/hip_runtime.h>
#include <stdint.h>
#include <stddef.h>

#define DEV __device__ __forceinline__
typedef unsigned short bf16_t;
typedef short bf16x8 __attribute__((ext_vector_type(8)));
typedef float f32x4 __attribute__((ext_vector_type(4)));
typedef float f32x2 __attribute__((ext_vector_type(2)));
typedef __bf16 bf16x2_t __attribute__((ext_vector_type(2)));

constexpr int T = 32768, DM = 1024, NB = 16, SEQ = 2048, NIN = 8208;
constexpr int O_FQ = 0, O_FK = 512, O_FV = 1024, O_FF = 1536, O_MQK = 1544, O_MV = 2056, O_MI = 2568, O_MF = 2572, O_MO = 2576,
              O_HF = 3088, O_HQ = 3600, O_HI = 4112, O_HG = 4624, O_GATES = 5136;
constexpr int DIN = 8256;
constexpr int C_FQ = 0, C_FK = 512, C_FV = 1024, C_MQK = 1536, C_MV = 2048, C_MO = 2560, C_HF = 3072, C_HQ = 3584, C_HI = 4096, C_HG = 4608, C_GATES = 5120,
              C_FF = 8192, C_MI = 8200, C_MF = 8204;
static_assert((DIN * 2) % 128 == 0 && C_MF + 4 <= DIN && C_GATES * 2 + 3072 <= C_FF * 2, "proj row layout");
constexpr int C_MERGED = 512;
constexpr int NEXP = 64, TOPK = 8, NLIST = 65, NHALF = 1, HALF_T = T / NHALF, NSLOT = 9;
constexpr int ROWCAP = 311296;
constexpr int TILECAP = ROWCAP / 256;
constexpr int TL_PAD = (TILECAP + 63) / 64 * 64;

constexpr size_t AL(size_t x) { return (x + 255) & ~(size_t)255; }
constexpr size_t OFF_CTL = 0;
constexpr size_t OFF_CNT = 32768;
constexpr int CNT_STRIDE = 32;
constexpr size_t OFF_QCTR = 65536;
constexpr size_t CTL_BYTES = 131072;
constexpr size_t OFF_MOD = CTL_BYTES;
constexpr size_t OFF_GS = AL(OFF_MOD + (size_t)2 * 16 * 6144 * 4);
constexpr size_t OFF_IDX = AL(OFF_GS + (size_t)T * 16 * 4);
constexpr size_t OFF_WTS = AL(OFF_IDX + (size_t)T * 8 * 4);
constexpr size_t OFF_RANK = AL(OFF_WTS + (size_t)T * 8 * 4);
constexpr size_t OFF_POS = AL(OFF_RANK + (size_t)T * 8 * 4);
constexpr size_t OFF_TILEL = AL(OFF_POS + (size_t)T * NSLOT * 4);
constexpr size_t OFF_WIN = AL(OFF_TILEL + (size_t)NHALF * (TILECAP + 16) * 4);
constexpr size_t OFF_WG8 = AL(OFF_WIN + (size_t)2816 * 1024 * 2);
constexpr size_t OFF_WBR = AL(OFF_WG8 + (size_t)5632 * 1024);
constexpr size_t OFF_WOUT = AL(OFF_WBR + (size_t)3 * 1024 * 512 * 2);
constexpr size_t OFF_WRT = AL(OFF_WOUT + (size_t)1024 * 1024 * 2);
constexpr size_t OFF_H = AL(OFF_WRT + (size_t)256 * 1024 * 2);
constexpr size_t OFF_H2F8 = OFF_H + (size_t)T * 1024;
constexpr size_t OFF_PROJ = AL(OFF_H + (size_t)T * 1024 * 2);
constexpr size_t OFF_END = AL(OFF_PROJ + (size_t)T * DIN * 2);
constexpr size_t OFF_W13 = OFF_PROJ;
constexpr size_t OFF_HID = AL(OFF_W13 + (size_t)NLIST * 512 * 1024);
constexpr size_t OFF_OUTA = AL(OFF_HID + (size_t)ROWCAP * 256);
constexpr size_t OFF_MOE_END = AL(OFF_OUTA + (size_t)ROWCAP * 1024);
constexpr size_t OFF_XB = OFF_MOE_END;
constexpr size_t OFF_W2 = OFF_MOE_END + (size_t)T * 2048;
static_assert(OFF_XB + (size_t)T * 2048 + (size_t)NEXP * 1024 * 256 <= OFF_END, "x1 rows and the routed down weights must fit behind the MoE overlay");
constexpr size_t OFF_FBUF = OFF_END;
constexpr size_t OFF_GBUF = AL(OFF_FBUF + (size_t)128 * SEQ * 4);
constexpr size_t OFF_ECBUF = AL(OFF_GBUF + (size_t)64 * SEQ * 16);
constexpr size_t OFF_EVBUF = AL(OFF_ECBUF + (size_t)64 * 32 * 4);
constexpr size_t OFF_H8 = AL(OFF_EVBUF + (size_t)64 * 32 * 384 * 4);
constexpr size_t OFF_W2S = AL(OFF_H8 + (size_t)T * 1024);
constexpr size_t OFF_EROW = AL(OFF_W2S + (size_t)1024 * 256 * 2);
constexpr size_t OFF_END2 = AL(OFF_EROW + (size_t)NLIST * T * 4);
static_assert((size_t)NEXP * 1024 * 256 * 2 <= (size_t)T * 1024, "routed W2 fits the lower half of H");
static_assert(OFF_MOE_END <= OFF_END, "MoE overlay must fit inside proj region");
static_assert(OFF_END2 <= (size_t)682 * 1000 * 1000, "workspace too large");
static_assert((size_t)64 * 32 * 4 * 64 * 64 * 2 <= (size_t)T * 1024 * 2, "mLSTM operand blocks fit the H region");

struct Params {
    const float* in[26];
    float* out;
    unsigned char* ws;
};
enum { I_X = 0, I_C, I_ADAW, I_ADAB, I_N1G, I_N2G, I_WIN, I_FOXBF, I_FOXQG, I_FOXKG, I_MCONV, I_MBI, I_MBF, I_MNG, I_HLB, I_HNG,
       I_WBR, I_WOUT, I_RW, I_RB, I_EW1, I_EW3, I_EW2, I_SW1, I_SW3, I_SW2 };

DEV int tid_op() { int t = threadIdx.x; asm volatile("" : "+v"(t)); return t; }
DEV int bid_op() { int b = blockIdx.x; asm volatile("" : "+s"(b)); return b; }
DEV float bf2f(bf16_t v) { return __uint_as_float((unsigned)v << 16); }
DEV unsigned pack2(float lo, float hi) { f32x2 v = {lo, hi}; bf16x2_t b = __builtin_convertvector(v, bf16x2_t); return __builtin_bit_cast(unsigned, b); }
DEV bf16_t f2bf(float f) { return (bf16_t)(pack2(f, 0.f) & 0xffffu); }
DEV float sigmoid_f(float x) { return 1.f / (1.f + __expf(-x)); }
DEV float silu_f(float x) { return x / (1.f + __expf(-x)); }
DEV float fsigmoid(float x) { return __builtin_amdgcn_rcpf(1.f + __expf(-x)); }
DEV float fsilu(float x) { return x * __builtin_amdgcn_rcpf(1.f + __expf(-x)); }
DEV unsigned pack4_fp8(float a, float b, float c, float d) {
    a = __builtin_amdgcn_fmed3f(a, -448.f, 448.f); b = __builtin_amdgcn_fmed3f(b, -448.f, 448.f); c = __builtin_amdgcn_fmed3f(c, -448.f, 448.f); d = __builtin_amdgcn_fmed3f(d, -448.f, 448.f);
    int v = __builtin_amdgcn_cvt_pk_fp8_f32(a, b, 0, false); v = __builtin_amdgcn_cvt_pk_fp8_f32(c, d, v, true); return (unsigned)v;
}
constexpr float F8_ACT_SCALE = 8.f, F8_W_SCALE = 64.f;
DEV float logsigmoid_f(float x) { return fminf(x, 0.f) - log1pf(__expf(-fabsf(x))); }
DEV int lane_op() { int l = (int)__builtin_amdgcn_mbcnt_hi(~0u, __builtin_amdgcn_mbcnt_lo(~0u, 0u)); asm volatile("" : "+v"(l)); return l; }
DEV float sx(float v, int o) { return __builtin_bit_cast(float, __builtin_amdgcn_ds_bpermute((lane_op() ^ o) << 2, __builtin_bit_cast(int, v))); }
DEV float sfrom(float v, int src) { return __builtin_bit_cast(float, __builtin_amdgcn_ds_bpermute(src << 2, __builtin_bit_cast(int, v))); }
DEV float sup(float v, int o) { const int l = lane_op(); return __builtin_bit_cast(float, __builtin_amdgcn_ds_bpermute(((l >= o) ? l - o : l) << 2, __builtin_bit_cast(int, v))); }
typedef unsigned u32x2v __attribute__((ext_vector_type(2)));
#define DPPF(v, ctrl) __builtin_bit_cast(float, __builtin_amdgcn_update_dpp(0, __builtin_bit_cast(int, (v)), (ctrl), 0xF, 0xF, true))
DEV float sum4(float v) { v += DPPF(v, 0xB1); v += DPPF(v, 0x4E); return v; }
DEV float sum8(float v) { v = sum4(v); v += DPPF(v, 0x141); return v; }
DEV float sum16(float v) { v = sum8(v); v += DPPF(v, 0x140); return v; }
DEV float max8(float v) { v = fmaxf(v, DPPF(v, 0xB1)); v = fmaxf(v, DPPF(v, 0x4E)); v = fmaxf(v, DPPF(v, 0x141)); return v; }
#define SWAP_RED(NAME, INS, OP) DEV float NAME(float v) { float a = v, b = v; asm volatile("s_nop 1\n\t" INS " %0, %1" : "+v"(a), "+v"(b)); return OP; }
SWAP_RED(red16_sum, "v_permlane16_swap_b32", a + b)
SWAP_RED(red32_sum, "v_permlane32_swap_b32", a + b)
SWAP_RED(red16_max, "v_permlane16_swap_b32", fmaxf(a, b))
SWAP_RED(red32_max, "v_permlane32_swap_b32", fmaxf(a, b))
#undef SWAP_RED
DEV float wave_sum(float v) { return red32_sum(red16_sum(sum16(v))); }
DEV void unpack8(uint4 u, float* f) {
    f[0] = __uint_as_float(u.x << 16); f[1] = __uint_as_float(u.x & 0xffff0000u);
    f[2] = __uint_as_float(u.y << 16); f[3] = __uint_as_float(u.y & 0xffff0000u);
    f[4] = __uint_as_float(u.z << 16); f[5] = __uint_as_float(u.z & 0xffff0000u);
    f[6] = __uint_as_float(u.w << 16); f[7] = __uint_as_float(u.w & 0xffff0000u);
}


constexpr int VB_COLS = 2576, VF_VALS = 2560, VF_COLS = 5632;
DEV int vb_to_proj(int vc) { const int blk = vc >> 9; return ((blk == 0) ? C_FQ : (blk == 1) ? C_FK : (blk == 2) ? C_MQK : (blk == 3) ? C_HF : C_HQ) + (vc & 511); }
DEV int vf_to_proj(int vc) { if (vc >= VF_VALS) return C_GATES + (vc - VF_VALS); const int blk = vc >> 9; return ((blk == 0) ? C_FV : (blk == 1) ? C_MV : (blk == 2) ? C_MO : (blk == 3) ? C_HI : C_HG) + (vc & 511); }
DEV int inproj_vrow(int n, bool& f8) {
    f8 = false;
    if (n < O_FV) return n;
    if (n < O_FF) { f8 = true; return n - O_FV; }
    if (n < O_MQK) return 2560 + (n - O_FF);
    if (n < O_MV) return 1024 + (n - O_MQK);
    if (n < O_MI) { f8 = true; return 512 + (n - O_MV); }
    if (n < O_MO) return 2568 + (n - O_MI);
    if (n < O_HF) { f8 = true; return 1024 + (n - O_MO); }
    if (n < O_HQ) return 1536 + (n - O_HF);
    if (n < O_HI) return 2048 + (n - O_HQ);
    if (n < O_HG) { f8 = true; return 1536 + (n - O_HI); }
    if (n < O_GATES) { f8 = true; return 2048 + (n - O_HG); }
    f8 = true; return VF_VALS + (n - O_GATES);
}
DEV void lds_barrier() { asm volatile("s_waitcnt lgkmcnt(0)\n\ts_barrier" ::: "memory"); }
DEV const float* arg_in(int idx) {
    typedef const float* fptr_t;
    const __attribute__((address_space(4))) char* ka = (const __attribute__((address_space(4))) char*)__builtin_amdgcn_kernarg_segment_ptr();
    return *(const __attribute__((address_space(4))) fptr_t*)(ka + idx * 8);
}
struct MB { const float* src; unsigned char* dst; int ld; bool ok, f8; };
DEV MB mix_cb(const Params& p, int layer, int u, int lane, int wid) {
    MB c;
    int job, kb, nb, b = 0;
    if (u < 1032) { job = 0; kb = u & 7; nb = u >> 3; }
    else if (u < 1224) { const int r = (u - 1032) & 63; job = 1; b = (u - 1032) >> 6; kb = r & 3; nb = r >> 2; }
    else if (u < 1352) { job = 2; kb = (u - 1224) & 7; nb = (u - 1224) >> 3; }
    else { job = 3; kb = u - 1352; nb = 0; }
    const int N = (job == 0) ? NIN : (job == 3) ? 64 : 1024, K = (job == 1) ? 512 : 1024;
    const float* base = arg_in((job == 0) ? (int)I_WIN : (int)I_WBR + job - 1);
    const int n = nb * 64 + lane, k0 = kb * 128 + 16 * wid;
    c.ok = n < N; c.ld = N;
    c.src = base + ((size_t)layer * (job == 1 ? 3 : 1) + b) * (size_t)K * N + (size_t)k0 * N + (c.ok ? n : 0);
    bool f8 = (job == 2); int nm = n;
    if (job == 0) nm = inproj_vrow(c.ok ? n : 0, f8);
    c.f8 = f8;
    const size_t doff = (job == 0) ? (f8 ? OFF_WG8 : OFF_WIN) : (job == 1) ? OFF_WBR + (size_t)b * 1024 * 512 * 2 : (job == 2) ? OFF_WOUT : OFF_WRT;
    c.dst = p.ws + doff + (f8 ? (size_t)nm * 1024 + k0 : ((size_t)nm * K + k0) * 2);
    return c;
}
constexpr int MIX_CBLOCKS = 1032 + 192 + 128 + 8;
DEV void phase_convert_mix(const Params& p, int layer, char* lds) {
    const int t = tid_op(), lane = t & 63, wid = t >> 6, G = gridDim.x;
    int u = bid_op();
    if (u >= MIX_CBLOCKS) return;
    MB c = mix_cb(p, layer, u, lane, wid);
    float v[16];
#pragma unroll
    for (int i = 0; i < 16; ++i) v[i] = c.src[(size_t)i * c.ld];
#pragma unroll 1
    for (; u < MIX_CBLOCKS; u += G) {
        const bool more = u + G < MIX_CBLOCKS;
        const MB cn = mix_cb(p, layer, more ? u + G : u, lane, wid);
        float nx[16];
#pragma unroll
        for (int i = 0; i < 16; ++i) nx[i] = cn.src[(size_t)i * cn.ld];
        if (c.ok) {
            if (c.f8) { const float sc = F8_W_SCALE;
                *(uint4*)c.dst = make_uint4(pack4_fp8(v[0] * sc, v[1] * sc, v[2] * sc, v[3] * sc), pack4_fp8(v[4] * sc, v[5] * sc, v[6] * sc, v[7] * sc),
                                            pack4_fp8(v[8] * sc, v[9] * sc, v[10] * sc, v[11] * sc), pack4_fp8(v[12] * sc, v[13] * sc, v[14] * sc, v[15] * sc)); }
            else { *(uint4*)c.dst = make_uint4(pack2(v[0], v[1]), pack2(v[2], v[3]), pack2(v[4], v[5]), pack2(v[6], v[7]));
                   *(uint4*)(c.dst + 16) = make_uint4(pack2(v[8], v[9]), pack2(v[10], v[11]), pack2(v[12], v[13]), pack2(v[14], v[15])); }
        }
        c = cn;
#pragma unroll
        for (int i = 0; i < 16; ++i) v[i] = nx[i];
    }
}
struct CU4 { const f32x4* src; unsigned char* dst; int ld4, pitch; };
DEV CU4 moe_cu(const Params& p, int layer, int u, int lane, int wid) {
    CU4 c;
    const int e = u / 24, r = u % 24, which = r >> 3, t = r & 7;
    const float* base = arg_in((int)I_EW1 + (e < NEXP ? 0 : 3) + which);
    const float* w = base + (size_t)(e < NEXP ? layer * NEXP + e : layer) * 262144;
    if (which < 2) { const int kb = t, nm = (lane >> 1) * 16 + (lane & 1) * 8 + (which ? 4 : 0);
        c.src = (const f32x4*)(w + (size_t)(kb * 128 + 16 * wid) * 256 + 4 * lane); c.ld4 = 64; c.pitch = 1024;
        c.dst = p.ws + OFF_W13 + (size_t)e * 512 * 1024 + (size_t)nm * 1024 + kb * 128 + 16 * wid; }
    else { const int kb = t & 1, nb = t >> 1, n = nb * 256 + 4 * lane;
        c.src = (const f32x4*)(w + (size_t)(kb * 128 + 16 * wid) * 1024 + n); c.ld4 = 256; c.pitch = 256;
        c.dst = p.ws + (e < NEXP ? OFF_W2 + (size_t)e * 1024 * 256 : OFF_W2S) + (size_t)n * 256 + kb * 128 + 16 * wid; }
    return c;
}
constexpr int MOE_CUNITS = NLIST * 24;
DEV unsigned pk4s(float a, float b, float c, float d) { const float sc = F8_W_SCALE; return pack4_fp8(a * sc, b * sc, c * sc, d * sc); }
DEV void conv_moe_all(const Params& p, int layer) {
    const int t = tid_op(), lane = t & 63, wid = t >> 6, G = gridDim.x;
    int u = bid_op();
    if (u >= MOE_CUNITS) return;
    CU4 c = moe_cu(p, layer, u, lane, wid);
    f32x4 A[8], B[8];
#pragma unroll
    for (int i = 0; i < 8; ++i) A[i] = c.src[(size_t)i * c.ld4];
#pragma unroll
    for (int i = 0; i < 8; ++i) B[i] = c.src[(size_t)(8 + i) * c.ld4];
#pragma unroll 1
    for (; u < MOE_CUNITS; u += G) {
        const bool more = u + G < MOE_CUNITS;
        const CU4 cn = moe_cu(p, layer, more ? u + G : u, lane, wid);
        unsigned lo[4][2];
#pragma unroll
        for (int j = 0; j < 4; ++j) { lo[j][0] = pk4s(A[0][j], A[1][j], A[2][j], A[3][j]); lo[j][1] = pk4s(A[4][j], A[5][j], A[6][j], A[7][j]); }
#pragma unroll
        for (int i = 0; i < 8; ++i) A[i] = cn.src[(size_t)i * cn.ld4];
#pragma unroll
        for (int j = 0; j < 4; ++j)
            *(uint4*)(c.dst + (size_t)j * c.pitch) = make_uint4(lo[j][0], lo[j][1], pk4s(B[0][j], B[1][j], B[2][j], B[3][j]), pk4s(B[4][j], B[5][j], B[6][j], B[7][j]));
#pragma unroll
        for (int i = 0; i < 8; ++i) B[i] = cn.src[(size_t)(8 + i) * cn.ld4];
        c = cn;
    }
}

DEV void phase_ada(const Params& p, char* lds) {
    float* condT = (float*)lds;
    float* red = condT + 1024 * 16;
    const int t = tid_op();
    for (int i = t; i < 16 * 1024; i += 512) { const int b = i >> 10, k = i & 1023; condT[k * 16 + b] = silu_f(p.in[I_C][i]); }
    __syncthreads();
    float* mod = (float*)(p.ws + OFF_MOD);
    for (int u = bid_op(); u < 2 * 96; u += gridDim.x) {
        const int l = u / 96, j0 = (u % 96) * 64, col = t & 63, kg = t >> 6;
        const float* w = p.in[I_ADAW] + (size_t)l * 1024 * 6144 + j0 + col;
        float acc[16];
#pragma unroll
        for (int b = 0; b < 16; ++b) acc[b] = 0.f;
        for (int k0 = kg * 128; k0 < kg * 128 + 128; k0 += 8) {
            float wv8[8];
#pragma unroll
            for (int uu = 0; uu < 8; ++uu) wv8[uu] = w[(size_t)(k0 + uu) * 6144];
#pragma unroll
            for (int uu = 0; uu < 8; ++uu) {
                const float wv = wv8[uu];
                const f32x4* cp = (const f32x4*)(condT + (k0 + uu) * 16);
#pragma unroll
                for (int q = 0; q < 4; ++q) { const f32x4 c4 = cp[q]; acc[q * 4 + 0] += c4[0] * wv; acc[q * 4 + 1] += c4[1] * wv; acc[q * 4 + 2] += c4[2] * wv; acc[q * 4 + 3] += c4[3] * wv; }
            }
        }
        __syncthreads();
#pragma unroll
        for (int b = 0; b < 16; ++b) red[(kg * 16 + b) * 64 + col] = acc[b];
        __syncthreads();
        for (int i = t; i < 16 * 64; i += 512) {
            const int b = i >> 6, c = i & 63;
            float s = p.in[I_ADAB][l * 6144 + j0 + c];
#pragma unroll
            for (int g = 0; g < 8; ++g) s += red[(g * 16 + b) * 64 + c];
            mod[((size_t)l * 16 + b) * 6144 + j0 + c] = s;
        }
    }
}

DEV void phase_norm(const Params& p, const float* xin, int layer, int which, bf16_t* hout) {
    const int lane = tid_op() & 63, wid = tid_op() >> 6;
    const float* g = p.in[which ? I_N2G : I_N1G] + layer * 1024;
    const float* mod = (const float*)(p.ws + OFF_MOD) + (size_t)layer * 16 * 6144;
    for (int row = bid_op() * 8 + wid; row < T; row += gridDim.x * 8) {
        const float* xr = xin + (size_t)row * 1024;
        f32x4 v[4]; float ss = 0.f;
#pragma unroll
        for (int i = 0; i < 4; ++i) { v[i] = *(const f32x4*)(xr + i * 256 + lane * 4); ss += v[i][0] * v[i][0] + v[i][1] * v[i][1] + v[i][2] * v[i][2] + v[i][3] * v[i][3]; }
        ss = wave_sum(ss);
        const float rstd = rsqrtf(ss * (1.f / 1024.f) + 1e-6f);
        const int b = row >> 11;
        const float* sh = mod + (size_t)b * 6144 + (which ? 3 : 0) * 1024;
        const float* sc = sh + 1024;
#pragma unroll
        for (int i = 0; i < 4; ++i) {
            const int c = i * 256 + lane * 4;
            const f32x4 g4 = *(const f32x4*)(g + c), sc4 = *(const f32x4*)(sc + c), sh4 = *(const f32x4*)(sh + c);
            float h0 = v[i][0] * rstd * g4[0] * (1.f + sc4[0]) + sh4[0];
            float h1 = v[i][1] * rstd * g4[1] * (1.f + sc4[1]) + sh4[1];
            float h2 = v[i][2] * rstd * g4[2] * (1.f + sc4[2]) + sh4[2];
            float h3 = v[i][3] * rstd * g4[3] * (1.f + sc4[3]) + sh4[3];
            uint2 o; o.x = pack2(h0, h1); o.y = pack2(h2, h3);
            *(uint2*)(hout + (size_t)row * 1024 + c) = o;
            if (which == 0) *(unsigned*)(p.ws + OFF_H8 + (size_t)row * 1024 + c) = pack4_fp8(h0 * F8_ACT_SCALE, h1 * F8_ACT_SCALE, h2 * F8_ACT_SCALE, h3 * F8_ACT_SCALE);
        }
    }
}

#define LAS __attribute__((address_space(3)))
namespace g8 {
typedef unsigned u32x4 __attribute__((ext_vector_type(4)));
constexpr int BM = 256, BK = 64, HALF = 128, HTB = HALF * BK * 2, STAGE_BYTES = 8 * HTB;
DEV int lds_byte(int r, int c) { const int st = (r >> 4) * 2 + (c >> 5), rr = r & 15, cc = c & 31, ob = rr * 64 + cc * 2; return st * 1024 + (ob ^ (((ob >> 9) & 1) << 5)); }
DEV void stage_rc(int b, int& R, int& C) { const int st = b / 1024, sb = b % 1024, swz = sb ^ (((sb >> 9) & 1) << 5); R = (st >> 1) * 16 + swz / 64; C = (st & 1) * 32 + (swz % 64) / 2; }
DEV int perm32(int rho) { const int n = rho >> 4, i = rho & 15; return 8 * (i >> 2) + 4 * n + (i & 3); }

struct GUnit { const char* A; const char* B; const int* rows; int pm, pn, aux; };

typedef int v8i_t __attribute__((ext_vector_type(8)));
typedef int v4i_t __attribute__((ext_vector_type(4)));
DEV v8i_t cat8(bf16x8 a, bf16x8 b) { const v4i_t x = __builtin_bit_cast(v4i_t, a), y = __builtin_bit_cast(v4i_t, b); return (v8i_t){x[0], x[1], x[2], x[3], y[0], y[1], y[2], y[3]}; }
template <bool PERM, bool GATHER, bool F8, int SEXP = 0, class Gen, class Epi>
DEV void gemm8(LAS unsigned char* lds, const int lda_b, const int ldb_b, const int K, const Gen& S, const Epi& E) {
    int tid_ = tid_op();
    const int tid = tid_, wid = __builtin_amdgcn_readfirstlane(tid >> 6), lane = tid & 63, wr = wid >> 2, wc = wid & 3, fr = lane & 15, fq = lane >> 4;
    const int nt = K / BK;
    int Rs[2], Cb[2];
    unsigned voffB[2];
#pragma unroll
    for (int i = 0; i < 2; ++i) { int R, C; stage_rc(tid * 16 + i * 8192, R, C); const int Rb = PERM ? (64 * (R >> 5) + 16 * ((R & 15) >> 2) + 4 * ((R >> 4) & 1) + (R & 3)) : R;
        Rs[i] = R; Cb[i] = C * 2; voffB[i] = (unsigned)Rb * (unsigned)ldb_b + (unsigned)C * 2u; }
    const size_t kstep = (size_t)(BK * 2);
    const size_t hstepB = (size_t)(PERM ? 8 : HALF) * ldb_b;
    const unsigned ldsw = (unsigned)wid * 1024u;
    const int aoff = lds_byte(wr * 64 + fr, fq * 8), boff = lds_byte(wc * 32 + fr, fq * 8);
#define PG8_SA(b, h) (((b) * 2 + (h)) * HTB)
#define PG8_SB(b, h) ((4 + (b) * 2 + (h)) * HTB)
#define PG8_STAGE(bufoff, gbase, voff) do { _Pragma("unroll") for (int _i = 0; _i < 2; ++_i) \
        __builtin_amdgcn_global_load_lds((const unsigned*)((const char*)(gbase) + (voff)[_i]), (LAS unsigned*)(lds + (bufoff) + ldsw + _i * 8192), 16, 0, 0); } while (0)
#define PG8_LDA(dst, b, h) do { _Pragma("unroll") for (int m = 0; m < 4; ++m) { if constexpr (F8) dst##8[m] = cat8(*(const LAS bf16x8*)(lds + PG8_SA(b, h) + aoff + m * 2048), *(const LAS bf16x8*)(lds + PG8_SA(b, h) + aoff + m * 2048 + 1024)); \
        else { _Pragma("unroll") for (int k = 0; k < 2; ++k) dst[m][k] = *(const LAS bf16x8*)(lds + PG8_SA(b, h) + aoff + m * 2048 + k * 1024); } } } while (0)
#define PG8_LDB(dst, b, h) do { _Pragma("unroll") for (int n = 0; n < 2; ++n) { if constexpr (F8) dst##8[n] = cat8(*(const LAS bf16x8*)(lds + PG8_SB(b, h) + boff + n * 2048), *(const LAS bf16x8*)(lds + PG8_SB(b, h) + boff + n * 2048 + 1024)); \
        else { _Pragma("unroll") for (int k = 0; k < 2; ++k) dst[n][k] = *(const LAS bf16x8*)(lds + PG8_SB(b, h) + boff + n * 2048 + k * 1024); } } } while (0)
#define PG8_MMA(ai, bj, At, Bt) do { __builtin_amdgcn_s_setprio(1); _Pragma("unroll") for (int m = 0; m < 4; ++m) _Pragma("unroll") for (int n = 0; n < 2; ++n) { \
        if constexpr (F8) asm volatile("v_mfma_scale_f32_16x16x128_f8f6f4 %0, %1, %2, %0, %3, %4 op_sel_hi:[0,0,0]" : "+v"(acc[ai][bj][m][n]) : "v"(Bt##8[n]), "v"(At##8[m]), "v"(0x7f7f7f7f), "v"(0x01010101 * (127 + SEXP))); \
        else { _Pragma("unroll") for (int k = 0; k < 2; ++k) acc[ai][bj][m][n] = __builtin_amdgcn_mfma_f32_16x16x32_bf16(Bt[n][k], At[m][k], acc[ai][bj][m][n], 0, 0, 0); } } \
        __builtin_amdgcn_s_setprio(0); } while (0)
#define PG8_WAIT_V(n) asm volatile("s_waitcnt vmcnt(" #n ")" ::: "memory")
#define PG8_WAIT_L(n) asm volatile("s_waitcnt lgkmcnt(" #n ")" ::: "memory")
#define PG8_BAR __builtin_amdgcn_s_barrier()
#define PG8_SCHED __builtin_amdgcn_sched_barrier(0)
    GUnit cur, nxt; int ui = 0;
    if (!S.next(0, cur)) return;
    unsigned cOff[2][2], nOff[2][2];
    auto mkoff = [&](unsigned (&o)[2][2], int buf) {
#pragma unroll
        for (int h = 0; h < 2; ++h)
#pragma unroll
            for (int i = 0; i < 2; ++i) {
                if constexpr (GATHER) { const unsigned r = (unsigned)S.rb[buf * 256 + h * HALF + Rs[i]]; o[h][i] = (r < (unsigned)T ? r : 0u) * (unsigned)lda_b + (unsigned)Cb[i]; }

                else o[h][i] = (unsigned)(h * HALF + Rs[i]) * (unsigned)lda_b + (unsigned)Cb[i];
            }
    };
    auto rows_dma = [&](const int* rows, int buf) {
        if constexpr (GATHER) __builtin_amdgcn_global_load_lds((const unsigned*)(rows + lane * 4), (LAS unsigned*)(S.rb + buf * 256), 16, 0, 0);
    };
    if constexpr (GATHER) {
        if (wid == 0) { rows_dma(cur.rows, 0); GUnit t1; if (S.next(1, t1)) rows_dma(t1.rows, 1); }
        asm volatile("s_waitcnt vmcnt(0)" ::: "memory");
        __builtin_amdgcn_s_barrier();
    }
    mkoff(cOff, 0);
    f32x4 acc[2][2][4][2];
#pragma unroll
    for (int a = 0; a < 2; ++a)
#pragma unroll
        for (int b = 0; b < 2; ++b)
#pragma unroll
            for (int m = 0; m < 4; ++m)
#pragma unroll
                for (int n = 0; n < 2; ++n) acc[a][b][m][n] = (f32x4){0.f, 0.f, 0.f, 0.f};
    bf16x8 At[4][2], B0[2][2], B1[2][2];
    v8i_t At8[4], B08[2], B18[2];
    const char* cA = cur.A; const char* cB = cur.B;
    PG8_STAGE(PG8_SB(0, 0), cB, voffB); PG8_STAGE(PG8_SB(0, 1), cB + hstepB, voffB); PG8_STAGE(PG8_SA(0, 0), cA, cOff[0]); PG8_STAGE(PG8_SA(0, 1), cA, cOff[1]);
    if (wr == 1) PG8_BAR;
    PG8_WAIT_V(2); PG8_BAR;
    PG8_STAGE(PG8_SB(1, 0), cB + kstep, voffB); PG8_STAGE(PG8_SA(1, 0), cA + kstep, cOff[0]); PG8_STAGE(PG8_SB(1, 1), cB + hstepB + kstep, voffB);
    PG8_WAIT_V(6); PG8_BAR;
    for (;;) {
        const bool has_next = S.next(ui + 1, nxt);
        if constexpr (GATHER) {
            { GUnit t2; if (S.next(ui + 2, t2) && wid == 0) rows_dma(t2.rows, ui & 1); }
            if (has_next) mkoff(nOff, (ui + 1) & 1);
            else {
#pragma unroll
                for (int h = 0; h < 2; ++h)
#pragma unroll
                    for (int i = 0; i < 2; ++i) nOff[h][i] = cOff[h][i];
            }
        }
        const char* nA = has_next ? nxt.A : cA; const char* nB = has_next ? nxt.B : cB;
#pragma unroll 1
        for (int t = 0; t < nt; t += 2) {
            const bool last = (t == nt - 2);
            const char* a1 = cA + (size_t)(t + 1) * kstep;
            const char* a2 = last ? nA : cA + (size_t)(t + 2) * kstep; const char* b2 = last ? nB : cB + (size_t)(t + 2) * kstep;
            const char* a3 = a2 + kstep; const char* b3 = b2 + kstep;
            unsigned o2[2][2];
#pragma unroll
            for (int h = 0; h < 2; ++h)
#pragma unroll
                for (int i = 0; i < 2; ++i) { if constexpr (GATHER) o2[h][i] = last ? nOff[h][i] : cOff[h][i]; else o2[h][i] = cOff[h][i]; }
            PG8_LDB(B0, 0, 0); PG8_LDB(B1, 0, 1); PG8_SCHED; PG8_LDA(At, 0, 0); PG8_STAGE(PG8_SA(1, 1), a1, cOff[1]);
            PG8_WAIT_V(8); PG8_WAIT_L(0); PG8_BAR; PG8_MMA(0, 0, At, B0); PG8_MMA(0, 1, At, B1); PG8_BAR; PG8_SCHED;
            PG8_LDA(At, 0, 1); PG8_STAGE(PG8_SB(0, 0), b2, voffB); PG8_STAGE(PG8_SB(0, 1), b2 + hstepB, voffB); PG8_STAGE(PG8_SA(0, 0), a2, o2[0]);
            PG8_WAIT_V(8); PG8_WAIT_L(0); PG8_BAR; PG8_MMA(1, 0, At, B0); PG8_MMA(1, 1, At, B1); PG8_BAR; PG8_SCHED;
            PG8_LDB(B0, 1, 0); PG8_LDB(B1, 1, 1); PG8_SCHED; PG8_LDA(At, 1, 0); PG8_STAGE(PG8_SA(0, 1), a2, o2[1]);
            PG8_WAIT_V(8); PG8_WAIT_L(0); PG8_BAR; PG8_MMA(0, 0, At, B0); PG8_MMA(0, 1, At, B1); PG8_BAR; PG8_SCHED;
            PG8_LDA(At, 1, 1); PG8_STAGE(PG8_SB(1, 0), b3, voffB); PG8_STAGE(PG8_SB(1, 1), b3 + hstepB, voffB); PG8_STAGE(PG8_SA(1, 0), a3, o2[0]);
            PG8_WAIT_V(8); PG8_WAIT_L(0); PG8_BAR; PG8_MMA(1, 0, At, B0); PG8_MMA(1, 1, At, B1); PG8_BAR; PG8_SCHED;
        }
        if (wr == 0) PG8_BAR;
        if constexpr (F8) asm volatile("s_nop 15\n\ts_nop 15" ::: "memory");
        { int pm_ = cur.pm, pn_ = cur.pn; asm volatile("" : "+s"(pm_), "+s"(pn_)); cur.pm = pm_; cur.pn = pn_; }
        E(acc, cur, wr, wc, fr, fq);
        if (!has_next) break;
        if (!(nxt.aux & 256)) {
#pragma unroll
            for (int a = 0; a < 2; ++a)
#pragma unroll
                for (int b = 0; b < 2; ++b)
#pragma unroll
                    for (int m = 0; m < 4; ++m)
#pragma unroll
                        for (int n = 0; n < 2; ++n) acc[a][b][m][n] = (f32x4){0.f, 0.f, 0.f, 0.f};
        }
        cur = nxt; cA = nA; cB = nB; ++ui;
        if constexpr (GATHER) {
#pragma unroll
            for (int h = 0; h < 2; ++h)
#pragma unroll
                for (int i = 0; i < 2; ++i) cOff[h][i] = nOff[h][i];
        }
        if (wr == 1) PG8_BAR;
    }
    PG8_WAIT_V(0);
    PG8_BAR;
#undef PG8_SA
#undef PG8_SB
#undef PG8_STAGE
#undef PG8_LDA
#undef PG8_LDB
#undef PG8_MMA
#undef PG8_WAIT_V
#undef PG8_WAIT_L
#undef PG8_BAR
#undef PG8_SCHED
}

struct TileOrder {
    int nM, nN, nwg;
    DEV void init(int nM_, int nN_) { nM = nM_; nN = nN_; nwg = nM * nN; }
    DEV bool get(int L, int& pm, int& pn) const {
        if (L >= nwg) return false;
        constexpr int NXCD = 8, WGM = 8;
        int wgid = L; { const int q = nwg / NXCD, r = nwg % NXCD, xcd = wgid % NXCD, off = wgid / NXCD; wgid = (xcd < r ? xcd * (q + 1) : r * (q + 1) + (xcd - r) * q) + off; }
        const int nig = WGM * nN, gid = wgid / nig, fm = gid * WGM, gsz = (nM - fm) < WGM ? (nM - fm) : WGM;
        pm = fm + ((wgid % nig) % gsz); pn = (wgid % nig) / gsz; return true;
    }
};
}

DEV unsigned ldsaddr_dummy() { return 0; }


DEV uint4 dpp_swap1(uint4 v) {
    uint4 r;
    r.x = (unsigned)__builtin_amdgcn_update_dpp(0, (int)v.x, 0xB1, 0xF, 0xF, true); r.y = (unsigned)__builtin_amdgcn_update_dpp(0, (int)v.y, 0xB1, 0xF, 0xF, true);
    r.z = (unsigned)__builtin_amdgcn_update_dpp(0, (int)v.z, 0xB1, 0xF, 0xF, true); r.w = (unsigned)__builtin_amdgcn_update_dpp(0, (int)v.w, 0xB1, 0xF, 0xF, true);
    return r;
}
DEV uint4 sel4(bool c, uint4 a, uint4 b) { uint4 r; r.x = c ? a.x : b.x; r.y = c ? a.y : b.y; r.z = c ? a.z : b.z; r.w = c ? a.w : b.w; return r; }
DEV void store_wide32(char* base, unsigned off, unsigned pitch, int fr, uint4 p0, uint4 p1) {
    const bool odd = fr & 1;
    const uint4 got = dpp_swap1(sel4(odd, p0, p1));
    *(uint4*)(base + (odd ? off - pitch + 16u : off)) = sel4(odd, got, p0);
    *(uint4*)(base + (odd ? off + 16u : off + pitch)) = sel4(odd, p1, got);
}

DEV void phase_inproj(const Params& p, char* lds) {
    bf16_t* P = (bf16_t*)(p.ws + OFF_PROJ);
    float* GS = (float*)(p.ws + OFF_GS);
    const int odd = bid_op() & 1;
#pragma unroll 1
    for (int pass = 0; pass < 3; ++pass) {
    const bool isbf = odd ? (pass != 1) : (pass == 1);
    const int i0 = (odd && pass == 2) ? 1 : 0;
    const int icnt = odd ? ((pass == 0) ? 1 : 0x7fffffff) : ((pass < 2) ? 0x7fffffff : 0);
    if (isbf) {
        struct Gen { g8::TileOrder o; const char* H; const char* W; int G, c, i0, cnt;
            DEV bool next(int i_, g8::GUnit& u) const { int pm, pn; if (i_ >= cnt) return false; const int i = i_ + i0; if (!o.get(i * G + c, pm, pn)) return false; u.pm = pm; u.pn = pn; u.aux = 0; u.rows = nullptr;
                u.A = H + (size_t)pm * 256 * 2048; u.B = W + (size_t)pn * 256 * 2048; return true; } } gen;
        gen.o.init(T / 256, 11); gen.H = (const char*)(p.ws + OFF_H); gen.W = (const char*)(p.ws + OFF_WIN); gen.G = gridDim.x; gen.c = bid_op(); gen.i0 = i0; gen.cnt = icnt;
        auto epi = [&](const f32x4 (&acc)[2][2][4][2], const g8::GUnit& u, int wr, int wc, int fr, int fq) {
            const int vc0 = u.pn * 256 + 64 * wc + 16 * fq;
            if (vc0 < 2560) {
                const unsigned pc0 = (unsigned)vb_to_proj(vc0);
#pragma unroll
                for (int ai = 0; ai < 2; ++ai)
#pragma unroll
                    for (int m = 0; m < 4; ++m) {
                        const int row = u.pm * 256 + ai * 128 + wr * 64 + m * 16 + fr;
                        const f32x4 a0 = acc[ai][0][m][0], a1 = acc[ai][0][m][1], b0 = acc[ai][1][m][0], b1 = acc[ai][1][m][1];
                        uint4 p0, p1;
                        p0.x = pack2(a0[0], a0[1]); p0.y = pack2(a0[2], a0[3]); p0.z = pack2(a1[0], a1[1]); p0.w = pack2(a1[2], a1[3]);
                        p1.x = pack2(b0[0], b0[1]); p1.y = pack2(b0[2], b0[3]); p1.z = pack2(b1[0], b1[1]); p1.w = pack2(b1[2], b1[3]);
                        store_wide32((char*)P, ((unsigned)row * DIN + pc0) * 2u, (unsigned)DIN * 2u, fr, p0, p1);
                    }
            } else if (vc0 == 2560) {
#pragma unroll
                for (int ai = 0; ai < 2; ++ai)
#pragma unroll
                    for (int m = 0; m < 4; ++m) {
                        const int row = u.pm * 256 + ai * 128 + wr * 64 + m * 16 + fr;
                        const f32x4 a0 = acc[ai][0][m][0], a1 = acc[ai][0][m][1], b0 = acc[ai][1][m][0], b1 = acc[ai][1][m][1];
                        uint4 p0, p1;
                        p0.x = pack2(a0[0], a0[1]); p0.y = pack2(a0[2], a0[3]); p0.z = pack2(a1[0], a1[1]); p0.w = pack2(a1[2], a1[3]);
                        p1.x = pack2(b0[0], b0[1]); p1.y = pack2(b0[2], b0[3]); p1.z = pack2(b1[0], b1[1]); p1.w = pack2(b1[2], b1[3]);
                        *(uint4*)(P + (size_t)row * DIN + C_FF) = p0; *(uint4*)(P + (size_t)row * DIN + C_MI) = p1;
                        *(f32x4*)(GS + (size_t)row * 16) = a0; *(f32x4*)(GS + (size_t)row * 16 + 4) = a1;
                        *(f32x4*)(GS + (size_t)row * 16 + 8) = b0; *(f32x4*)(GS + (size_t)row * 16 + 12) = b1;
                    }
            }
        };
        g8::gemm8<true, false, false>((LAS unsigned char*)lds, 2048, 2048, 1024, gen, epi);
    } else {
        struct Gen { g8::TileOrder o; const char* H; const char* W; int G, c, i0, cnt;
            DEV bool next(int i_, g8::GUnit& u) const { int pm, pn; if (i_ >= cnt) return false; const int i = i_ + i0;
                int L = i * G + c;
                if (G == 256) { if (i >= 10) { if (c < 128 || i >= 12) return false; L = 2560 + (i - 10) * 128 + (c - 128); } }
                if (!o.get(L, pm, pn)) return false; u.pm = pm; u.pn = pn; u.aux = 0; u.rows = nullptr;
                u.A = H + (size_t)pm * 256 * 1024; u.B = W + (size_t)pn * 256 * 1024; return true; } } gen;
        gen.o.init(T / 256, 22); gen.H = (const char*)(p.ws + OFF_H8); gen.W = (const char*)(p.ws + OFF_WG8); gen.G = gridDim.x; gen.c = bid_op(); gen.i0 = i0; gen.cnt = icnt;
        auto epi = [&](const f32x4 (&acc)[2][2][4][2], const g8::GUnit& u, int wr, int wc, int fr, int fq) {
            const int vc0 = u.pn * 256 + 64 * wc + 16 * fq;
            const unsigned pc0 = (unsigned)vf_to_proj(vc0);
            const bool gate = u.pn >= 10;
#pragma unroll
            for (int ai = 0; ai < 2; ++ai)
#pragma unroll
                for (int m = 0; m < 4; ++m) {
                    const int row = u.pm * 256 + ai * 128 + wr * 64 + m * 16 + fr;
                    f32x4 a0 = acc[ai][0][m][0], a1 = acc[ai][0][m][1], b0 = acc[ai][1][m][0], b1 = acc[ai][1][m][1];
                    if (gate) {
                        unsigned w4[4];
#pragma unroll
                        for (int q = 0; q < 4; ++q) {
                            const f32x4 v = (q == 0) ? a0 : (q == 1) ? a1 : (q == 2) ? b0 : b1;
                            unsigned w = 0u;
#pragma unroll
                            for (int j = 0; j < 4; ++j) w = __builtin_amdgcn_cvt_pk_u8_f32(fmaxf(fsigmoid(v[j]) * 255.f, 1.f), j, w);
                            w4[q] = w;
                        }
                        *(uint4*)((unsigned char*)P + (size_t)row * (DIN * 2) + C_GATES * 2 + (vc0 - VF_VALS)) = make_uint4(w4[0], w4[1], w4[2], w4[3]);
                        continue;
                    }
                    uint4 p0, p1;
                    p0.x = pack2(a0[0], a0[1]); p0.y = pack2(a0[2], a0[3]); p0.z = pack2(a1[0], a1[1]); p0.w = pack2(a1[2], a1[3]);
                    p1.x = pack2(b0[0], b0[1]); p1.y = pack2(b0[2], b0[3]); p1.z = pack2(b1[0], b1[1]); p1.w = pack2(b1[2], b1[3]);
                    store_wide32((char*)P, ((unsigned)row * DIN + pc0) * 2u, (unsigned)DIN * 2u, fr, p0, p1);
                }
        };
        g8::gemm8<true, false, true, -9>((LAS unsigned char*)lds, 1024, 1024, 512, gen, epi);
    }
    }
}

DEV void phase_merge(const Params& p, char* lds) {
    bf16_t* P = (bf16_t*)(p.ws + OFF_PROJ);
    const char* W = (const char*)(p.ws + OFF_WBR);
    struct Gen { g8::TileOrder o; const char* P; const char* W; int G, c;
        DEV bool next(int i, g8::GUnit& u) const { int pm, pn; const int ti = i / 3, b = i - ti * 3; if (!o.get(ti * G + c, pm, pn)) return false; u.pm = pm; u.pn = pn; u.aux = b | (b > 0 ? 256 : 0); u.rows = nullptr;
            const int ycol = (b == 0) ? C_FQ : (b == 1) ? C_MO : C_HG;
            u.A = P + ((size_t)pm * 256 * DIN + ycol) * 2; u.B = W + ((size_t)b * 1024 + pn * 256) * 512 * 2; return true; } } gen;
    gen.o.init(T / 256, 4); gen.P = (const char*)P; gen.W = W; gen.G = gridDim.x; gen.c = bid_op();
    auto epi = [&](f32x4 (&acc)[2][2][4][2], const g8::GUnit& u, int wr, int wc, int fr, int fq) {
        const int b = u.aux & 3;
#pragma unroll
        for (int ai = 0; ai < 2; ++ai) {
            uint4 gq[4], hq[4];
            const unsigned char* rp = (const unsigned char*)P + (size_t)(u.pm * 256 + ai * 128 + wr * 64 + fr) * (DIN * 2) + C_GATES * 2 + b * 1024 + u.pn * 256 + 64 * wc + 16 * fq;
#pragma unroll
            for (int m = 0; m < 4; ++m) {
                gq[m] = *(const uint4*)(rp + (size_t)(m * 16) * (DIN * 2));
                if (b < 2) hq[m] = *(const uint4*)(rp + (size_t)(m * 16) * (DIN * 2) + 1024);
            }
#pragma unroll
            for (int m = 0; m < 4; ++m) {
#pragma unroll
                for (int bj = 0; bj < 2; ++bj) {
                    const unsigned g0 = bj ? gq[m].z : gq[m].x, g1 = bj ? gq[m].w : gq[m].y;
                    float g[8] = {(float)(g0 & 0xffu), (float)((g0 >> 8) & 0xffu), (float)((g0 >> 16) & 0xffu), (float)(g0 >> 24),
                                  (float)(g1 & 0xffu), (float)((g1 >> 8) & 0xffu), (float)((g1 >> 16) & 0xffu), (float)(g1 >> 24)};
                    if (b < 2) {
                        const unsigned h0 = bj ? hq[m].z : hq[m].x, h1 = bj ? hq[m].w : hq[m].y;
                        const float gn[8] = {(float)(h0 & 0xffu), (float)((h0 >> 8) & 0xffu), (float)((h0 >> 16) & 0xffu), (float)(h0 >> 24),
                                             (float)(h1 & 0xffu), (float)((h1 >> 8) & 0xffu), (float)((h1 >> 16) & 0xffu), (float)(h1 >> 24)};
#pragma unroll
                        for (int j = 0; j < 8; ++j) g[j] *= __builtin_amdgcn_rcpf(gn[j]);
                    } else {
#pragma unroll
                        for (int j = 0; j < 8; ++j) g[j] *= (1.f / 255.f);
                    }
#pragma unroll
                    for (int j = 0; j < 4; ++j) { acc[ai][bj][m][0][j] *= g[j]; acc[ai][bj][m][1][j] *= g[4 + j]; }
                }
                if (b == 2) {
                    const f32x4 a0 = acc[ai][0][m][0], a1 = acc[ai][0][m][1], b0 = acc[ai][1][m][0], b1 = acc[ai][1][m][1];
                    const float ms = 16.f;
                    *(uint4*)((char*)(p.ws + OFF_H) + (size_t)(u.pm * 256 + ai * 128 + wr * 64 + m * 16 + fr) * 1024 + u.pn * 256 + 64 * wc + 16 * fq) =
                        make_uint4(pack4_fp8(a0[0] * ms, a0[1] * ms, a0[2] * ms, a0[3] * ms), pack4_fp8(a1[0] * ms, a1[1] * ms, a1[2] * ms, a1[3] * ms),
                                   pack4_fp8(b0[0] * ms, b0[1] * ms, b0[2] * ms, b0[3] * ms), pack4_fp8(b1[0] * ms, b1[1] * ms, b1[2] * ms, b1[3] * ms));
                }
            }
        }
    };
    g8::gemm8<true, false, false>((LAS unsigned char*)lds, DIN * 2, 1024, 512, gen, epi);
}

DEV void phase_out(const Params& p, int layer, char* lds) {
    const char* M = (const char*)(p.ws + OFF_H);
    const char* W = (const char*)(p.ws + OFF_WOUT);
    const float* mod = (const float*)(p.ws + OFF_MOD) + (size_t)layer * 16 * 6144;
    struct Gen { g8::TileOrder o; const char* M; const char* W; int G, c;
        DEV bool next(int i, g8::GUnit& u) const { int pm, pn; if (!o.get(i * G + c, pm, pn)) return false; u.pm = pm; u.pn = pn; u.aux = i; u.rows = nullptr;
            u.A = M + (size_t)pm * 256 * 1024; u.B = W + (size_t)pn * 256 * 1024; return true; } } gen;
    gen.o.init(T / 256, 4); gen.M = M; gen.W = W; gen.G = gridDim.x; gen.c = bid_op();
    const float* xf = p.in[I_X];
    const bf16_t* xh = (const bf16_t*)p.out;
    const int skew = gen.c & 1;
    auto epi = [&](const f32x4 (&acc)[2][2][4][2], const g8::GUnit& u, int wr, int wc, int fr, int fq) {
        const int bb = (u.pm * 256) >> 11;
        const int c0 = u.pn * 256 + 64 * wc + 16 * fq;
        f32x4 g1[4];
#pragma unroll
        for (int q = 0; q < 4; ++q) g1[q] = *(const f32x4*)(mod + (size_t)bb * 6144 + 2 * 1024 + c0 + 4 * q);
#pragma unroll
        for (int ai = 0; ai < 2; ++ai) {
            const unsigned r0 = (unsigned)(u.pm * 256 + ai * 128 + wr * 64 + fr);
            if (layer == 0) {
#pragma unroll
                for (int mh = 0; mh < 2; ++mh) {
                    f32x4 xr[2][4];
#pragma unroll
                    for (int m = 0; m < 2; ++m)
#pragma unroll
                        for (int q = 0; q < 4; ++q) xr[m][q] = *(const f32x4*)(xf + (size_t)(r0 + (mh * 2 + m) * 16) * 1024 + c0 + 4 * q);
#pragma unroll
                    for (int m2 = 0; m2 < 2; ++m2) {
                        const int m = mh * 2 + m2;
                        float o[16];
#pragma unroll
                        for (int bj = 0; bj < 2; ++bj)
#pragma unroll
                            for (int n = 0; n < 2; ++n)
#pragma unroll
                                for (int j = 0; j < 4; ++j) o[8 * bj + 4 * n + j] = xr[m2][2 * bj + n][j] + g1[2 * bj + n][j] * acc[ai][bj][m][n][j];
                        uint4 p0, p1;
                        p0.x = pack2(o[0], o[1]); p0.y = pack2(o[2], o[3]); p0.z = pack2(o[4], o[5]); p0.w = pack2(o[6], o[7]);
                        p1.x = pack2(o[8], o[9]); p1.y = pack2(o[10], o[11]); p1.z = pack2(o[12], o[13]); p1.w = pack2(o[14], o[15]);
                        store_wide32((char*)(p.ws + OFF_XB), ((r0 + m * 16) * 1024u + (unsigned)c0) * 2u, 2048u, fr, p0, p1);
                    }
                }
            } else {
                uint4 xr[4][2];
#pragma unroll
                for (int m = 0; m < 4; ++m)
#pragma unroll
                    for (int q = 0; q < 2; ++q) xr[m][q] = *(const uint4*)(xh + (size_t)(r0 + m * 16) * 1024 + c0 + 8 * q);
#pragma unroll
                for (int m = 0; m < 4; ++m) {
                    float o[16];
#pragma unroll
                    for (int bj = 0; bj < 2; ++bj) {
                        float xv[8]; unpack8(xr[m][bj], xv);
#pragma unroll
                        for (int n = 0; n < 2; ++n)
#pragma unroll
                            for (int j = 0; j < 4; ++j) o[8 * bj + 4 * n + j] = xv[4 * n + j] + g1[2 * bj + n][j] * acc[ai][bj][m][n][j];
                    }
                    uint4 p0, p1;
                    p0.x = pack2(o[0], o[1]); p0.y = pack2(o[2], o[3]); p0.z = pack2(o[4], o[5]); p0.w = pack2(o[6], o[7]);
                    p1.x = pack2(o[8], o[9]); p1.y = pack2(o[10], o[11]); p1.z = pack2(o[12], o[13]); p1.w = pack2(o[14], o[15]);
                    store_wide32((char*)(p.ws + OFF_XB), ((r0 + m * 16) * 1024u + (unsigned)c0) * 2u, 2048u, fr, p0, p1);
                }
            }
        }
    };
    if (skew) conv_moe_all(p, layer);
    g8::gemm8<true, false, true, -10>((LAS unsigned char*)lds, 1024, 1024, 512, gen, epi);
    if (!skew) conv_moe_all(p, layer);
}

DEV void phase_front(const Params& p, int layer, char* lds) {
    constexpr int LDH = 1032;
    bf16_t* HT = (bf16_t*)lds;
    float* LG = (float*)(HT + 32 * LDH);
    int* cntl = (int*)(LG + 32 * 64);
    int* basel = cntl + 128;
    int* sel = basel + 128;
    const int tid = tid_op(), lane = tid & 63, wid = tid >> 6, qi = lane & 15, g = lane >> 4;
    const float* gam = p.in[I_N2G] + layer * 1024;
    const float* mod = (const float*)(p.ws + OFF_MOD) + (size_t)layer * 16 * 6144;
    const bf16_t* WrT = (const bf16_t*)(p.ws + OFF_WRT);
    bf16_t* Hb = (bf16_t*)(p.ws + OFF_H);
    const float bias = p.in[I_RB][layer * 64 + lane];
    float* wts = (float*)(p.ws + OFF_WTS);
    int* cnt = (int*)(p.ws + OFF_CNT) + layer * 128 * CNT_STRIDE;
    lds_barrier();
    if (tid < 128) cntl[tid] = 0;
    const int ntok = T / (int)gridDim.x, tbase = bid_op() * ntok;
    const int grp = lane >> 3;
    bf16x8 bw[16];
    const bf16_t* wp = WrT + (size_t)((wid & 3) * 16 + qi) * 1024 + 8 * g;
#pragma unroll
    for (int kk = 0; kk < 16; ++kk) bw[kk] = *(const bf16x8*)(wp + 32 * kk);
    uint2 xq[4][4];
#pragma unroll
    for (int rr = 0; rr < 4; ++rr)
#pragma unroll
        for (int i = 0; i < 4; ++i) xq[rr][i] = *(const uint2*)((const bf16_t*)(p.ws + OFF_XB) + (size_t)(tbase + wid * 4 + rr) * 1024 + i * 256 + lane * 4);
#pragma unroll 1
    for (int sub = 0; sub < ntok / 32; ++sub) {
        const int t0 = tbase + sub * 32;
        {
            f32x4 v[4][4];
#pragma unroll
            for (int rr = 0; rr < 4; ++rr)
#pragma unroll
                for (int i = 0; i < 4; ++i) { const uint2 q = xq[rr][i];
                    v[rr][i] = (f32x4){__uint_as_float(q.x << 16), __uint_as_float(q.x & 0xffff0000u), __uint_as_float(q.y << 16), __uint_as_float(q.y & 0xffff0000u)}; }
            if (sub + 1 < ntok / 32) {
#pragma unroll
                for (int rr = 0; rr < 4; ++rr)
#pragma unroll
                    for (int i = 0; i < 4; ++i) xq[rr][i] = *(const uint2*)((const bf16_t*)(p.ws + OFF_XB) + (size_t)(t0 + 32 + wid * 4 + rr) * 1024 + i * 256 + lane * 4);
            }
            const int b = t0 >> 11;
            const float* sh = mod + (size_t)b * 6144 + 3 * 1024;
            const float* sc = sh + 1024;
#pragma unroll
            for (int rr = 0; rr < 4; ++rr) {
                float ss = 0.f;
#pragma unroll
                for (int i = 0; i < 4; ++i) ss += v[rr][i][0] * v[rr][i][0] + v[rr][i][1] * v[rr][i][1] + v[rr][i][2] * v[rr][i][2] + v[rr][i][3] * v[rr][i][3];
                ss = wave_sum(ss);
                const float rstd = rsqrtf(ss * (1.f / 1024.f) + 1e-6f);
                const int row = t0 + wid * 4 + rr;
#pragma unroll
                for (int i = 0; i < 4; ++i) {
                    const int c = i * 256 + lane * 4;
                    const f32x4 g4 = *(const f32x4*)(gam + c), sc4 = *(const f32x4*)(sc + c), sh4 = *(const f32x4*)(sh + c);
                    const float y0 = v[rr][i][0] * rstd * g4[0] * (1.f + sc4[0]) + sh4[0], y1 = v[rr][i][1] * rstd * g4[1] * (1.f + sc4[1]) + sh4[1];
                    const float y2 = v[rr][i][2] * rstd * g4[2] * (1.f + sc4[2]) + sh4[2], y3 = v[rr][i][3] * rstd * g4[3] * (1.f + sc4[3]) + sh4[3];
                    uint2 o; o.x = pack2(y0, y1); o.y = pack2(y2, y3);
                    *(unsigned*)(p.ws + OFF_H2F8 + (size_t)row * 1024 + c) = pack4_fp8(y0 * F8_ACT_SCALE, y1 * F8_ACT_SCALE, y2 * F8_ACT_SCALE, y3 * F8_ACT_SCALE);
                    *(uint2*)&HT[(wid * 4 + rr) * LDH + c] = o;
                }
            }
        }
        lds_barrier();
        {
            const int mt = wid >> 2, nt = wid & 3;
            f32x4 acc = (f32x4){0.f, 0.f, 0.f, 0.f}, acc2 = acc;
            const bf16_t* hp = HT + (mt * 16 + qi) * LDH + 8 * g;
            bf16x8 bw2[16];
#pragma unroll
            for (int kk = 0; kk < 16; ++kk) bw2[kk] = *(const bf16x8*)(wp + 32 * (16 + kk));
#pragma unroll
            for (int kk = 0; kk < 16; kk += 2) {
                acc = __builtin_amdgcn_mfma_f32_16x16x32_bf16(*(const bf16x8*)(hp + 32 * kk), bw[kk], acc, 0, 0, 0);
                acc2 = __builtin_amdgcn_mfma_f32_16x16x32_bf16(*(const bf16x8*)(hp + 32 * (kk + 1)), bw[kk + 1], acc2, 0, 0, 0);
            }
#pragma unroll
            for (int kk = 0; kk < 16; kk += 2) {
                acc = __builtin_amdgcn_mfma_f32_16x16x32_bf16(*(const bf16x8*)(hp + 32 * (16 + kk)), bw2[kk], acc, 0, 0, 0);
                acc2 = __builtin_amdgcn_mfma_f32_16x16x32_bf16(*(const bf16x8*)(hp + 32 * (17 + kk)), bw2[kk + 1], acc2, 0, 0, 0);
            }
#pragma unroll
            for (int j = 0; j < 4; ++j) LG[(mt * 16 + 4 * g + j) * 64 + nt * 16 + qi] = acc[j] + acc2[j];
        }
        lds_barrier();
#pragma unroll 1
        for (int rr = 0; rr < 4; ++rr) {
            const int k = sub * 32 + wid * 4 + rr, t = tbase + k;
            const float s = fsigmoid(LG[(wid * 4 + rr) * 64 + lane]);
            const float c = s + bias;
            float m1 = c;
            m1 = max8(m1);
            const unsigned long long bal = __ballot(c == m1);
            const unsigned gb = (unsigned)((bal >> (grp * 8)) & 0xffull);
            const int first = __ffs(gb) - 1;
            float c2 = ((lane & 7) == first) ? -INFINITY : c;
            c2 = max8(c2);
            const float gs = m1 + c2;
            int cg = 0;
#pragma unroll
            for (int gg = 0; gg < 8; ++gg) { const float v = __builtin_bit_cast(float, __builtin_amdgcn_readlane(__builtin_bit_cast(int, gs), gg * 8)); cg += (v > gs || (v == gs && gg < grp)) ? 1 : 0; }
            const float masked = (cg < 4) ? c : -INFINITY;
            int r = 0;
#pragma unroll
            for (int j = 0; j < 64; ++j) { const float v = __builtin_bit_cast(float, __builtin_amdgcn_readlane(__builtin_bit_cast(int, masked), j)); r += (v > masked || (v == masked && j < lane)) ? 1 : 0; }
            const bool selb = (r < 8) && (cg < 4);
            const float wsum = wave_sum(selb ? s : 0.f);
            if (selb) {
                const int half = t / HALF_T;
                wts[(size_t)t * 8 + r] = s / wsum * 2.5f;
                const int lr = atomicAdd(&cntl[half * 64 + lane], 1);
                sel[k * 8 + r] = (lane << 16) | lr;
            }
        }
    }
    lds_barrier();
    if (tid < 128) basel[tid] = atomicAdd(&cnt[tid * CNT_STRIDE], cntl[tid]);
    lds_barrier();
    int* erow = (int*)(p.ws + OFF_EROW); int* prel = (int*)(p.ws + OFF_POS);
    for (int i = tid; i < ntok * 8; i += 512) {
        const int t = tbase + (i >> 3), v = sel[i], e = v >> 16, r = basel[e] + (v & 0xffff);
        erow[(size_t)e * T + r] = t; prel[t * NSLOT + (i & 7)] = (e << 16) | r;
    }
    for (int i = tid; i < ntok; i += 512) { const int t = tbase + i; erow[(size_t)NEXP * T + t] = t; prel[t * NSLOT + 8] = (NEXP << 16) | t; }
}

DEV void moe_tables(const Params& p, int layer, char* lds) {
    LAS int* TL = (LAS int*)(lds + 131072);
    LAS int* TS = TL + TL_PAD + 512;
    const int* cnt = (const int*)(p.ws + OFF_CNT) + layer * 128 * CNT_STRIDE;
    const int tid = tid_op(), lane = tid & 63;
    __syncthreads();
    if (tid < 64) {
        const int nt = (cnt[tid * CNT_STRIDE] + 255) >> 8;
        int inc = nt;
#pragma unroll
        for (int o = 1; o < 64; o <<= 1) { const int n = __builtin_bit_cast(int, sup(__builtin_bit_cast(float, inc), o)); if (lane >= o) inc += n; }
        TS[tid] = inc - nt;
        if (tid == 63) { TS[64] = inc; TS[65] = inc + T / 256; }
    }
    __syncthreads();
    const int ntiles = TS[65];
    for (int tile = tid; tile < ntiles; tile += 512) {
        int l = 0;
#pragma unroll
        for (int st = 64; st > 0; st >>= 1) { const int q = l + st; if (q <= 64 && TS[q] <= tile) l = q; }
        TL[tile] = l;
    }
    __syncthreads();
}

DEV void phase_moe_up(const Params& p, int layer, int half, char* lds) {
    const char* H = (const char*)(p.ws + OFF_H2F8);
    const char* W13 = (const char*)(p.ws + OFF_W13);
    bf16_t* HID = (bf16_t*)(p.ws + OFF_HID);
    moe_tables(p, layer, lds);
    LAS int* TL = (LAS int*)(lds + 131072);
    struct Gen { const char* H; const char* W; const int* erow; LAS const int* tl; LAS const int* ts; LAS int* rb; int nun, G, c;
        DEV bool next(int i, g8::GUnit& u) const { const int L = i * G + c; if (L >= nun) return false; const int tile = L >> 1, pn = L & 1, l = __builtin_amdgcn_readfirstlane(tl[tile]), t0 = __builtin_amdgcn_readfirstlane(ts[l]);
            u.pm = tile; u.pn = pn; u.aux = l; u.rows = erow + (size_t)l * T + (tile - t0) * 256; u.A = H; u.B = W + ((size_t)l * 512 + pn * 256) * 1024; return true; } } gen;
    gen.H = H; gen.W = W13; gen.erow = (const int*)(p.ws + OFF_EROW); gen.tl = TL; gen.ts = TL + TL_PAD + 512; gen.rb = TL + TL_PAD; gen.nun = __builtin_amdgcn_readfirstlane(TL[TL_PAD + 512 + 65]) * 2; gen.G = gridDim.x; gen.c = bid_op();
    auto epi = [&](const f32x4 (&acc)[2][2][4][2], const g8::GUnit& u, int wr, int wc, int fr, int fq) {
#pragma unroll
        for (int ai = 0; ai < 2; ++ai)
#pragma unroll
            for (int m = 0; m < 4; ++m) {
                const int row = u.pm * 256 + ai * 128 + wr * 64 + m * 16 + fr;
                uint2 o;
#pragma unroll
                for (int bj = 0; bj < 2; ++bj) {
                    const f32x4 v1 = acc[ai][bj][m][0], v3 = acc[ai][bj][m][1];
                    const unsigned w = pack4_fp8(fsilu(v1[0]) * v3[0] * F8_ACT_SCALE, fsilu(v1[1]) * v3[1] * F8_ACT_SCALE, fsilu(v1[2]) * v3[2] * F8_ACT_SCALE, fsilu(v1[3]) * v3[3] * F8_ACT_SCALE);
                    if (bj == 0) o.x = w; else o.y = w;
                }
                *(uint2*)((unsigned char*)HID + (size_t)row * 256 + u.pn * 128 + 32 * wc + 8 * fq) = o;
            }
    };
    g8::gemm8<true, true, true, -9>((LAS unsigned char*)lds, 1024, 1024, 512, gen, epi);
}
DEV void phase_moe_down(const Params& p, int half, char* lds) {
    const char* HID = (const char*)(p.ws + OFF_HID);
    const char* W2 = (const char*)(p.ws + OFF_W2);
    unsigned char* OA = (unsigned char*)(p.ws + OFF_OUTA);
    LAS int* TL = (LAS int*)(lds + 131072);
    struct Gen { const char* HID; const char* W; const char* WS; LAS const int* tl; int nun, G, c;
        DEV bool next(int i, g8::GUnit& u) const { const int L = i * G + c; if (L >= nun) return false; const int tile = L >> 2, pn = L & 3, l = __builtin_amdgcn_readfirstlane(tl[tile]);
            u.pm = tile; u.pn = pn; u.aux = l; u.rows = nullptr; u.A = HID + (size_t)tile * 256 * 256; u.B = (l < NEXP ? W + (size_t)l * 1024 * 256 : WS) + (size_t)pn * 256 * 256; return true; } } gen;
    if (bid_op() & 1) __builtin_amdgcn_s_sleep(127);
    gen.HID = HID; gen.W = W2; gen.WS = (const char*)(p.ws + OFF_W2S); gen.tl = TL; gen.nun = __builtin_amdgcn_readfirstlane(TL[TL_PAD + 512 + 65]) * 4; gen.G = gridDim.x; gen.c = bid_op();
    auto epi = [&](const f32x4 (&acc)[2][2][4][2], const g8::GUnit& u, int wr, int wc, int fr, int fq) {
#pragma unroll
        for (int ai = 0; ai < 2; ++ai)
#pragma unroll
            for (int m = 0; m < 4; ++m) {
                const int row = u.pm * 256 + ai * 128 + wr * 64 + m * 16 + fr;
                unsigned w4[4];
#pragma unroll
                for (int bj = 0; bj < 2; ++bj) {
                    const f32x4 v0 = acc[ai][bj][m][0], v1 = acc[ai][bj][m][1];
                    w4[2 * bj] = pack4_fp8(v0[0], v0[1], v0[2], v0[3]); w4[2 * bj + 1] = pack4_fp8(v1[0], v1[1], v1[2], v1[3]);
                }
                *(uint4*)(OA + (size_t)row * 1024 + u.pn * 256 + 64 * wc + 16 * fq) = make_uint4(w4[0], w4[1], w4[2], w4[3]);
            }
    };
    g8::gemm8<true, false, true, -5>((LAS unsigned char*)lds, 256, 256, 128, gen, epi);
}
DEV void phase_combine(const Params& p, int layer, int half, char* lds) {
    const LAS int* TS = (const LAS int*)(lds + 131072) + TL_PAD + 512;
    const unsigned char* OA = (const unsigned char*)(p.ws + OFF_OUTA);
    const float* mod = (const float*)(p.ws + OFF_MOD) + (size_t)layer * 16 * 6144;
    const float* modn = (const float*)(p.ws + OFF_MOD) + (size_t)(layer + 1) * 16 * 6144;
    const float* gnx = p.in[I_N1G] + (layer + 1) * 1024;
    bf16_t* Hb = (bf16_t*)(p.ws + OFF_H);
    const int tid = tid_op(), lane = tid & 63, wid = tid >> 6;
    typedef float f32x2v __attribute__((ext_vector_type(2)));
    for (int tl0 = bid_op() * 8 + wid; tl0 < HALF_T; tl0 += gridDim.x * 8) {
        const int tok = __builtin_amdgcn_readfirstlane(half * HALF_T + tl0), b = tok >> 11;
        const float* wt = (const float*)(p.ws + OFF_WTS) + (size_t)tok * 8;
        const int* ps = (const int*)(p.ws + OFF_POS) + (size_t)tok * NSLOT;
        uint4 rw[NSLOT];
#pragma unroll
        for (int k = 0; k < NSLOT; ++k) { const int v = ps[k]; rw[k] = *(const uint4*)(OA + (size_t)(TS[v >> 16] * 256 + (v & 0xffff)) * 1024 + lane * 16); }
        float* o = p.out + (size_t)tok * 1024 + lane * 16;
        float x[16];
        { const bf16_t* xb = (const bf16_t*)(p.ws + OFF_XB) + (size_t)tok * 1024 + lane * 16;
          const uint4 q0 = *(const uint4*)xb, q1 = *(const uint4*)(xb + 8); unpack8(q0, x); unpack8(q1, x + 8); }
        float a[16];
#pragma unroll
        for (int j = 0; j < 16; ++j) a[j] = 0.f;
#pragma unroll
        for (int k = 0; k < NSLOT; ++k) {
            const float w = ((k < 8) ? wt[k] : 1.f) * (1.f / 16.f);
            const unsigned uu[4] = {rw[k].x, rw[k].y, rw[k].z, rw[k].w};
#pragma unroll
            for (int q = 0; q < 4; ++q) {
                const f32x2v f0 = __builtin_amdgcn_cvt_pk_f32_fp8((int)uu[q], false), f1 = __builtin_amdgcn_cvt_pk_f32_fp8((int)uu[q], true);
                a[4 * q] += w * f0[0]; a[4 * q + 1] += w * f0[1]; a[4 * q + 2] += w * f1[0]; a[4 * q + 3] += w * f1[1];
            }
        }
        const float* g2 = mod + (size_t)b * 6144 + 5 * 1024 + lane * 16;
        float xn[16]; float ss = 0.f;
#pragma unroll
        for (int q = 0; q < 4; ++q) {
            const f32x4 gq = *(const f32x4*)(g2 + 4 * q);
#pragma unroll
            for (int j = 0; j < 4; ++j) { xn[4 * q + j] = x[4 * q + j] + gq[j] * a[4 * q + j]; ss += xn[4 * q + j] * xn[4 * q + j]; }
            if (layer != 0) *(f32x4*)(o + 4 * q) = (f32x4){xn[4 * q], xn[4 * q + 1], xn[4 * q + 2], xn[4 * q + 3]};
        }
        if (layer == 0) {
            {
                bf16_t* ob = (bf16_t*)p.out + (size_t)tok * 1024 + lane * 16; uint4 w;
                w.x = pack2(xn[0], xn[1]); w.y = pack2(xn[2], xn[3]); w.z = pack2(xn[4], xn[5]); w.w = pack2(xn[6], xn[7]); *(uint4*)ob = w;
                w.x = pack2(xn[8], xn[9]); w.y = pack2(xn[10], xn[11]); w.z = pack2(xn[12], xn[13]); w.w = pack2(xn[14], xn[15]); *(uint4*)(ob + 8) = w;
            }
            ss = wave_sum(ss);
            const float rstd = rsqrtf(ss * (1.f / 1024.f) + 1e-6f);
            const float* sh = modn + (size_t)b * 6144 + lane * 16;
            const float* sc = sh + 1024;
            float h[16];
#pragma unroll
            for (int j = 0; j < 16; ++j) h[j] = xn[j] * rstd * gnx[lane * 16 + j] * (1.f + sc[j]) + sh[j];
            uint4 w;
            w.x = pack2(h[0], h[1]); w.y = pack2(h[2], h[3]); w.z = pack2(h[4], h[5]); w.w = pack2(h[6], h[7]);
            *(uint4*)(Hb + (size_t)tok * 1024 + lane * 16) = w;
            w.x = pack2(h[8], h[9]); w.y = pack2(h[10], h[11]); w.z = pack2(h[12], h[13]); w.w = pack2(h[14], h[15]);
            *(uint4*)(Hb + (size_t)tok * 1024 + lane * 16 + 8) = w;
            const float s8 = F8_ACT_SCALE;
            *(uint4*)(p.ws + OFF_H8 + (size_t)tok * 1024 + lane * 16) = make_uint4(pack4_fp8(h[0] * s8, h[1] * s8, h[2] * s8, h[3] * s8), pack4_fp8(h[4] * s8, h[5] * s8, h[6] * s8, h[7] * s8),
                                                                                   pack4_fp8(h[8] * s8, h[9] * s8, h[10] * s8, h[11] * s8), pack4_fp8(h[12] * s8, h[13] * s8, h[14] * s8, h[15] * s8));
        }
    }
}

typedef short v4i16_t __attribute__((ext_vector_type(4)));
DEV v4i16_t lds_tr(const bf16_t* ptr) { return __builtin_amdgcn_ds_read_tr16_b64_v4i16((LAS v4i16_t*)ptr); }

DEV void prep_hgrn(const Params& p, int layer, int u, char* lds, int tid, uint4 rf0, uint4 rf1, uint4 rq0, uint4 rq1) {
    float* LF = (float*)lds;
    float* OFFS = LF + 64 * 128;
    bf16_t* P = (bf16_t*)(p.ws + OFF_PROJ);
    const int bh = u >> 5, c = u & 31, b = bh >> 2, h = bh & 3;
    const int row0 = tid >> 4, col0 = (tid & 15) * 8;
    bf16_t* gb = P + ((size_t)b * SEQ + c * 64 + row0) * DIN + h * 128 + col0;
    float kk[2][8], qq[2][8];
    float lbv[8];
#pragma unroll
    for (int j = 0; j < 8; ++j) { lbv[j] = 0.f; if (layer == 1) { const float p0 = p.in[I_HLB][h * 128 + col0 + j], p1 = p.in[I_HLB][512 + h * 128 + col0 + j]; lbv[j] = 1.f / (1.f + __expf(p0 - p1)); } }
    lds_barrier();
#pragma unroll
    for (int i = 0; i < 2; ++i) {
        const int row = row0 + 32 * i;
        float z[8], qv[8], lf[8];
        unpack8(i == 0 ? rf0 : rf1, z); unpack8(i == 0 ? rq0 : rq1, qv);
#pragma unroll
        for (int j = 0; j < 8; ++j) {
            const float lb = lbv[j];
            const float sg = fsigmoid(z[j]);
            lf[j] = __logf(lb + (1.f - lb) * sg);
            kk[i][j] = (1.f - lb) * (1.f - sg);
            qq[i][j] = fsilu(qv[j]);
        }
        *(f32x4*)&LF[row * 128 + col0] = (f32x4){lf[0], lf[1], lf[2], lf[3]};
        *(f32x4*)&LF[row * 128 + col0 + 4] = (f32x4){lf[4], lf[5], lf[6], lf[7]};
    }
    lds_barrier();
    {
        const int d = tid & 127, part = tid >> 7;
        float v[16];
#pragma unroll
        for (int t = 0; t < 16; ++t) v[t] = LF[(part * 16 + t) * 128 + d];
#pragma unroll
        for (int t = 1; t < 16; ++t) v[t] += v[t - 1];
#pragma unroll
        for (int t = 0; t < 16; ++t) LF[(part * 16 + t) * 128 + d] = v[t];
        OFFS[part * 128 + d] = v[15];
    }
    lds_barrier();
#pragma unroll
    for (int i = 0; i < 2; ++i) {
        const int row = row0 + 32 * i, part = row >> 4;
        float qm[8], km[8];
#pragma unroll
        for (int j = 0; j < 8; ++j) {
            const int d = col0 + j;
            const float o0 = OFFS[d], o1 = OFFS[128 + d], o2 = OFFS[256 + d];
            const float off = (part > 0 ? o0 : 0.f) + (part > 1 ? o1 : 0.f) + (part > 2 ? o2 : 0.f);
            const float At = LF[row * 128 + d] + off, Am = LF[31 * 128 + d] + o0;
            qm[j] = qq[i][j] * __expf(At - Am);
            km[j] = kk[i][j] * __expf(fminf(Am - At, 60.f));
        }
        uint4 w; w.x = pack2(qm[0], qm[1]); w.y = pack2(qm[2], qm[3]); w.z = pack2(qm[4], qm[5]); w.w = pack2(qm[6], qm[7]);
        *(uint4*)(gb + (size_t)(32 * i) * DIN + C_HQ) = w;
        w.x = pack2(km[0], km[1]); w.y = pack2(km[2], km[3]); w.z = pack2(km[4], km[5]); w.w = pack2(km[6], km[7]);
        *(uint4*)(gb + (size_t)(32 * i) * DIN + C_HF) = w;
    }
    if (tid < 128) {
        const float o0 = OFFS[tid], o1 = OFFS[128 + tid], o2 = OFFS[256 + tid];
        const float Am = LF[31 * 128 + tid] + o0, Ac = LF[63 * 128 + tid] + o0 + o1 + o2;
        float* ev = (float*)(p.ws + OFF_EVBUF) + (size_t)u * 384;
        ev[tid] = __expf(Am); ev[128 + tid] = __expf(Ac); ev[256 + tid] = __expf(Ac - Am);
    }
}

DEV void prep_mlstm(const Params& p, int layer, int u, char* lds, int tid, uint4 rr0, uint4 rr1, uint4 rr2, float gmi, float gmf) {
    bf16_t* RAW = (bf16_t*)lds;
    float* EQ = (float*)(RAW + 67 * 128 + 64);
    float* EW = EQ + 64;
    float* CW = EW + 64;
    const int lane = tid & 63, wid = tid >> 6;
    const int bh = u >> 5, c = u & 31, h = bh & 3, t0 = c * 64;
    const int pr = tid >> 4, pc8 = (tid & 15) * 8;
    lds_barrier();
    *(uint4*)&RAW[pr * 128 + pc8] = rr0;
    *(uint4*)&RAW[(pr + 32) * 128 + pc8] = rr1;
    if (tid < 48) *(uint4*)&RAW[(pr + 64) * 128 + pc8] = rr2;
    {
        const int j = tid >> 7, cc = tid & 127;
        const int ch = (cc < 64) ? (h * 64 + cc) : (256 + h * 64 + (cc - 64));
        CW[j * 128 + cc] = p.in[I_MCONV][(size_t)layer * 4 * 512 + j * 512 + ch];
    }
    if (wid == 0) {
        const float ip = gmi + p.in[I_MBI][layer * 4 + h];
        float bc = logsigmoid_f(gmf + p.in[I_MBF][layer * 4 + h]);
#pragma unroll
        for (int o = 1; o < 64; o <<= 1) { const float n = sup(bc, o); if (lane >= o) bc += n; }
        const float bcC = sfrom(bc, 63);
        const float eq = __expf(bc), ew = __expf(bcC - bc + ip);
        EQ[lane] = eq; EW[lane] = ew;
        *(f32x4*)((float*)(p.ws + OFF_GBUF) + ((size_t)bh * SEQ + t0 + lane) * 4) = (f32x4){bc, ip, eq, ew};
        if (lane == 0) ((float*)(p.ws + OFF_ECBUF))[u] = __expf(bcC);
    }
    lds_barrier();
    bf16_t* blk = (bf16_t*)(p.ws + OFF_H) + (size_t)u * (4 * 64 * 64);
#pragma unroll 1
    for (int hh = 0; hh < 2; ++hh) {
        const int row = tid >> 3, c8 = (tid & 7) * 16 + hh * 8;
        float a[8];
#pragma unroll
        for (int e = 0; e < 8; ++e) a[e] = 0.f;
#pragma unroll
        for (int j = 0; j < 4; ++j) {
            float x[8];
            unpack8(*(const uint4*)&RAW[(row + j) * 128 + c8], x);
            const f32x4 w0 = *(const f32x4*)&CW[j * 128 + c8], w1 = *(const f32x4*)&CW[j * 128 + c8 + 4];
            a[0] += w0[0] * x[0]; a[1] += w0[1] * x[1]; a[2] += w0[2] * x[2]; a[3] += w0[3] * x[3];
            a[4] += w1[0] * x[4]; a[5] += w1[1] * x[5]; a[6] += w1[2] * x[6]; a[7] += w1[3] * x[7];
        }
        const bool isq = c8 < 64;
        const float sc = isq ? 1.f : 0.125f;
        const float ex = isq ? EQ[row] : EW[row];
        float y[8], ys[8];
#pragma unroll
        for (int e = 0; e < 8; ++e) { y[e] = fsilu(a[e]) * sc; ys[e] = y[e] * ex; }
        bf16_t* d0 = blk + (isq ? 0 : 4096) + row * 64 + (c8 & 63);
        uint4 w;
        w.x = pack2(y[0], y[1]); w.y = pack2(y[2], y[3]); w.z = pack2(y[4], y[5]); w.w = pack2(y[6], y[7]); *(uint4*)d0 = w;
        w.x = pack2(ys[0], ys[1]); w.y = pack2(ys[2], ys[3]); w.z = pack2(ys[4], ys[5]); w.w = pack2(ys[6], ys[7]); *(uint4*)(d0 + 8192) = w;
    }
}

DEV void prep_foxk(const Params& p, int layer, int u, int tid, uint4 kr0, uint4 kr1, uint4 kr2, uint4 kr3) {
    bf16_t* P = (bf16_t*)(p.ws + OFF_PROJ);
    const int bh = u >> 3, rb = u & 7, b = bh >> 3, h = bh & 7;
    const int r = tid >> 3, c8 = (tid & 7) * 8;
    bf16_t* kp = P + ((size_t)b * SEQ + rb * 256 + r) * DIN + C_FK + h * 64 + c8;
    float gk[8];
#pragma unroll
    for (int d = 0; d < 8; ++d) gk[d] = p.in[I_FOXKG][layer * 64 + c8 + d];
#pragma unroll
    for (int i = 0; i < 4; ++i) {
        float kf[8]; unpack8(i == 0 ? kr0 : i == 1 ? kr1 : i == 2 ? kr2 : kr3, kf);
        float ss = 0.f;
#pragma unroll
        for (int d = 0; d < 8; ++d) ss += kf[d] * kf[d];
        ss = sum8(ss);
        const float rstd = rsqrtf(ss * (1.f / 64.f) + 1e-6f);
        uint4 w;
        w.x = pack2(kf[0] * rstd * gk[0], kf[1] * rstd * gk[1]); w.y = pack2(kf[2] * rstd * gk[2], kf[3] * rstd * gk[3]);
        w.z = pack2(kf[4] * rstd * gk[4], kf[5] * rstd * gk[5]); w.w = pack2(kf[6] * rstd * gk[6], kf[7] * rstd * gk[7]);
        *(uint4*)(kp + (size_t)(64 * i) * DIN) = w;
    }
}
DEV void prep_foxf(const Params& p, int layer, int bh, char* lds, int tid) {
    float* wsum = (float*)lds;
    const float* GS = (const float*)(p.ws + OFF_GS);
    const int lane = tid & 63, wid = tid >> 6, b = bh >> 3, h = bh & 7;
    const float bfv = p.in[I_FOXBF][layer * 8 + h];
    float v[4]; float loc = 0.f;
#pragma unroll
    for (int i = 0; i < 4; ++i) { const int s = tid * 4 + i; v[i] = logsigmoid_f(GS[((size_t)b * SEQ + s) * 16 + h] + bfv); loc += v[i]; v[i] = loc; }
    float inc = loc;
#pragma unroll
    for (int o = 1; o < 64; o <<= 1) { const float n = sup(inc, o); if (lane >= o) inc += n; }
    lds_barrier();
    if (lane == 63) wsum[wid] = inc;
    lds_barrier();
    float base = inc - loc;
    for (int w = 0; w < wid; ++w) base += wsum[w];
    constexpr float L2E = 1.4426950408889634f;
    *(f32x4*)((float*)(p.ws + OFF_FBUF) + (size_t)bh * SEQ + tid * 4) = (f32x4){-(base + v[0]) * L2E, -(base + v[1]) * L2E, -(base + v[2]) * L2E, -(base + v[3]) * L2E};
}
DEV void phase_prep(const Params& p, int layer, char* lds) {
    const int tid = tid_op(), G = gridDim.x, bid = bid_op();
    const bf16_t* P = (const bf16_t*)(p.ws + OFF_PROJ);
    const float* GS = (const float*)(p.ws + OFF_GS);
    {
        const int row0 = tid >> 4, col0 = (tid & 15) * 8;
        uint4 a0, a1, a2, a3, n0 = make_uint4(0u, 0u, 0u, 0u), n1 = n0, n2 = n0, n3 = n0;
#define HGP_LOAD(r0_, r1_, r2_, r3_, u_) do { const int bh_ = (u_) >> 5, c_ = (u_) & 31; const bf16_t* gb_ = P + ((size_t)(bh_ >> 2) * SEQ + c_ * 64 + row0) * DIN + (bh_ & 3) * 128 + col0; \
            r0_ = *(const uint4*)(gb_ + C_HF); r1_ = *(const uint4*)(gb_ + (size_t)32 * DIN + C_HF); r2_ = *(const uint4*)(gb_ + C_HQ); r3_ = *(const uint4*)(gb_ + (size_t)32 * DIN + C_HQ); } while (0)
        int u = bid;
        if (u < 2048) HGP_LOAD(a0, a1, a2, a3, u);
        for (; u < 2048; u += G) {
            if (u + G < 2048) HGP_LOAD(n0, n1, n2, n3, u + G);
            prep_hgrn(p, layer, u, lds, tid, a0, a1, a2, a3);
            a0 = n0; a1 = n1; a2 = n2; a3 = n3;
        }
#undef HGP_LOAD
    }
    {
        const int pr = tid >> 4, pc8 = (tid & 15) * 8;
        uint4 a0, a1, a2, n0 = make_uint4(0u, 0u, 0u, 0u), n1 = n0, n2 = n0; float g0 = 0.f, g1 = 0.f, m0 = 0.f, m1 = 0.f;
#define MLP_LOAD(r0_, r1_, r2_, gi_, gf_, u_) do { const int bh_ = (u_) >> 5, t0_ = ((u_) & 31) * 64, h_ = bh_ & 3; const bf16_t* rowb_ = P + (size_t)(bh_ >> 2) * SEQ * DIN; \
            const unsigned off_ = (unsigned)pr * DIN + (unsigned)((pc8 < 64) ? (C_MQK + h_ * 64 + pc8) : (C_MQK + 256 + h_ * 64 + (pc8 - 64))); \
            const bf16_t* ub_ = rowb_ + (ptrdiff_t)(t0_ - 3) * DIN; const bool ok_ = (t0_ - 3 + pr >= 0); \
            r0_ = *(const uint4*)(ok_ ? ub_ + off_ : rowb_); if (!ok_) r0_ = make_uint4(0u, 0u, 0u, 0u); \
            r1_ = *(const uint4*)(ub_ + off_ + 32u * DIN); r2_ = *(const uint4*)((tid < 48) ? ub_ + off_ + 64u * DIN : rowb_); \
            const float* gp_ = GS + ((size_t)(bh_ >> 2) * SEQ + t0_ + (tid & 63)) * 16 + 8; gi_ = gp_[h_]; gf_ = gp_[4 + h_]; } while (0)
        int u = bid;
        if (u < 2048) MLP_LOAD(a0, a1, a2, g0, g1, u);
        for (; u < 2048; u += G) {
            if (u + G < 2048) MLP_LOAD(n0, n1, n2, m0, m1, u + G);
            prep_mlstm(p, layer, u, lds, tid, a0, a1, a2, g0, g1);
            a0 = n0; a1 = n1; a2 = n2; g0 = m0; g1 = m1;
        }
#undef MLP_LOAD
    }
    {
        const int r = tid >> 3, c8 = (tid & 7) * 8;
        uint4 a0, a1, a2, a3, n0 = make_uint4(0u, 0u, 0u, 0u), n1 = n0, n2 = n0, n3 = n0;
#define FKP_LOAD(r0_, r1_, r2_, r3_, u_) do { const int bh_ = (u_) >> 3, rb_ = (u_) & 7; const bf16_t* kp_ = P + ((size_t)(bh_ >> 3) * SEQ + rb_ * 256 + r) * DIN + C_FK + (bh_ & 7) * 64 + c8; \
            r0_ = *(const uint4*)kp_; r1_ = *(const uint4*)(kp_ + (size_t)64 * DIN); r2_ = *(const uint4*)(kp_ + (size_t)128 * DIN); r3_ = *(const uint4*)(kp_ + (size_t)192 * DIN); } while (0)
        int u = bid;
        if (u < 1024) FKP_LOAD(a0, a1, a2, a3, u);
        for (; u < 1024; u += G) {
            if (u + G < 1024) FKP_LOAD(n0, n1, n2, n3, u + G);
            prep_foxk(p, layer, u, tid, a0, a1, a2, a3);
            a0 = n0; a1 = n1; a2 = n2; a3 = n3;
        }
#undef FKP_LOAD
    }
    for (int u = (bid + G - 128 % G) % G; u < 128; u += G) prep_foxf(p, layer, u, lds, tid);
}

template <bool DRY = false>
DEV void phase_fox(const Params& p, int layer, char* lds) {
    constexpr int LDK = 72;
    constexpr float LOG2E = 1.4426950408889634f;
    constexpr int BUFB = 2 * 128 * LDK * 2 + 512;
    int* qsh = (int*)(lds + 2 * BUFB);
    bf16_t* P = (bf16_t*)(p.ws + OFF_PROJ);
    const int tid = tid_op(), lane = tid & 63, wid = tid >> 6, qi = lane & 15, g = lane >> 4, tq = qi >> 2, tp = lane & 3;
    int* qctr = (int*)(p.ws + OFF_QCTR) + layer * 64 + (DRY ? 32 : 0);
    const int skey = tid >> 3, sc8 = (tid & 7) * 8;
    for (;;) {
        __syncthreads();
        if (tid == 0) qsh[0] = atomicAdd(qctr, 1);
        __syncthreads();
        const int u = qsh[0];
        if (u >= NB * 8 * 8) break;
        const int qb = 7 - (u / (NB * 8)), bh = u % (NB * 8), b = bh >> 3, h = bh & 7;
        const int q0 = qb * 256, nst = 2 * qb + 2;
        const float* Fg = (const float*)(p.ws + OFF_FBUF) + (size_t)bh * SEQ;
        const int wrow = q0 + wid * 32;
        bf16x8 qf[2][2];
#pragma unroll
        for (int t = 0; t < 2; ++t) {
            const int trow = wrow + 16 * t + qi;
            const bf16_t* qp = P + ((size_t)b * SEQ + trow) * DIN + C_FQ + h * 64 + 8 * g;
            float q[16];
            unpack8(*(const uint4*)qp, q); unpack8(*(const uint4*)(qp + 32), q + 8);
            float ss = 0.f;
#pragma unroll
            for (int d = 0; d < 16; ++d) ss += q[d] * q[d];
            ss = red32_sum(red16_sum(ss));
            const float rstd = rsqrtf(ss * (1.f / 64.f) + 1e-6f) * (0.125f * LOG2E);
            const float* gq = p.in[I_FOXQG] + layer * 64 + 8 * g;
#pragma unroll
            for (int s2 = 0; s2 < 2; ++s2) {
                uint4 w;
                w.x = pack2(q[8 * s2 + 0] * rstd * gq[32 * s2 + 0], q[8 * s2 + 1] * rstd * gq[32 * s2 + 1]);
                w.y = pack2(q[8 * s2 + 2] * rstd * gq[32 * s2 + 2], q[8 * s2 + 3] * rstd * gq[32 * s2 + 3]);
                w.z = pack2(q[8 * s2 + 4] * rstd * gq[32 * s2 + 4], q[8 * s2 + 5] * rstd * gq[32 * s2 + 5]);
                w.w = pack2(q[8 * s2 + 6] * rstd * gq[32 * s2 + 6], q[8 * s2 + 7] * rstd * gq[32 * s2 + 7]);
                qf[t][s2] = __builtin_bit_cast(bf16x8, w);
            }
        }
        const bf16_t* kvp = P + ((size_t)b * SEQ + skey) * DIN + h * 64 + sc8;
        uint4 kA0, kA1, vA0, vA1; float fA = 0.f;
#define FOX_LOAD(K0, K1, V0, V1, FF, st_) do { const bf16_t* np_ = kvp + (size_t)(st_) * 128 * DIN; \
            K0 = *(const uint4*)(np_ + C_FK); K1 = *(const uint4*)(np_ + (size_t)64 * DIN + C_FK); V0 = *(const uint4*)(np_ + C_FV); V1 = *(const uint4*)(np_ + (size_t)64 * DIN + C_FV); \
            if (tid < 128) FF = Fg[(st_) * 128 + tid]; } while (0)
        FOX_LOAD(kA0, kA1, vA0, vA1, fA, 0);
        float m[2] = {-INFINITY, -INFINITY}, lsum[2] = {0.f, 0.f};
        f32x4 oacc[2][4];
#pragma unroll
        for (int t = 0; t < 2; ++t)
#pragma unroll
            for (int dt = 0; dt < 4; ++dt) oacc[t][dt] = (f32x4){0.f, 0.f, 0.f, 0.f};
#define FOX_COMPUTE(st) do { \
            const bf16_t* Ks = (const bf16_t*)(lds + ((st) & 1) * BUFB); const bf16_t* Vs = Ks + 128 * LDK; const float* Fs = (const float*)(Vs + 128 * LDK); \
            if ((st) * 128 <= wrow + 31) {                         \
                f32x4 sacc[2][8]; \
                _Pragma("unroll") for (int n = 0; n < 8; ++n) { \
                    sacc[0][n] = *(const f32x4*)&Fs[n * 16 + 4 * g]; sacc[1][n] = sacc[0][n];            \
                    _Pragma("unroll") for (int s2 = 0; s2 < 2; ++s2) { \
                        const bf16x8 kfr = *(const bf16x8*)&Ks[(n * 16 + qi) * LDK + 32 * s2 + 8 * g]; \
                        sacc[0][n] = __builtin_amdgcn_mfma_f32_16x16x32_bf16(kfr, qf[0][s2], sacc[0][n], 0, 0, 0); \
                        sacc[1][n] = __builtin_amdgcn_mfma_f32_16x16x32_bf16(kfr, qf[1][s2], sacc[1][n], 0, 0, 0); \
                    } \
                } \
                const bool diag = ((st) * 128 + 127 > wrow);         \
                bf16x8 pf[2][4]; \
                _Pragma("unroll") for (int t = 0; t < 2; ++t) { \
                    const int trow = wrow + 16 * t + qi; \
                    float mx = -INFINITY; \
                    _Pragma("unroll") for (int n = 0; n < 8; ++n) { \
                        _Pragma("unroll") for (int j = 0; j < 4; ++j) { \
                            float v = sacc[t][n][j]; \
                            if (diag) v = ((st) * 128 + n * 16 + 4 * g + j <= trow) ? v : -INFINITY; \
                            sacc[t][n][j] = v; mx = fmaxf(mx, v); \
                        } \
                    } \
                    mx = red32_max(red16_max(mx)); \
                    const float mn = fmaxf(m[t], mx); \
                    const float corr = __builtin_amdgcn_exp2f(m[t] - mn); \
                    m[t] = mn; \
                    float ps = 0.f; \
                    _Pragma("unroll") for (int n = 0; n < 8; ++n) \
                        _Pragma("unroll") for (int j = 0; j < 4; ++j) { const float e = __builtin_amdgcn_exp2f(sacc[t][n][j] - mn); sacc[t][n][j] = e; ps += e; } \
                    lsum[t] = lsum[t] * corr + ps; \
                    _Pragma("unroll") for (int dt = 0; dt < 4; ++dt) { oacc[t][dt][0] *= corr; oacc[t][dt][1] *= corr; oacc[t][dt][2] *= corr; oacc[t][dt][3] *= corr; } \
                    _Pragma("unroll") for (int ks = 0; ks < 4; ++ks) { \
                        uint4 w; \
                        w.x = pack2(sacc[t][2 * ks][0], sacc[t][2 * ks][1]); w.y = pack2(sacc[t][2 * ks][2], sacc[t][2 * ks][3]); \
                        w.z = pack2(sacc[t][2 * ks + 1][0], sacc[t][2 * ks + 1][1]); w.w = pack2(sacc[t][2 * ks + 1][2], sacc[t][2 * ks + 1][3]); \
                        pf[t][ks] = __builtin_bit_cast(bf16x8, w); \
                    } \
                } \
                _Pragma("unroll") for (int ks = 0; ks < 4; ++ks) \
                    _Pragma("unroll") for (int dt = 0; dt < 4; ++dt) { \
                        const v4i16_t lo = lds_tr(&Vs[((2 * ks) * 16 + 4 * g + tq) * LDK + dt * 16 + 4 * tp]); \
                        const v4i16_t hi = lds_tr(&Vs[((2 * ks + 1) * 16 + 4 * g + tq) * LDK + dt * 16 + 4 * tp]); \
                        const bf16x8 vfr = (bf16x8){lo[0], lo[1], lo[2], lo[3], hi[0], hi[1], hi[2], hi[3]}; \
                        oacc[0][dt] = __builtin_amdgcn_mfma_f32_16x16x32_bf16(vfr, pf[0][ks], oacc[0][dt], 0, 0, 0); \
                        oacc[1][dt] = __builtin_amdgcn_mfma_f32_16x16x32_bf16(vfr, pf[1][ks], oacc[1][dt], 0, 0, 0); \
                    } \
            } \
        } while (0)
#define FOX_STORE(K0, K1, V0, V1, FF, st_) do { bf16_t* Kw = (bf16_t*)(lds + ((st_) & 1) * BUFB); bf16_t* Vw = Kw + 128 * LDK; \
            *(uint4*)&Kw[skey * LDK + sc8] = K0; *(uint4*)&Kw[(skey + 64) * LDK + sc8] = K1; \
            *(uint4*)&Vw[skey * LDK + sc8] = V0; *(uint4*)&Vw[(skey + 64) * LDK + sc8] = V1; \
            if (tid < 128) ((float*)(Vw + 128 * LDK))[tid] = FF; } while (0)
        FOX_STORE(kA0, kA1, vA0, vA1, fA, 0);
        if (1 < nst) FOX_LOAD(kA0, kA1, vA0, vA1, fA, 1);
        __syncthreads();
#pragma unroll 1
        for (int st = 0; st < nst; ++st) {
            if (st + 1 < nst) { FOX_STORE(kA0, kA1, vA0, vA1, fA, st + 1); if (st + 2 < nst) FOX_LOAD(kA0, kA1, vA0, vA1, fA, st + 2); }
            FOX_COMPUTE(st);
            __syncthreads();
        }
#undef FOX_STORE
#undef FOX_LOAD
#undef FOX_COMPUTE
#pragma unroll
        for (int t = 0; t < 2; ++t) {
            float l = lsum[t];
            l = red32_sum(red16_sum(l));
            const float il = 1.f / l;
            const int trow = wrow + 16 * t + qi;
            bf16_t* op = DRY ? (bf16_t*)(p.ws + OFF_WIN) + ((size_t)b * SEQ + trow) * 128 + (h & 1) * 64 + 4 * g : P + ((size_t)b * SEQ + trow) * DIN + C_FQ + h * 64 + 4 * g;
#pragma unroll
            for (int dt = 0; dt < 4; ++dt) {
                uint2 o; o.x = pack2(oacc[t][dt][0] * il, oacc[t][dt][1] * il); o.y = pack2(oacc[t][dt][2] * il, oacc[t][dt][3] * il);
                *(uint2*)(op + dt * 16) = o;
            }
        }
    }
}

template <bool DRY = false>
DEV void phase_mlstm(const Params& p, int layer, char* lds) {
    constexpr int LDQ = 72, LDV = 136, LDO = 132;
    bf16_t* Qs = (bf16_t*)lds;
    bf16_t* Ks = Qs + 64 * LDQ;
    bf16_t* QD = Ks + 64 * LDQ;
    bf16_t* KW = QD + 64 * LDQ;
    bf16_t* VV = KW + 64 * LDQ;
    bf16_t* PP = VV + 64 * LDV;
    float* GT = (float*)(PP + 64 * LDQ);
    float* ECs = GT + 256;
    float* OS = ECs + 4;
    bf16_t* P = (bf16_t*)(p.ws + OFF_PROJ);
    const int tid = tid_op(), lane = tid & 63, wid = tid >> 6, qi = lane & 15, g = lane >> 4, tq = qi >> 2, tp = lane & 3;
    const int row0 = tid >> 4, col0 = (tid & 15) * 8;
    const int prow = tid >> 3, pch = (tid & 7) * 8;
    const short one_bf = (short)0x3F80;
    const bf16x8 ones = (bf16x8){one_bf, one_bf, one_bf, one_bf, one_bf, one_bf, one_bf, one_bf};
    for (int u = bid_op(); u < NB * 4; u += gridDim.x) {
        const int b = u >> 2, h = u & 3;
        lds_barrier();
        for (int i = tid; i < 64 * LDQ / 2; i += 512) ((unsigned*)PP)[i] = 0u;
        float gn[8];
#pragma unroll
        for (int j = 0; j < 8; ++j) gn[j] = p.in[I_MNG][layer * 512 + h * 128 + col0 + j];
        f32x4 Cst[4], Nst[4];
#pragma unroll
        for (int dt = 0; dt < 4; ++dt) { Cst[dt] = (f32x4){0.f, 0.f, 0.f, 0.f}; Nst[dt] = (f32x4){0.f, 0.f, 0.f, 0.f}; }
        const bf16_t* rowb = P + (size_t)b * SEQ * DIN;
        const bf16_t* mlb = (const bf16_t*)(p.ws + OFF_H) + (size_t)u * 32 * (4 * 64 * 64);
        const float* gbuf = (const float*)(p.ws + OFF_GBUF) + (size_t)u * SEQ * 4;
        const float* ecb = (const float*)(p.ws + OFF_ECBUF) + u * 32;
        const unsigned off_v = (unsigned)row0 * DIN + (unsigned)(C_MV + h * 128 + col0);
        const unsigned off_o = (unsigned)row0 * DIN + (unsigned)(C_MO + h * 128 + col0);
        const unsigned off_m = (unsigned)tid * 8u;
        uint4 m0, m1, m2, m3, rv0, rv1, rg0, rg1; f32x4 gt4 = (f32x4){0.f, 0.f, 0.f, 0.f}; float ecv = 0.f;
#define ML_PREFETCH(c_) do { const int c__ = (c_); const bf16_t* mb_ = mlb + (size_t)c__ * (4 * 64 * 64); const bf16_t* uv_ = rowb + (size_t)(c__ * 64) * DIN; \
            m0 = *(const uint4*)(mb_ + off_m); m1 = *(const uint4*)(mb_ + 4096 + off_m); m2 = *(const uint4*)(mb_ + 8192 + off_m); m3 = *(const uint4*)(mb_ + 12288 + off_m); \
            rv0 = *(const uint4*)(uv_ + off_v); rv1 = *(const uint4*)(uv_ + off_v + 32u * DIN); rg0 = *(const uint4*)(uv_ + off_o); rg1 = *(const uint4*)(uv_ + off_o + 32u * DIN); \
            if (tid < 64) gt4 = *(const f32x4*)(gbuf + (size_t)(c__ * 64 + tid) * 4); ecv = ecb[c__]; } while (0)
        ML_PREFETCH(0);
#pragma unroll 1
        for (int c = 0; c < SEQ / 64; ++c) {
            *(uint4*)&Qs[prow * LDQ + pch] = m0; *(uint4*)&Ks[prow * LDQ + pch] = m1; *(uint4*)&QD[prow * LDQ + pch] = m2; *(uint4*)&KW[prow * LDQ + pch] = m3;
            *(uint4*)&VV[row0 * LDV + col0] = rv0; *(uint4*)&VV[(row0 + 32) * LDV + col0] = rv1;
            if (tid < 64) *(f32x4*)&GT[tid * 4] = gt4;
            const float ec = ecv;
            const uint4 g0 = rg0, g1 = rg1;
            if (c + 1 < SEQ / 64) ML_PREFETCH(c + 1);
            lds_barrier();
#pragma unroll
            for (int rep = 0; rep < 2; ++rep) {
                const int idx = wid + 8 * rep;
                if (idx < 10) {
                    const int tt = (idx >= 6) ? 3 : (idx >= 3) ? 2 : (idx >= 1) ? 1 : 0, st = idx - tt * (tt + 1) / 2;
                    f32x4 acc = (f32x4){0.f, 0.f, 0.f, 0.f};
#pragma unroll
                    for (int ks = 0; ks < 2; ++ks) {
                        const bf16x8 a = *(const bf16x8*)&Ks[(st * 16 + qi) * LDQ + 32 * ks + 8 * g];
                        const bf16x8 bq = *(const bf16x8*)&Qs[(tt * 16 + qi) * LDQ + 32 * ks + 8 * g];
                        acc = __builtin_amdgcn_mfma_f32_16x16x32_bf16(a, bq, acc, 0, 0, 0);
                    }
                    const float bt = GT[(tt * 16 + qi) * 4];
#pragma unroll
                    for (int j = 0; j < 4; ++j) {
                        const f32x4 gs = *(const f32x4*)&GT[(st * 16 + 4 * g + j) * 4];
                        const bool valid = (st < tt) || (4 * g + j <= qi);
                        acc[j] = valid ? acc[j] * __expf(bt - gs[0] + gs[1]) : 0.f;
                    }
                    uint2 w; w.x = pack2(acc[0], acc[1]); w.y = pack2(acc[2], acc[3]);
                    *(uint2*)&PP[(tt * 16 + qi) * LDQ + st * 16 + 4 * g] = w;
                }
            }
            f32x4 o[4], dn[4];
            {
                bf16x8 cp[2], np[2];
#pragma unroll
                for (int k2 = 0; k2 < 2; ++k2) {
                    uint4 w;
                    w.x = pack2(Cst[2 * k2][0], Cst[2 * k2][1]); w.y = pack2(Cst[2 * k2][2], Cst[2 * k2][3]);
                    w.z = pack2(Cst[2 * k2 + 1][0], Cst[2 * k2 + 1][1]); w.w = pack2(Cst[2 * k2 + 1][2], Cst[2 * k2 + 1][3]);
                    cp[k2] = __builtin_bit_cast(bf16x8, w);
                    w.x = pack2(Nst[2 * k2][0], Nst[2 * k2][1]); w.y = pack2(Nst[2 * k2][2], Nst[2 * k2][3]);
                    w.z = pack2(Nst[2 * k2 + 1][0], Nst[2 * k2 + 1][1]); w.w = pack2(Nst[2 * k2 + 1][2], Nst[2 * k2 + 1][3]);
                    np[k2] = __builtin_bit_cast(bf16x8, w);
                }
#pragma unroll
                for (int tt = 0; tt < 4; ++tt) {
                    o[tt] = (f32x4){0.f, 0.f, 0.f, 0.f}; dn[tt] = (f32x4){0.f, 0.f, 0.f, 0.f};
#pragma unroll
                    for (int k2 = 0; k2 < 2; ++k2) {
                        const uint2 a0 = *(const uint2*)&QD[(tt * 16 + qi) * LDQ + (2 * k2) * 16 + 4 * g];
                        const uint2 a1 = *(const uint2*)&QD[(tt * 16 + qi) * LDQ + (2 * k2 + 1) * 16 + 4 * g];
                        const bf16x8 af = __builtin_bit_cast(bf16x8, make_uint4(a0.x, a0.y, a1.x, a1.y));
                        o[tt] = __builtin_amdgcn_mfma_f32_16x16x32_bf16(af, cp[k2], o[tt], 0, 0, 0);
                        dn[tt] = __builtin_amdgcn_mfma_f32_16x16x32_bf16(af, np[k2], dn[tt], 0, 0, 0);
                    }
                }
            }
            bf16x8 vf[2];
#pragma unroll
            for (int ks = 0; ks < 2; ++ks) {
                const v4i16_t lo = lds_tr(&VV[(32 * ks + 8 * g + tq) * LDV + 16 * wid + 4 * tp]);
                const v4i16_t hi = lds_tr(&VV[(32 * ks + 8 * g + 4 + tq) * LDV + 16 * wid + 4 * tp]);
                vf[ks] = (bf16x8){lo[0], lo[1], lo[2], lo[3], hi[0], hi[1], hi[2], hi[3]};
            }
#pragma unroll
            for (int dt = 0; dt < 4; ++dt) {
#pragma unroll
                for (int j = 0; j < 4; ++j) { Cst[dt][j] *= ec; Nst[dt][j] *= ec; }
#pragma unroll
                for (int ks = 0; ks < 2; ++ks) {
                    const v4i16_t lo = lds_tr(&KW[(32 * ks + 8 * g + tq) * LDQ + dt * 16 + 4 * tp]);
                    const v4i16_t hi = lds_tr(&KW[(32 * ks + 8 * g + 4 + tq) * LDQ + dt * 16 + 4 * tp]);
                    const bf16x8 kfr = (bf16x8){lo[0], lo[1], lo[2], lo[3], hi[0], hi[1], hi[2], hi[3]};
                    Cst[dt] = __builtin_amdgcn_mfma_f32_16x16x32_bf16(kfr, vf[ks], Cst[dt], 0, 0, 0);
                    Nst[dt] = __builtin_amdgcn_mfma_f32_16x16x32_bf16(kfr, ones, Nst[dt], 0, 0, 0);
                }
            }
            lds_barrier();
#pragma unroll
            for (int tt = 0; tt < 4; ++tt)
#pragma unroll
                for (int ks = 0; ks < 2; ++ks)
                    if (ks <= (tt >> 1)) {
                        const bf16x8 a = *(const bf16x8*)&PP[(tt * 16 + qi) * LDQ + 32 * ks + 8 * g];
                        o[tt] = __builtin_amdgcn_mfma_f32_16x16x32_bf16(a, vf[ks], o[tt], 0, 0, 0);
                        dn[tt] = __builtin_amdgcn_mfma_f32_16x16x32_bf16(a, ones, dn[tt], 0, 0, 0);
                    }
#pragma unroll
            for (int tt = 0; tt < 4; ++tt)
#pragma unroll
                for (int j = 0; j < 4; ++j) {
                    const float den = dn[tt][j];
                    OS[(tt * 16 + 4 * g + j) * LDO + 16 * wid + qi] = o[tt][j] * __builtin_amdgcn_rcpf(fmaxf(fabsf(den), 1.f));
                }
            lds_barrier();
            bf16_t* uo = (bf16_t*)rowb + (size_t)(c * 64) * DIN;
#pragma unroll
            for (int i = 0; i < 2; ++i) {
                const int row = row0 + 32 * i;
                const f32x4 oa = *(const f32x4*)&OS[row * LDO + col0], ob = *(const f32x4*)&OS[row * LDO + col0 + 4];
                float ss = oa[0] * oa[0] + oa[1] * oa[1] + oa[2] * oa[2] + oa[3] * oa[3] + ob[0] * ob[0] + ob[1] * ob[1] + ob[2] * ob[2] + ob[3] * ob[3];
                ss = sum16(ss);
                const float rstd = rsqrtf(ss * (1.f / 128.f) + 1e-6f);
                float gg[8]; unpack8((i == 0) ? g0 : g1, gg);
#pragma unroll
                for (int j = 0; j < 8; ++j) gg[j] = fsigmoid(gg[j]) * gn[j];
                uint4 w;
                w.x = pack2(oa[0] * rstd * gg[0], oa[1] * rstd * gg[1]); w.y = pack2(oa[2] * rstd * gg[2], oa[3] * rstd * gg[3]);
                w.z = pack2(ob[0] * rstd * gg[4], ob[1] * rstd * gg[5]); w.w = pack2(ob[2] * rstd * gg[6], ob[3] * rstd * gg[7]);
                if constexpr (DRY) *(uint4*)((bf16_t*)(p.ws + OFF_WIN) + ((size_t)b * SEQ + c * 64 + row) * 128 + col0) = w;
                else *(uint4*)(uo + off_o + (unsigned)(32 * i) * DIN) = w;
            }
        }
#undef ML_PREFETCH
    }
}

template <bool DRY = false>
DEV void phase_hgrn(const Params& p, int layer, char* lds) {
    constexpr int LDA = 136, LDP = 72, LDO = 132;
    bf16_t* QM = (bf16_t*)lds;
    bf16_t* KM = QM + 64 * LDA;
    bf16_t* VV = KM + 64 * LDA;
    bf16_t* PP = VV + 64 * LDA;
    float* EM = (float*)(PP + 64 * LDP);
    float* EC = EM + 128;
    float* EK = EC + 128;
    float* OS = EK + 128;
    bf16_t* P = (bf16_t*)(p.ws + OFF_PROJ);
    const int tid = tid_op(), lane = tid & 63, wid = tid >> 6, qi = lane & 15, g = lane >> 4, tq = qi >> 2, tp = lane & 3;
    const int row0 = tid >> 4, col0 = (tid & 15) * 8;
    for (int u = (bid_op() + (int)gridDim.x - 64) % (int)gridDim.x; u < NB * 4; u += gridDim.x) {
        const int b = u >> 2, h = u & 3;
        float gn[8];
#pragma unroll
        for (int j = 0; j < 8; ++j) gn[j] = p.in[I_HNG][layer * 512 + h * 128 + col0 + j];
        lds_barrier();
        for (int i = tid; i < 64 * LDP / 2; i += 512) ((unsigned*)PP)[i] = 0u;
        f32x4 S[8];
#pragma unroll
        for (int dt = 0; dt < 8; ++dt) S[dt] = (f32x4){0.f, 0.f, 0.f, 0.f};
        bf16_t* gbase = P + ((size_t)b * SEQ + row0) * DIN + h * 128 + col0;
        const float* evb = (const float*)(p.ws + OFF_EVBUF) + (size_t)u * 32 * 384;
        uint4 q0r, q1r, k0r, k1r, v0r, v1r, g0r, g1r; f32x4 ev4 = (f32x4){0.f, 0.f, 0.f, 0.f};
#define HG_PREFETCH(c_) do { const bf16_t* rp_ = gbase + (size_t)((c_) * 64) * DIN; \
            q0r = *(const uint4*)(rp_ + C_HQ); q1r = *(const uint4*)(rp_ + (size_t)32 * DIN + C_HQ); k0r = *(const uint4*)(rp_ + C_HF); k1r = *(const uint4*)(rp_ + (size_t)32 * DIN + C_HF); \
            v0r = *(const uint4*)(rp_ + C_HI); v1r = *(const uint4*)(rp_ + (size_t)32 * DIN + C_HI); g0r = *(const uint4*)(rp_ + C_HG); g1r = *(const uint4*)(rp_ + (size_t)32 * DIN + C_HG); \
            if (tid < 96) ev4 = *(const f32x4*)(evb + (size_t)(c_) * 384 + tid * 4); } while (0)
        HG_PREFETCH(0);
#pragma unroll 1
        for (int c = 0; c < SEQ / 64; ++c) {
            *(uint4*)&QM[row0 * LDA + col0] = q0r; *(uint4*)&QM[(row0 + 32) * LDA + col0] = q1r;
            *(uint4*)&KM[row0 * LDA + col0] = k0r; *(uint4*)&KM[(row0 + 32) * LDA + col0] = k1r;
            *(uint4*)&VV[row0 * LDA + col0] = v0r; *(uint4*)&VV[(row0 + 32) * LDA + col0] = v1r;
            if (tid < 96) *(f32x4*)&EM[tid * 4] = ev4;
            const uint4 rg0 = g0r, rg1 = g1r;
            if (c + 1 < SEQ / 64) HG_PREFETCH(c + 1);
            lds_barrier();
#pragma unroll
            for (int rep = 0; rep < 2; ++rep) {
                const int idx = wid + 8 * rep;
                if (idx < 10) {
                    const int tt = (idx >= 6) ? 3 : (idx >= 3) ? 2 : (idx >= 1) ? 1 : 0, st = idx - tt * (tt + 1) / 2;
                    f32x4 acc = (f32x4){0.f, 0.f, 0.f, 0.f};
#pragma unroll
                    for (int ks = 0; ks < 4; ++ks) {
                        const bf16x8 a = *(const bf16x8*)&KM[(st * 16 + qi) * LDA + 32 * ks + 8 * g];
                        const bf16x8 bq = *(const bf16x8*)&QM[(tt * 16 + qi) * LDA + 32 * ks + 8 * g];
                        acc = __builtin_amdgcn_mfma_f32_16x16x32_bf16(a, bq, acc, 0, 0, 0);
                    }
                    if (tt == st) {
#pragma unroll
                        for (int j = 0; j < 4; ++j) if (4 * g + j > qi) acc[j] = 0.f;
                    }
                    uint2 w; w.x = pack2(acc[0], acc[1]); w.y = pack2(acc[2], acc[3]);
                    *(uint2*)&PP[(tt * 16 + qi) * LDP + st * 16 + 4 * g] = w;
                }
            }
            f32x4 o[4];
            {
                bf16x8 sp[4];
#pragma unroll
                for (int k2 = 0; k2 < 4; ++k2) {
                    const f32x4 e0 = *(const f32x4*)&EM[(2 * k2) * 16 + 4 * g], e1 = *(const f32x4*)&EM[(2 * k2 + 1) * 16 + 4 * g];
                    uint4 w;
                    w.x = pack2(S[2 * k2][0] * e0[0], S[2 * k2][1] * e0[1]); w.y = pack2(S[2 * k2][2] * e0[2], S[2 * k2][3] * e0[3]);
                    w.z = pack2(S[2 * k2 + 1][0] * e1[0], S[2 * k2 + 1][1] * e1[1]); w.w = pack2(S[2 * k2 + 1][2] * e1[2], S[2 * k2 + 1][3] * e1[3]);
                    sp[k2] = __builtin_bit_cast(bf16x8, w);
                }
#pragma unroll
                for (int tt = 0; tt < 4; ++tt) {
                    o[tt] = (f32x4){0.f, 0.f, 0.f, 0.f};
#pragma unroll
                    for (int k2 = 0; k2 < 4; ++k2) {
                        const uint2 a0 = *(const uint2*)&QM[(tt * 16 + qi) * LDA + (2 * k2) * 16 + 4 * g];
                        const uint2 a1 = *(const uint2*)&QM[(tt * 16 + qi) * LDA + (2 * k2 + 1) * 16 + 4 * g];
                        const uint4 w = make_uint4(a0.x, a0.y, a1.x, a1.y);
                        o[tt] = __builtin_amdgcn_mfma_f32_16x16x32_bf16(__builtin_bit_cast(bf16x8, w), sp[k2], o[tt], 0, 0, 0);
                    }
                }
            }
            bf16x8 vf[2];
#pragma unroll
            for (int ks = 0; ks < 2; ++ks) {
                const v4i16_t lo = lds_tr(&VV[(32 * ks + 8 * g + tq) * LDA + 16 * wid + 4 * tp]);
                const v4i16_t hi = lds_tr(&VV[(32 * ks + 8 * g + 4 + tq) * LDA + 16 * wid + 4 * tp]);
                vf[ks] = (bf16x8){lo[0], lo[1], lo[2], lo[3], hi[0], hi[1], hi[2], hi[3]};
            }
#pragma unroll
            for (int dt = 0; dt < 8; ++dt) {
                f32x4 Tacc = (f32x4){0.f, 0.f, 0.f, 0.f};
#pragma unroll
                for (int ks = 0; ks < 2; ++ks) {
                    const v4i16_t lo = lds_tr(&KM[(32 * ks + 8 * g + tq) * LDA + dt * 16 + 4 * tp]);
                    const v4i16_t hi = lds_tr(&KM[(32 * ks + 8 * g + 4 + tq) * LDA + dt * 16 + 4 * tp]);
                    const bf16x8 kfr = (bf16x8){lo[0], lo[1], lo[2], lo[3], hi[0], hi[1], hi[2], hi[3]};
                    Tacc = __builtin_amdgcn_mfma_f32_16x16x32_bf16(kfr, vf[ks], Tacc, 0, 0, 0);
                }
                const f32x4 ec = *(const f32x4*)&EC[dt * 16 + 4 * g], ek = *(const f32x4*)&EK[dt * 16 + 4 * g];
#pragma unroll
                for (int j = 0; j < 4; ++j) S[dt][j] = ec[j] * S[dt][j] + ek[j] * Tacc[j];
            }
            lds_barrier();
#pragma unroll
            for (int tt = 0; tt < 4; ++tt)
#pragma unroll
                for (int ks = 0; ks < 2; ++ks)
                    if (ks <= (tt >> 1)) {
                        const bf16x8 a = *(const bf16x8*)&PP[(tt * 16 + qi) * LDP + 32 * ks + 8 * g];
                        o[tt] = __builtin_amdgcn_mfma_f32_16x16x32_bf16(a, vf[ks], o[tt], 0, 0, 0);
                    }
#pragma unroll
            for (int tt = 0; tt < 4; ++tt)
#pragma unroll
                for (int j = 0; j < 4; ++j) OS[(tt * 16 + 4 * g + j) * LDO + 16 * wid + qi] = o[tt][j];
            lds_barrier();
#pragma unroll
            for (int i = 0; i < 2; ++i) {
                const int row = row0 + 32 * i;
                const f32x4 oa = *(const f32x4*)&OS[row * LDO + col0], ob = *(const f32x4*)&OS[row * LDO + col0 + 4];
                float ss = oa[0] * oa[0] + oa[1] * oa[1] + oa[2] * oa[2] + oa[3] * oa[3] + ob[0] * ob[0] + ob[1] * ob[1] + ob[2] * ob[2] + ob[3] * ob[3];
                ss = sum16(ss);
                const float rstd = rsqrtf(ss * (1.f / 128.f) + 1e-6f);
                float gg[8]; unpack8((i == 0) ? rg0 : rg1, gg);
#pragma unroll
                for (int j = 0; j < 8; ++j) gg[j] = fsilu(gg[j]) * gn[j];
                uint4 w;
                w.x = pack2(oa[0] * rstd * gg[0], oa[1] * rstd * gg[1]); w.y = pack2(oa[2] * rstd * gg[2], oa[3] * rstd * gg[3]);
                w.z = pack2(ob[0] * rstd * gg[4], ob[1] * rstd * gg[5]); w.w = pack2(ob[2] * rstd * gg[6], ob[3] * rstd * gg[7]);
                if constexpr (DRY) *(uint4*)((bf16_t*)(p.ws + OFF_WIN) + ((size_t)b * SEQ + c * 64 + row) * 128 + col0) = w;
                else *(uint4*)(gbase + (size_t)(c * 64 + 32 * i) * DIN + C_HG) = w;
            }
        }
#undef HG_PREFETCH
    }
}

#define XB_TMO      128
#define XB_XCNT(j)  (256  + 64 * (j))
#define XB_XSUB(j)  (1280 + 64 * (j))
#define XB_XGEN(j)  (2304 + 64 * (j))
#define XB_TOP      3328
#define XB_TOPGEN   3392
#define XCD_BAR_WORDS 3456
#define XB_SPIN_CAP (1u << 18)
__device__ __forceinline__ unsigned xb_ld(unsigned* p)              { return __hip_atomic_load(p, __ATOMIC_RELAXED, __HIP_MEMORY_SCOPE_AGENT); }
__device__ __forceinline__ unsigned xb_add(unsigned* p, unsigned v) { return __hip_atomic_fetch_add(p, v, __ATOMIC_RELAXED, __HIP_MEMORY_SCOPE_AGENT); }
__device__ __forceinline__ unsigned xb_xcc_id() { return (unsigned)__builtin_amdgcn_s_getreg((3 << 11) | 20) & 0xFu; }
#define XB_SPIN(cond, bar) do { unsigned _sp = 0; while (cond) { __builtin_amdgcn_s_sleep(1); \
    if ((++_sp & 255u) == 0u) { if (xb_ld(&(bar)[XB_TMO])) break; if (_sp > XB_SPIN_CAP) { atomicAdd(&(bar)[XB_TMO], 1u); break; } } } } while (0)
struct XcdBarrier { unsigned* bar; unsigned x; volatile LAS unsigned* st; };
__device__ __forceinline__ XcdBarrier xcd_barrier_post(unsigned* bar, volatile LAS unsigned* st) {
    XcdBarrier b; b.bar = bar; b.x = xb_xcc_id(); b.st = st;
    if (threadIdx.x == 0) (void)xb_add(&bar[XB_XCNT(b.x)], 1u);
    return b;
}
__device__ __forceinline__ void xcd_barrier_complete(unsigned* bar, unsigned x, unsigned& nloc, unsigned& nx) {
    const unsigned G = gridDim.x * gridDim.y * gridDim.z;
    unsigned sum, cnt, mine, sp = 0u;
    for (;;) {
        sum = 0u; cnt = 0u; mine = 0u;
#pragma unroll
        for (unsigned j = 0; j < 16; ++j) { const unsigned c = xb_ld(&bar[XB_XCNT(j)]); sum += c; cnt += (c > 0u) ? 1u : 0u; mine = (j == x) ? c : mine; }
        if (sum == G) break;
        __builtin_amdgcn_s_sleep(1);
        if ((++sp & 255u) == 0u) { if (xb_ld(&bar[XB_TMO])) break; if (sp > XB_SPIN_CAP) { atomicAdd(&bar[XB_TMO], 1u); break; } }
    }
    nloc = mine > 0u ? mine : 1u; nx = cnt > 0u ? cnt : 1u;
}
__device__ __forceinline__ void xcd_barrier(const XcdBarrier& b) {
    asm volatile("s_waitcnt vmcnt(0)" ::: "memory");
    __syncthreads();
    if (threadIdx.x == 0) {
        unsigned* bar = b.bar;
        __builtin_amdgcn_s_waitcnt(0);
        unsigned nloc = b.st[0], nx = b.st[1];
        if (nloc == 0u) { xcd_barrier_complete(bar, b.x, nloc, nx); b.st[0] = nloc; b.st[1] = nx; }
        const unsigned old = xb_add(&bar[XB_XSUB(b.x)], 1u);
        const unsigned gen = old / nloc;
        if (old + 1u == (gen + 1u) * nloc) {
            __builtin_amdgcn_fence(__ATOMIC_RELEASE, "agent");
            asm volatile("s_waitcnt vmcnt(0)" ::: "memory");
            const unsigned og = xb_add(&bar[XB_TOP], 1u);
            const unsigned tg = og / nx;
            if (og + 1u == (tg + 1u) * nx) xb_add(&bar[XB_TOPGEN], 1u);
            else XB_SPIN(xb_ld(&bar[XB_TOPGEN]) == tg, bar);
            __builtin_amdgcn_fence(__ATOMIC_ACQUIRE, "agent");
            xb_add(&bar[XB_XGEN(b.x)], 1u);
            asm volatile("s_waitcnt vmcnt(0)" ::: "memory");
        } else {
            XB_SPIN(xb_ld(&bar[XB_XGEN(b.x)]) == gen, bar);
            __builtin_amdgcn_fence(__ATOMIC_ACQUIRE, "agent");
            asm volatile("s_waitcnt vmcnt(0)" ::: "memory");
        }
    }
    __syncthreads();
}

constexpr int LDS_BYTES = 131072 + 16 + TL_PAD * 4 + 2 * 256 * 4 + 512;
__global__ void __launch_bounds__(512, 2) mega_fwd(Params p) {
    extern __shared__ __attribute__((aligned(16))) char lds_all[];
    char* lds = lds_all + 16;
    if (threadIdx.x == 0) *(uint4*)lds_all = make_uint4(0u, 0u, 0u, 0u);
    __syncthreads();
    (void)xcd_barrier_post((unsigned*)(p.ws + OFF_CTL), (volatile LAS unsigned*)lds_all);
#define GRID_BAR() do { XcdBarrier b_; b_.bar = (unsigned*)(p.ws + OFF_CTL); b_.x = xb_xcc_id(); b_.st = (volatile LAS unsigned*)lds_all; xcd_barrier(b_); } while (0)
    bf16_t* Hb = (bf16_t*)(p.ws + OFF_H);
    phase_convert_mix(p, 0, lds);
    phase_ada(p, lds);
    GRID_BAR();
    phase_norm(p, p.in[I_X], 0, 0, Hb);
    GRID_BAR();
#pragma unroll 1
    for (int layer = 0; layer < 2; ++layer) {
        phase_inproj(p, lds);
        GRID_BAR();
        phase_prep(p, layer, lds);
        GRID_BAR();
        phase_mlstm(p, layer, lds);
        phase_hgrn(p, layer, lds);
        phase_fox(p, layer, lds);
        GRID_BAR();
        phase_merge(p, lds);
        GRID_BAR();
        phase_out(p, layer, lds);
        GRID_BAR();
        phase_front(p, layer, lds);
        GRID_BAR();
#pragma unroll 1
        for (int half = 0; half < NHALF; ++half) {
            phase_moe_up(p, layer, half, lds);
            GRID_BAR();
            phase_moe_down(p, half, lds);
            GRID_BAR();
            phase_combine(p, layer, half, lds);
            if (layer == 0 && half == NHALF - 1) phase_convert_mix(p, 1, lds);
            GRID_BAR();
        }
    }
}

extern "C" void kernel_launch(void* const* d_in, const int* in_sizes, int n_in, void* d_out, int out_size, void* d_ws, size_t ws_size, hipStream_t stream) {
    (void)in_sizes; (void)n_in; (void)out_size; (void)ws_size;
    Params p{};
    for (int i = 0; i < 26; ++i) p.in[i] = (const float*)d_in[i];
    p.out = (float*)d_out;
    p.ws = (unsigned char*)d_ws;
    static int grid = 0;
    if (!grid) {
        int dev = 0, cus = 0, per_cu = 0;
        (void)hipGetDevice(&dev);
        (void)hipDeviceGetAttribute(&cus, hipDeviceAttributeMultiprocessorCount, dev);
        (void)hipFuncSetAttribute((const void*)mega_fwd, hipFuncAttributeMaxDynamicSharedMemorySize, LDS_BYTES);
        (void)hipOccupancyMaxActiveBlocksPerMultiprocessor(&per_cu, mega_fwd, 512, LDS_BYTES);
        if (cus <= 0) cus = 256;
        grid = cus * (per_cu < 1 ? per_cu : 1);
        if (grid <= 0) grid = cus;
        if (grid > 256) grid = 256;
    }
    (void)hipMemsetAsync(d_ws, 0, CTL_BYTES, stream);
    hipLaunchKernelGGL(mega_fwd, dim3(grid), dim3(512), LDS_BYTES, stream, p);
}
```

```cpp
#include <hip/hip_runtime.h>
#include <stdint.h>
#include <stddef.h>

#define DEV __device__ __forceinline__
typedef unsigned short bf16_t;
typedef short bf16x8 __attribute__((ext_vector_type(8)));
typedef float f32x4 __attribute__((ext_vector_type(4)));
typedef float f32x2 __attribute__((ext_vector_type(2)));
typedef __bf16 bf16x2_t __attribute__((ext_vector_type(2)));

constexpr int T = 32768, DM = 1024, NB = 16, SEQ = 2048, NIN = 8208;
constexpr int O_FQ = 0, O_FK = 512, O_FV = 1024, O_FF = 1536, O_MQK = 1544, O_MV = 2056, O_MI = 2568, O_MF = 2572, O_MO = 2576,
              O_HF = 3088, O_HQ = 3600, O_HI = 4112, O_HG = 4624, O_GATES = 5136;
constexpr int DIN = 8256;
constexpr int C_FQ = 0, C_FK = 512, C_FV = 1024, C_MQK = 1536, C_MV = 2048, C_MO = 2560, C_HF = 3072, C_HQ = 3584, C_HI = 4096, C_HG = 4608, C_GATES = 5120,
              C_FF = 8192, C_MI = 8200, C_MF = 8204;
constexpr int YB_OFF = C_GATES * 2 + 3072;
static_assert((DIN * 2) % 128 == 0 && C_MF + 4 <= DIN && YB_OFF + 1536 <= C_FF * 2 && YB_OFF % 128 == 0, "proj row layout");
constexpr int C_MERGED = 512;
constexpr int NEXP = 64, TOPK = 8, NLIST = 65, NHALF = 1, HALF_T = T / NHALF, NSLOT = 9;
constexpr int ROWCAP = 311296;
constexpr int TILECAP = ROWCAP / 256;
constexpr int TL_PAD = (TILECAP + 63) / 64 * 64;

constexpr size_t AL(size_t x) { return (x + 255) & ~(size_t)255; }
constexpr size_t OFF_CTL = 0;
constexpr size_t OFF_CNT = 32768;
constexpr int CNT_STRIDE = 32;
constexpr size_t OFF_QCTR = 65536;
constexpr size_t CTL_BYTES = 131072;
constexpr size_t OFF_MOD = CTL_BYTES;
constexpr size_t OFF_GS = AL(OFF_MOD + (size_t)2 * 16 * 6144 * 4);
constexpr size_t OFF_IDX = AL(OFF_GS + (size_t)T * 16 * 4);
constexpr size_t OFF_WTS = AL(OFF_IDX + (size_t)T * 8 * 4);
constexpr size_t OFF_RANK = AL(OFF_WTS + (size_t)T * 8 * 4);
constexpr size_t OFF_POS = AL(OFF_RANK + (size_t)T * 8 * 4);
constexpr size_t OFF_TILEL = AL(OFF_POS + (size_t)T * NSLOT * 4);
constexpr size_t OFF_WIN = AL(OFF_TILEL + (size_t)NHALF * (TILECAP + 16) * 4);
constexpr size_t OFF_WG8 = AL(OFF_WIN + (size_t)768 * 1024 * 2);
constexpr size_t OFF_WBR = AL(OFF_WG8 + (size_t)8448 * 1024);
constexpr size_t OFF_WOUT = AL(OFF_WBR + (size_t)3 * 1024 * 512 * 2);
constexpr size_t OFF_WRT = AL(OFF_WOUT + (size_t)1024 * 1024 * 2);
constexpr size_t OFF_H = AL(OFF_WRT + (size_t)256 * 1024 * 2);
constexpr size_t OFF_H2F8 = OFF_H + (size_t)T * 1024;
constexpr size_t OFF_PROJ = AL(OFF_H + (size_t)T * 1024 * 2);
constexpr size_t OFF_END = AL(OFF_PROJ + (size_t)T * DIN * 2);
constexpr size_t OFF_W13 = OFF_PROJ;
constexpr size_t OFF_HID = AL(OFF_W13 + (size_t)NLIST * 512 * 1024);
constexpr size_t OFF_OUTA = AL(OFF_HID + (size_t)ROWCAP * 256);
constexpr size_t OFF_MOE_END = AL(OFF_OUTA + (size_t)ROWCAP * 1024);
constexpr size_t OFF_XB = OFF_MOE_END;
constexpr size_t OFF_W2 = OFF_MOE_END + (size_t)T * 2048;
static_assert(OFF_XB + (size_t)T * 2048 + (size_t)NEXP * 1024 * 256 <= OFF_END, "x1 rows and the routed down weights must fit behind the MoE overlay");
constexpr size_t OFF_FBUF = OFF_END;
constexpr size_t OFF_GBUF = AL(OFF_FBUF + (size_t)128 * SEQ * 4);
constexpr size_t OFF_ECBUF = AL(OFF_GBUF + (size_t)64 * SEQ * 16);
constexpr size_t OFF_EVBUF = AL(OFF_ECBUF + (size_t)64 * 32 * 4);
constexpr size_t OFF_H8 = AL(OFF_EVBUF + (size_t)64 * 32 * 384 * 4);
constexpr size_t OFF_W2S = AL(OFF_H8 + (size_t)T * 1024);
constexpr size_t OFF_EROW = AL(OFF_W2S + (size_t)1024 * 256 * 2);
constexpr size_t OFF_END2 = AL(OFF_EROW + (size_t)NLIST * T * 4);
static_assert((size_t)NEXP * 1024 * 256 * 2 <= (size_t)T * 1024, "routed W2 fits the lower half of H");
static_assert(OFF_MOE_END <= OFF_END, "MoE overlay must fit inside proj region");
static_assert(OFF_END2 <= (size_t)682 * 1000 * 1000, "workspace too large");
static_assert((size_t)64 * 32 * 4 * 64 * 64 * 2 <= (size_t)T * 1024 * 2, "mLSTM operand blocks fit the H region");

struct Params {
    const float* in[26];
    float* out;
    unsigned char* ws;
};
enum { I_X = 0, I_C, I_ADAW, I_ADAB, I_N1G, I_N2G, I_WIN, I_FOXBF, I_FOXQG, I_FOXKG, I_MCONV, I_MBI, I_MBF, I_MNG, I_HLB, I_HNG,
       I_WBR, I_WOUT, I_RW, I_RB, I_EW1, I_EW3, I_EW2, I_SW1, I_SW3, I_SW2 };

DEV int tid_op() { int t = threadIdx.x; asm volatile("" : "+v"(t)); return t; }
DEV int bid_op() { int b = blockIdx.x; asm volatile("" : "+s"(b)); return b; }
DEV float bf2f(bf16_t v) { return __uint_as_float((unsigned)v << 16); }
DEV unsigned pack2(float lo, float hi) { f32x2 v = {lo, hi}; bf16x2_t b = __builtin_convertvector(v, bf16x2_t); return __builtin_bit_cast(unsigned, b); }
DEV bf16_t f2bf(float f) { return (bf16_t)(pack2(f, 0.f) & 0xffffu); }
DEV float sigmoid_f(float x) { return 1.f / (1.f + __expf(-x)); }
DEV float silu_f(float x) { return x / (1.f + __expf(-x)); }
DEV float fsigmoid(float x) { return __builtin_amdgcn_rcpf(1.f + __expf(-x)); }
DEV float fsilu(float x) { return x * __builtin_amdgcn_rcpf(1.f + __expf(-x)); }
DEV unsigned pack4_fp8(float a, float b, float c, float d) {
    a = __builtin_amdgcn_fmed3f(a, -448.f, 448.f); b = __builtin_amdgcn_fmed3f(b, -448.f, 448.f); c = __builtin_amdgcn_fmed3f(c, -448.f, 448.f); d = __builtin_amdgcn_fmed3f(d, -448.f, 448.f);
    int v = __builtin_amdgcn_cvt_pk_fp8_f32(a, b, 0, false); v = __builtin_amdgcn_cvt_pk_fp8_f32(c, d, v, true); return (unsigned)v;
}
constexpr float F8_ACT_SCALE = 8.f, F8_W_SCALE = 64.f;
DEV float logsigmoid_f(float x) { return fminf(x, 0.f) - log1pf(__expf(-fabsf(x))); }
DEV int lane_op() { int l = (int)__builtin_amdgcn_mbcnt_hi(~0u, __builtin_amdgcn_mbcnt_lo(~0u, 0u)); asm volatile("" : "+v"(l)); return l; }
DEV float sx(float v, int o) { return __builtin_bit_cast(float, __builtin_amdgcn_ds_bpermute((lane_op() ^ o) << 2, __builtin_bit_cast(int, v))); }
DEV float sfrom(float v, int src) { return __builtin_bit_cast(float, __builtin_amdgcn_ds_bpermute(src << 2, __builtin_bit_cast(int, v))); }
DEV float sup(float v, int o) { const int l = lane_op(); return __builtin_bit_cast(float, __builtin_amdgcn_ds_bpermute(((l >= o) ? l - o : l) << 2, __builtin_bit_cast(int, v))); }
typedef unsigned u32x2v __attribute__((ext_vector_type(2)));
#define DPPF(v, ctrl) __builtin_bit_cast(float, __builtin_amdgcn_update_dpp(0, __builtin_bit_cast(int, (v)), (ctrl), 0xF, 0xF, true))
DEV float sum4(float v) { v += DPPF(v, 0xB1); v += DPPF(v, 0x4E); return v; }
DEV float sum8(float v) { v = sum4(v); v += DPPF(v, 0x141); return v; }
DEV float sum16(float v) { v = sum8(v); v += DPPF(v, 0x140); return v; }
DEV float max16(float v) { v = fmaxf(v, DPPF(v, 0xB1)); v = fmaxf(v, DPPF(v, 0x4E)); v = fmaxf(v, DPPF(v, 0x141)); v = fmaxf(v, DPPF(v, 0x140)); return v; }
DEV float min16(float v) { v = fminf(v, DPPF(v, 0xB1)); v = fminf(v, DPPF(v, 0x4E)); v = fminf(v, DPPF(v, 0x141)); v = fminf(v, DPPF(v, 0x140)); return v; }
DEV float max8(float v) { v = fmaxf(v, DPPF(v, 0xB1)); v = fmaxf(v, DPPF(v, 0x4E)); v = fmaxf(v, DPPF(v, 0x141)); return v; }
#define SWAP_RED(NAME, INS, OP) DEV float NAME(float v) { float a = v, b = v; asm volatile("s_nop 1\n\t" INS " %0, %1" : "+v"(a), "+v"(b)); return OP; }
SWAP_RED(red16_sum, "v_permlane16_swap_b32", a + b)
SWAP_RED(red32_sum, "v_permlane32_swap_b32", a + b)
SWAP_RED(red16_max, "v_permlane16_swap_b32", fmaxf(a, b))
SWAP_RED(red32_max, "v_permlane32_swap_b32", fmaxf(a, b))
#undef SWAP_RED
DEV float wave_sum(float v) { return red32_sum(red16_sum(sum16(v))); }
DEV void unpack8(uint4 u, float* f) {
    f[0] = __uint_as_float(u.x << 16); f[1] = __uint_as_float(u.x & 0xffff0000u);
    f[2] = __uint_as_float(u.y << 16); f[3] = __uint_as_float(u.y & 0xffff0000u);
    f[4] = __uint_as_float(u.z << 16); f[5] = __uint_as_float(u.z & 0xffff0000u);
    f[6] = __uint_as_float(u.w << 16); f[7] = __uint_as_float(u.w & 0xffff0000u);
}


constexpr int VB_VALS = 0, VF_VALS = 5120, VF_COLS = 8192;
DEV int vb_to_proj(int vc) { return C_HF + vc; }
DEV int vf_to_proj(int vc) { if (vc >= VF_VALS) return C_GATES + (vc - VF_VALS); const int blk = vc >> 9;
    return ((blk == 0) ? C_FV : (blk == 1) ? C_MV : (blk == 2) ? C_MO : (blk == 3) ? C_HI : (blk == 4) ? C_HG : (blk == 5) ? C_FQ : (blk == 6) ? C_FK : (blk == 7) ? C_MQK : (blk == 8) ? C_HQ : C_HF) + (vc & 511); }
DEV int inproj_vrow(int n, bool& f8) {
    f8 = true;
    if (n < O_FK) return 2560 + n;
    if (n < O_FV) return 3072 + (n - O_FK);
    if (n < O_FF) return n - O_FV;
    if (n < O_MQK) return 8192 + (n - O_FF);
    if (n < O_MV) return 3584 + (n - O_MQK);
    if (n < O_MI) return 512 + (n - O_MV);
    if (n < O_MO) return 8200 + (n - O_MI);
    if (n < O_HF) return 1024 + (n - O_MO);
    if (n < O_HQ) return 4608 + (n - O_HF);
    if (n < O_HI) return 4096 + (n - O_HQ);
    if (n < O_HG) return 1536 + (n - O_HI);
    if (n < O_GATES) return 2048 + (n - O_HG);
    return VF_VALS + (n - O_GATES);
}
DEV void lds_barrier() { asm volatile("s_waitcnt lgkmcnt(0)\n\ts_barrier" ::: "memory"); }
DEV const float* arg_in(int idx) {
    typedef const float* fptr_t;
    const __attribute__((address_space(4))) char* ka = (const __attribute__((address_space(4))) char*)__builtin_amdgcn_kernarg_segment_ptr();
    return *(const __attribute__((address_space(4))) fptr_t*)(ka + idx * 8);
}
struct MB { const float* src; unsigned char* dst; int ld; bool ok, f8; };
DEV MB mix_cb(const Params& p, int layer, int u, int lane, int wid) {
    MB c;
    int job, kb, nb, b = 0;
    if (u < 1032) { job = 0; kb = u & 7; nb = u >> 3; }
    else if (u < 1224) { const int r = (u - 1032) & 63; job = 1; b = (u - 1032) >> 6; kb = r & 3; nb = r >> 2; }
    else if (u < 1352) { job = 2; kb = (u - 1224) & 7; nb = (u - 1224) >> 3; }
    else { job = 3; kb = u - 1352; nb = 0; }
    const int N = (job == 0) ? NIN : (job == 3) ? 64 : 1024, K = (job == 1) ? 512 : 1024;
    const float* base = arg_in((job == 0) ? (int)I_WIN : (int)I_WBR + job - 1);
    const int n = nb * 64 + lane, k0 = kb * 128 + 16 * wid;
    c.ok = n < N; c.ld = N;
    c.src = base + ((size_t)layer * (job == 1 ? 3 : 1) + b) * (size_t)K * N + (size_t)k0 * N + (c.ok ? n : 0);
    bool f8 = (job == 1 || job == 2); int nm = n;
    if (job == 0) nm = inproj_vrow(c.ok ? n : 0, f8);
    c.f8 = f8;
    const size_t doff = (job == 0) ? (f8 ? OFF_WG8 : OFF_WIN) : (job == 1) ? OFF_WBR + (size_t)b * 1024 * 512 : (job == 2) ? OFF_WOUT : OFF_WRT;
    c.dst = p.ws + doff + (f8 ? (size_t)nm * K + k0 : ((size_t)nm * K + k0) * 2);
    return c;
}
constexpr int MIX_CBLOCKS = 1032 + 192 + 128 + 8;
DEV void phase_convert_mix(const Params& p, int layer, char* lds, const int ub = 0, const int ue = MIX_CBLOCKS, const int first = 0, int G = 0) {
    const int t = tid_op(), lane = t & 63, wid = t >> 6;
    if (G == 0) G = gridDim.x;
    if (bid_op() < first) return;
    int u = ub + bid_op() - first;
    if (u >= ue) return;
    MB c = mix_cb(p, layer, u, lane, wid);
    float v[16];
#pragma unroll
    for (int i = 0; i < 16; ++i) v[i] = c.src[(size_t)i * c.ld];
#pragma unroll 1
    for (; u < ue; u += G) {
        const bool more = u + G < ue;
        const MB cn = mix_cb(p, layer, more ? u + G : u, lane, wid);
        float nx[16];
#pragma unroll
        for (int i = 0; i < 16; ++i) nx[i] = cn.src[(size_t)i * cn.ld];
        if (c.ok) {
            if (c.f8) { const float sc = F8_W_SCALE;
                *(uint4*)c.dst = make_uint4(pack4_fp8(v[0] * sc, v[1] * sc, v[2] * sc, v[3] * sc), pack4_fp8(v[4] * sc, v[5] * sc, v[6] * sc, v[7] * sc),
                                            pack4_fp8(v[8] * sc, v[9] * sc, v[10] * sc, v[11] * sc), pack4_fp8(v[12] * sc, v[13] * sc, v[14] * sc, v[15] * sc)); }
            else { *(uint4*)c.dst = make_uint4(pack2(v[0], v[1]), pack2(v[2], v[3]), pack2(v[4], v[5]), pack2(v[6], v[7]));
                   *(uint4*)(c.dst + 16) = make_uint4(pack2(v[8], v[9]), pack2(v[10], v[11]), pack2(v[12], v[13]), pack2(v[14], v[15])); }
        }
        c = cn;
#pragma unroll
        for (int i = 0; i < 16; ++i) v[i] = nx[i];
    }
}
struct CU4 { const f32x4* src; unsigned char* dst; int ld4, pitch; };
DEV CU4 moe_cu(const Params& p, int layer, int u, int lane, int wid) {
    CU4 c;
    const int e = u / 24, r = u % 24, which = r >> 3, t = r & 7;
    const float* base = arg_in((int)I_EW1 + (e < NEXP ? 0 : 3) + which);
    const float* w = base + (size_t)(e < NEXP ? layer * NEXP + e : layer) * 262144;
    if (which < 2) { const int kb = t, nm = (lane >> 1) * 16 + (lane & 1) * 8 + (which ? 4 : 0);
        c.src = (const f32x4*)(w + (size_t)(kb * 128 + 16 * wid) * 256 + 4 * lane); c.ld4 = 64; c.pitch = 1024;
        c.dst = p.ws + OFF_W13 + (size_t)e * 512 * 1024 + (size_t)nm * 1024 + kb * 128 + 16 * wid; }
    else { const int kb = t & 1, nb = t >> 1, n = nb * 256 + 4 * lane;
        c.src = (const f32x4*)(w + (size_t)(kb * 128 + 16 * wid) * 1024 + n); c.ld4 = 256; c.pitch = 256;
        c.dst = p.ws + (e < NEXP ? OFF_W2 + (size_t)e * 1024 * 256 : OFF_W2S) + (size_t)n * 256 + kb * 128 + 16 * wid; }
    return c;
}
constexpr int MOE_CUNITS = NLIST * 24;
DEV unsigned pk4s(float a, float b, float c, float d) { const float sc = F8_W_SCALE; return pack4_fp8(a * sc, b * sc, c * sc, d * sc); }
DEV void conv_moe_all(const Params& p, int layer) {
    const int t = tid_op(), lane = t & 63, wid = t >> 6, G = gridDim.x;
    int u = bid_op();
    if (u >= MOE_CUNITS) return;
    CU4 c = moe_cu(p, layer, u, lane, wid);
    f32x4 A[8], B[8];
#pragma unroll
    for (int i = 0; i < 8; ++i) A[i] = c.src[(size_t)i * c.ld4];
#pragma unroll
    for (int i = 0; i < 8; ++i) B[i] = c.src[(size_t)(8 + i) * c.ld4];
#pragma unroll 1
    for (; u < MOE_CUNITS; u += G) {
        const bool more = u + G < MOE_CUNITS;
        const CU4 cn = moe_cu(p, layer, more ? u + G : u, lane, wid);
        unsigned lo[4][2];
#pragma unroll
        for (int j = 0; j < 4; ++j) { lo[j][0] = pk4s(A[0][j], A[1][j], A[2][j], A[3][j]); lo[j][1] = pk4s(A[4][j], A[5][j], A[6][j], A[7][j]); }
#pragma unroll
        for (int i = 0; i < 8; ++i) A[i] = cn.src[(size_t)i * cn.ld4];
#pragma unroll
        for (int j = 0; j < 4; ++j)
            *(uint4*)(c.dst + (size_t)j * c.pitch) = make_uint4(lo[j][0], lo[j][1], pk4s(B[0][j], B[1][j], B[2][j], B[3][j]), pk4s(B[4][j], B[5][j], B[6][j], B[7][j]));
#pragma unroll
        for (int i = 0; i < 8; ++i) B[i] = cn.src[(size_t)(8 + i) * cn.ld4];
        c = cn;
    }
}

DEV void phase_ada(const Params& p, char* lds) {
    float* condT = (float*)lds;
    float* red = condT + 1024 * 16;
    const int t = tid_op();
    for (int i = t; i < 16 * 1024; i += 512) { const int b = i >> 10, k = i & 1023; condT[k * 16 + b] = silu_f(p.in[I_C][i]); }
    __syncthreads();
    float* mod = (float*)(p.ws + OFF_MOD);
    for (int u = bid_op(); u < 2 * 96; u += gridDim.x) {
        const int l = u / 96, j0 = (u % 96) * 64, col = t & 63, kg = t >> 6;
        const float* w = p.in[I_ADAW] + (size_t)l * 1024 * 6144 + j0 + col;
        float acc[16];
#pragma unroll
        for (int b = 0; b < 16; ++b) acc[b] = 0.f;
        for (int k0 = kg * 128; k0 < kg * 128 + 128; k0 += 8) {
            float wv8[8];
#pragma unroll
            for (int uu = 0; uu < 8; ++uu) wv8[uu] = w[(size_t)(k0 + uu) * 6144];
#pragma unroll
            for (int uu = 0; uu < 8; ++uu) {
                const float wv = wv8[uu];
                const f32x4* cp = (const f32x4*)(condT + (k0 + uu) * 16);
#pragma unroll
                for (int q = 0; q < 4; ++q) { const f32x4 c4 = cp[q]; acc[q * 4 + 0] += c4[0] * wv; acc[q * 4 + 1] += c4[1] * wv; acc[q * 4 + 2] += c4[2] * wv; acc[q * 4 + 3] += c4[3] * wv; }
            }
        }
        __syncthreads();
#pragma unroll
        for (int b = 0; b < 16; ++b) red[(kg * 16 + b) * 64 + col] = acc[b];
        __syncthreads();
        for (int i = t; i < 16 * 64; i += 512) {
            const int b = i >> 6, c = i & 63;
            float s = p.in[I_ADAB][l * 6144 + j0 + c];
#pragma unroll
            for (int g = 0; g < 8; ++g) s += red[(g * 16 + b) * 64 + c];
            mod[((size_t)l * 16 + b) * 6144 + j0 + c] = s;
        }
    }
}

DEV void phase_norm(const Params& p, const float* xin, int layer, int which, bf16_t* hout) {
    const int lane = tid_op() & 63, wid = tid_op() >> 6;
    const float* g = p.in[which ? I_N2G : I_N1G] + layer * 1024;
    const float* mod = (const float*)(p.ws + OFF_MOD) + (size_t)layer * 16 * 6144;
    for (int row = bid_op() * 8 + wid; row < T; row += gridDim.x * 8) {
        const float* xr = xin + (size_t)row * 1024;
        f32x4 v[4]; float ss = 0.f;
#pragma unroll
        for (int i = 0; i < 4; ++i) { v[i] = *(const f32x4*)(xr + i * 256 + lane * 4); ss += v[i][0] * v[i][0] + v[i][1] * v[i][1] + v[i][2] * v[i][2] + v[i][3] * v[i][3]; }
        ss = wave_sum(ss);
        const float rstd = rsqrtf(ss * (1.f / 1024.f) + 1e-6f);
        const int b = row >> 11;
        const float* sh = mod + (size_t)b * 6144 + (which ? 3 : 0) * 1024;
        const float* sc = sh + 1024;
#pragma unroll
        for (int i = 0; i < 4; ++i) {
            const int c = i * 256 + lane * 4;
            const f32x4 g4 = *(const f32x4*)(g + c), sc4 = *(const f32x4*)(sc + c), sh4 = *(const f32x4*)(sh + c);
            float h0 = v[i][0] * rstd * g4[0] * (1.f + sc4[0]) + sh4[0];
            float h1 = v[i][1] * rstd * g4[1] * (1.f + sc4[1]) + sh4[1];
            float h2 = v[i][2] * rstd * g4[2] * (1.f + sc4[2]) + sh4[2];
            float h3 = v[i][3] * rstd * g4[3] * (1.f + sc4[3]) + sh4[3];
            if (which == 0) *(unsigned*)(p.ws + OFF_H8 + (size_t)row * 1024 + c) = pack4_fp8(h0 * F8_ACT_SCALE, h1 * F8_ACT_SCALE, h2 * F8_ACT_SCALE, h3 * F8_ACT_SCALE);
        }
    }
}

#define LAS __attribute__((address_space(3)))
namespace g8 {
typedef unsigned u32x4 __attribute__((ext_vector_type(4)));
constexpr int BM = 256, BK = 64, HALF = 128, HTB = HALF * BK * 2, STAGE_BYTES = 8 * HTB;
DEV int lds_byte(int r, int c) { const int st = (r >> 4) * 2 + (c >> 5), rr = r & 15, cc = c & 31, ob = rr * 64 + cc * 2; return st * 1024 + (ob ^ (((ob >> 9) & 1) << 5)); }
DEV void stage_rc(int b, int& R, int& C) { const int st = b / 1024, sb = b % 1024, swz = sb ^ (((sb >> 9) & 1) << 5); R = (st >> 1) * 16 + swz / 64; C = (st & 1) * 32 + (swz % 64) / 2; }
DEV int perm32(int rho) { const int n = rho >> 4, i = rho & 15; return 8 * (i >> 2) + 4 * n + (i & 3); }

struct GUnit { const char* A; const char* B; const int* rows; int pm, pn, aux; };

typedef int v8i_t __attribute__((ext_vector_type(8)));
typedef int v4i_t __attribute__((ext_vector_type(4)));
DEV v8i_t cat8(bf16x8 a, bf16x8 b) { const v4i_t x = __builtin_bit_cast(v4i_t, a), y = __builtin_bit_cast(v4i_t, b); return (v8i_t){x[0], x[1], x[2], x[3], y[0], y[1], y[2], y[3]}; }
template <bool PERM, bool GATHER, bool F8, int SEXP = 0, class Gen, class Epi>
DEV void gemm8(LAS unsigned char* lds, const int lda_b, const int ldb_b, const int K, const Gen& S, const Epi& E) {
    int tid_ = tid_op();
    const int tid = tid_, wid = __builtin_amdgcn_readfirstlane(tid >> 6), lane = tid & 63, wr = wid >> 2, wc = wid & 3, fr = lane & 15, fq = lane >> 4;
    const int nt = K / BK;
    int Rs[2], Cb[2];
    unsigned voffB[2];
#pragma unroll
    for (int i = 0; i < 2; ++i) { int R, C; stage_rc(tid * 16 + i * 8192, R, C); const int Rb = PERM ? (64 * (R >> 5) + 16 * ((R & 15) >> 2) + 4 * ((R >> 4) & 1) + (R & 3)) : R;
        Rs[i] = R; Cb[i] = C * 2; voffB[i] = (unsigned)Rb * (unsigned)ldb_b + (unsigned)C * 2u; }
    const size_t kstep = (size_t)(BK * 2);
    const size_t hstepB = (size_t)(PERM ? 8 : HALF) * ldb_b;
    const unsigned ldsw = (unsigned)wid * 1024u;
    const int aoff = lds_byte(wr * 64 + fr, fq * 8), boff = lds_byte(wc * 32 + fr, fq * 8);
#define PG8_SA(b, h) (((b) * 2 + (h)) * HTB)
#define PG8_SB(b, h) ((4 + (b) * 2 + (h)) * HTB)
#define PG8_STAGE(bufoff, gbase, voff) do { _Pragma("unroll") for (int _i = 0; _i < 2; ++_i) \
        __builtin_amdgcn_global_load_lds((const unsigned*)((const char*)(gbase) + (voff)[_i]), (LAS unsigned*)(lds + (bufoff) + ldsw + _i * 8192), 16, 0, 0); } while (0)
#define PG8_LDA(dst, b, h) do { _Pragma("unroll") for (int m = 0; m < 4; ++m) { if constexpr (F8) dst##8[m] = cat8(*(const LAS bf16x8*)(lds + PG8_SA(b, h) + aoff + m * 2048), *(const LAS bf16x8*)(lds + PG8_SA(b, h) + aoff + m * 2048 + 1024)); \
        else { _Pragma("unroll") for (int k = 0; k < 2; ++k) dst[m][k] = *(const LAS bf16x8*)(lds + PG8_SA(b, h) + aoff + m * 2048 + k * 1024); } } } while (0)
#define PG8_LDB(dst, b, h) do { _Pragma("unroll") for (int n = 0; n < 2; ++n) { if constexpr (F8) dst##8[n] = cat8(*(const LAS bf16x8*)(lds + PG8_SB(b, h) + boff + n * 2048), *(const LAS bf16x8*)(lds + PG8_SB(b, h) + boff + n * 2048 + 1024)); \
        else { _Pragma("unroll") for (int k = 0; k < 2; ++k) dst[n][k] = *(const LAS bf16x8*)(lds + PG8_SB(b, h) + boff + n * 2048 + k * 1024); } } } while (0)
#define PG8_MMA(ai, bj, At, Bt) do { __builtin_amdgcn_s_setprio(1); _Pragma("unroll") for (int m = 0; m < 4; ++m) _Pragma("unroll") for (int n = 0; n < 2; ++n) { \
        if constexpr (F8) asm volatile("v_mfma_scale_f32_16x16x128_f8f6f4 %0, %1, %2, %0, %3, %4 op_sel_hi:[0,0,0]" : "+v"(acc[ai][bj][m][n]) : "v"(Bt##8[n]), "v"(At##8[m]), "v"(0x7f7f7f7f), "v"(0x01010101 * (127 + SEXP))); \
        else { _Pragma("unroll") for (int k = 0; k < 2; ++k) acc[ai][bj][m][n] = __builtin_amdgcn_mfma_f32_16x16x32_bf16(Bt[n][k], At[m][k], acc[ai][bj][m][n], 0, 0, 0); } } \
        __builtin_amdgcn_s_setprio(0); } while (0)
#define PG8_WAIT_V(n) asm volatile("s_waitcnt vmcnt(" #n ")" ::: "memory")
#define PG8_WAIT_L(n) asm volatile("s_waitcnt lgkmcnt(" #n ")" ::: "memory")
#define PG8_BAR __builtin_amdgcn_s_barrier()
#define PG8_SCHED __builtin_amdgcn_sched_barrier(0)
    GUnit cur, nxt; int ui = 0;
    if (!S.next(0, cur)) return;
    unsigned cOff[2][2], nOff[2][2];
    auto mkoff = [&](unsigned (&o)[2][2], int buf) {
#pragma unroll
        for (int h = 0; h < 2; ++h)
#pragma unroll
            for (int i = 0; i < 2; ++i) {
                if constexpr (GATHER) { const unsigned r = (unsigned)S.rb[buf * 256 + h * HALF + Rs[i]]; o[h][i] = (r < (unsigned)T ? r : 0u) * (unsigned)lda_b + (unsigned)Cb[i]; }

                else o[h][i] = (unsigned)(h * HALF + Rs[i]) * (unsigned)lda_b + (unsigned)Cb[i];
            }
    };
    auto rows_dma = [&](const int* rows, int buf) {
        if constexpr (GATHER) __builtin_amdgcn_global_load_lds((const unsigned*)(rows + lane * 4), (LAS unsigned*)(S.rb + buf * 256), 16, 0, 0);
    };
    if constexpr (GATHER) {
        if (wid == 0) { rows_dma(cur.rows, 0); GUnit t1; if (S.next(1, t1)) rows_dma(t1.rows, 1); }
        asm volatile("s_waitcnt vmcnt(0)" ::: "memory");
        __builtin_amdgcn_s_barrier();
    }
    mkoff(cOff, 0);
    f32x4 acc[2][2][4][2];
#pragma unroll
    for (int a = 0; a < 2; ++a)
#pragma unroll
        for (int b = 0; b < 2; ++b)
#pragma unroll
            for (int m = 0; m < 4; ++m)
#pragma unroll
                for (int n = 0; n < 2; ++n) acc[a][b][m][n] = (f32x4){0.f, 0.f, 0.f, 0.f};
    bf16x8 At[4][2], B0[2][2], B1[2][2];
    v8i_t At8[4], B08[2], B18[2];
    const char* cA = cur.A; const char* cB = cur.B;
    PG8_STAGE(PG8_SB(0, 0), cB, voffB); PG8_STAGE(PG8_SB(0, 1), cB + hstepB, voffB); PG8_STAGE(PG8_SA(0, 0), cA, cOff[0]); PG8_STAGE(PG8_SA(0, 1), cA, cOff[1]);
    if (wr == 1) PG8_BAR;
    PG8_WAIT_V(2); PG8_BAR;
    PG8_STAGE(PG8_SB(1, 0), cB + kstep, voffB); PG8_STAGE(PG8_SA(1, 0), cA + kstep, cOff[0]); PG8_STAGE(PG8_SB(1, 1), cB + hstepB + kstep, voffB);
    PG8_WAIT_V(6); PG8_BAR;
    for (;;) {
        const bool has_next = S.next(ui + 1, nxt);
        if constexpr (GATHER) {
            { GUnit t2; if (S.next(ui + 2, t2) && wid == 0) rows_dma(t2.rows, ui & 1); }
            if (has_next) mkoff(nOff, (ui + 1) & 1);
            else {
#pragma unroll
                for (int h = 0; h < 2; ++h)
#pragma unroll
                    for (int i = 0; i < 2; ++i) nOff[h][i] = cOff[h][i];
            }
        }
        const char* nA = has_next ? nxt.A : cA; const char* nB = has_next ? nxt.B : cB;
#pragma unroll 1
        for (int t = 0; t < nt; t += 2) {
            const bool last = (t == nt - 2);
            const char* a1 = cA + (size_t)(t + 1) * kstep;
            const char* a2 = last ? nA : cA + (size_t)(t + 2) * kstep; const char* b2 = last ? nB : cB + (size_t)(t + 2) * kstep;
            const char* a3 = a2 + kstep; const char* b3 = b2 + kstep;
            unsigned o2[2][2];
#pragma unroll
            for (int h = 0; h < 2; ++h)
#pragma unroll
                for (int i = 0; i < 2; ++i) { if constexpr (GATHER) o2[h][i] = last ? nOff[h][i] : cOff[h][i]; else o2[h][i] = cOff[h][i]; }
            PG8_LDB(B0, 0, 0); PG8_LDB(B1, 0, 1); PG8_SCHED; PG8_LDA(At, 0, 0); PG8_STAGE(PG8_SA(1, 1), a1, cOff[1]);
            PG8_WAIT_V(8); PG8_WAIT_L(0); PG8_BAR; PG8_MMA(0, 0, At, B0); PG8_MMA(0, 1, At, B1); PG8_BAR; PG8_SCHED;
            PG8_LDA(At, 0, 1); PG8_STAGE(PG8_SB(0, 0), b2, voffB); PG8_STAGE(PG8_SB(0, 1), b2 + hstepB, voffB); PG8_STAGE(PG8_SA(0, 0), a2, o2[0]);
            PG8_WAIT_V(8); PG8_WAIT_L(0); PG8_BAR; PG8_MMA(1, 0, At, B0); PG8_MMA(1, 1, At, B1); PG8_BAR; PG8_SCHED;
            PG8_LDB(B0, 1, 0); PG8_LDB(B1, 1, 1); PG8_SCHED; PG8_LDA(At, 1, 0); PG8_STAGE(PG8_SA(0, 1), a2, o2[1]);
            PG8_WAIT_V(8); PG8_WAIT_L(0); PG8_BAR; PG8_MMA(0, 0, At, B0); PG8_MMA(0, 1, At, B1); PG8_BAR; PG8_SCHED;
            PG8_LDA(At, 1, 1); PG8_STAGE(PG8_SB(1, 0), b3, voffB); PG8_STAGE(PG8_SB(1, 1), b3 + hstepB, voffB); PG8_STAGE(PG8_SA(1, 0), a3, o2[0]);
            PG8_WAIT_V(8); PG8_WAIT_L(0); PG8_BAR; PG8_MMA(1, 0, At, B0); PG8_MMA(1, 1, At, B1); PG8_BAR; PG8_SCHED;
        }
        if (wr == 0) PG8_BAR;
        if constexpr (F8) asm volatile("s_nop 15\n\ts_nop 15" ::: "memory");
        { int pm_ = cur.pm, pn_ = cur.pn; asm volatile("" : "+s"(pm_), "+s"(pn_)); cur.pm = pm_; cur.pn = pn_; }
        E(acc, cur, wr, wc, fr, fq);
        if (!has_next) break;
        if (!(nxt.aux & 256)) {
#pragma unroll
            for (int a = 0; a < 2; ++a)
#pragma unroll
                for (int b = 0; b < 2; ++b)
#pragma unroll
                    for (int m = 0; m < 4; ++m)
#pragma unroll
                        for (int n = 0; n < 2; ++n) acc[a][b][m][n] = (f32x4){0.f, 0.f, 0.f, 0.f};
        }
        cur = nxt; cA = nA; cB = nB; ++ui;
        if constexpr (GATHER) {
#pragma unroll
            for (int h = 0; h < 2; ++h)
#pragma unroll
                for (int i = 0; i < 2; ++i) cOff[h][i] = nOff[h][i];
        }
        if (wr == 1) PG8_BAR;
    }
    PG8_WAIT_V(0);
    PG8_BAR;
#undef PG8_SA
#undef PG8_SB
#undef PG8_STAGE
#undef PG8_LDA
#undef PG8_LDB
#undef PG8_MMA
#undef PG8_WAIT_V
#undef PG8_WAIT_L
#undef PG8_BAR
#undef PG8_SCHED
}

struct TileOrder {
    int nM, nN, nwg;
    DEV void init(int nM_, int nN_) { nM = nM_; nN = nN_; nwg = nM * nN; }
    DEV bool get(int L, int& pm, int& pn) const {
        if (L >= nwg) return false;
        constexpr int NXCD = 8, WGM = 8;
        int wgid = L; { const int q = nwg / NXCD, r = nwg % NXCD, xcd = wgid % NXCD, off = wgid / NXCD; wgid = (xcd < r ? xcd * (q + 1) : r * (q + 1) + (xcd - r) * q) + off; }
        const int nig = WGM * nN, gid = wgid / nig, fm = gid * WGM, gsz = (nM - fm) < WGM ? (nM - fm) : WGM;
        pm = fm + ((wgid % nig) % gsz); pn = (wgid % nig) / gsz; return true;
    }
};
}

DEV unsigned ldsaddr_dummy() { return 0; }


DEV uint4 dpp_swap1(uint4 v) {
    uint4 r;
    r.x = (unsigned)__builtin_amdgcn_update_dpp(0, (int)v.x, 0xB1, 0xF, 0xF, true); r.y = (unsigned)__builtin_amdgcn_update_dpp(0, (int)v.y, 0xB1, 0xF, 0xF, true);
    r.z = (unsigned)__builtin_amdgcn_update_dpp(0, (int)v.z, 0xB1, 0xF, 0xF, true); r.w = (unsigned)__builtin_amdgcn_update_dpp(0, (int)v.w, 0xB1, 0xF, 0xF, true);
    return r;
}
DEV uint4 sel4(bool c, uint4 a, uint4 b) { uint4 r; r.x = c ? a.x : b.x; r.y = c ? a.y : b.y; r.z = c ? a.z : b.z; r.w = c ? a.w : b.w; return r; }
DEV void store_wide32(char* base, unsigned off, unsigned pitch, int fr, uint4 p0, uint4 p1) {
    const bool odd = fr & 1;
    const uint4 got = dpp_swap1(sel4(odd, p0, p1));
    *(uint4*)(base + (odd ? off - pitch + 16u : off)) = sel4(odd, got, p0);
    *(uint4*)(base + (odd ? off + 16u : off + pitch)) = sel4(odd, p1, got);
}

DEV void phase_inproj(const Params& p, int layer, char* lds) {
    bf16_t* P = (bf16_t*)(p.ws + OFF_PROJ);
    float* GS = (float*)(p.ws + OFF_GS);
    const int j_ = bid_op() >> 3, odd = (j_ ^ (j_ >> 3)) & 1;
    if (odd) { __builtin_amdgcn_s_sleep(127); __builtin_amdgcn_s_sleep(127); __builtin_amdgcn_s_sleep(127); }
#pragma unroll 1
    for (int pass = 0; pass < 3; ++pass) {
    const bool isbf = odd ? (pass != 1) : (pass == 1);
    const int i0 = (odd && pass == 2) ? 1 : 0;
    const int icnt = odd ? ((pass == 0) ? 1 : 0x7fffffff) : ((pass < 2) ? 0x7fffffff : 0);
    if (isbf) {
        struct Gen { g8::TileOrder o; const char* H; const char* W; int G, c, i0, cnt;
            DEV bool next(int i_, g8::GUnit& u) const { int pm, pn; if (i_ >= cnt) return false; const int i = i_ + i0; if (!o.get(i * G + c, pm, pn)) return false; u.pm = pm; u.pn = pn; u.aux = 0; u.rows = nullptr;
                u.A = H + (size_t)pm * 256 * 2048; u.B = W + (size_t)pn * 256 * 2048; return true; } } gen;
        gen.o.init(T / 256, 0); gen.H = (const char*)(p.ws + OFF_H); gen.W = (const char*)(p.ws + OFF_WIN); gen.G = gridDim.x; gen.c = bid_op(); gen.i0 = i0; gen.cnt = icnt;
        auto epi = [&](const f32x4 (&acc)[2][2][4][2], const g8::GUnit& u, int wr, int wc, int fr, int fq) {
            const int vc0 = u.pn * 256 + 64 * wc + 16 * fq;
            if (vc0 < VB_VALS) {
                const unsigned pc0 = (unsigned)vb_to_proj(vc0);
#pragma unroll
                for (int ai = 0; ai < 2; ++ai)
#pragma unroll
                    for (int m = 0; m < 4; ++m) {
                        const int row = u.pm * 256 + ai * 128 + wr * 64 + m * 16 + fr;
                        const f32x4 a0 = acc[ai][0][m][0], a1 = acc[ai][0][m][1], b0 = acc[ai][1][m][0], b1 = acc[ai][1][m][1];
                        uint4 p0, p1;
                        p0.x = pack2(a0[0], a0[1]); p0.y = pack2(a0[2], a0[3]); p0.z = pack2(a1[0], a1[1]); p0.w = pack2(a1[2], a1[3]);
                        p1.x = pack2(b0[0], b0[1]); p1.y = pack2(b0[2], b0[3]); p1.z = pack2(b1[0], b1[1]); p1.w = pack2(b1[2], b1[3]);
                        store_wide32((char*)P, ((unsigned)row * DIN + pc0) * 2u, (unsigned)DIN * 2u, fr, p0, p1);
                    }
            } else if (vc0 == VB_VALS) {
#pragma unroll
                for (int ai = 0; ai < 2; ++ai)
#pragma unroll
                    for (int m = 0; m < 4; ++m) {
                        const int row = u.pm * 256 + ai * 128 + wr * 64 + m * 16 + fr;
                        const f32x4 a0 = acc[ai][0][m][0], a1 = acc[ai][0][m][1], b0 = acc[ai][1][m][0], b1 = acc[ai][1][m][1];
                        uint4 p0, p1;
                        p0.x = pack2(a0[0], a0[1]); p0.y = pack2(a0[2], a0[3]); p0.z = pack2(a1[0], a1[1]); p0.w = pack2(a1[2], a1[3]);
                        p1.x = pack2(b0[0], b0[1]); p1.y = pack2(b0[2], b0[3]); p1.z = pack2(b1[0], b1[1]); p1.w = pack2(b1[2], b1[3]);
                        *(uint4*)(P + (size_t)row * DIN + C_FF) = p0; *(uint4*)(P + (size_t)row * DIN + C_MI) = p1;
                        *(f32x4*)(GS + (size_t)row * 16) = a0; *(f32x4*)(GS + (size_t)row * 16 + 4) = a1;
                        *(f32x4*)(GS + (size_t)row * 16 + 8) = b0; *(f32x4*)(GS + (size_t)row * 16 + 12) = b1;
                    }
            }
        };
        g8::gemm8<true, false, false>((LAS unsigned char*)lds, 2048, 2048, 1024, gen, epi);
    } else {
        struct Gen { g8::TileOrder o, o2; const char* H; const char* W; int G, c, i0, cnt;
            DEV bool next(int i_, g8::GUnit& u) const { int pm, pn; if (i_ >= cnt) return false; const int i = i_ + i0;
                int L = i * G + c;
                if (L < o.nwg) { if (!o.get(L, pm, pn)) return false; pn += 20; }
                else { if (!o2.get(L - o.nwg, pm, pn)) return false; }
                u.pm = pm; u.pn = pn; u.aux = 0; u.rows = nullptr;
                u.A = H + (size_t)pm * 256 * 1024; u.B = W + (size_t)pn * 256 * 1024; return true; } } gen;
        gen.o.init(T / 256, 13); gen.o2.init(T / 256, 20); gen.H = (const char*)(p.ws + OFF_H8); gen.W = (const char*)(p.ws + OFF_WG8); gen.G = gridDim.x; gen.c = bid_op(); gen.i0 = i0; gen.cnt = icnt;
        auto epi = [&](const f32x4 (&acc)[2][2][4][2], const g8::GUnit& u, int wr, int wc, int fr, int fq) {
            const int vc0 = u.pn * 256 + 64 * wc + 16 * fq;
            if (u.pn == 32) {
                if (vc0 == 8192) {
#pragma unroll
                    for (int ai = 0; ai < 2; ++ai)
#pragma unroll
                        for (int m = 0; m < 4; ++m) {
                            const int row = u.pm * 256 + ai * 128 + wr * 64 + m * 16 + fr;
                            const f32x4 a0 = acc[ai][0][m][0], a1 = acc[ai][0][m][1], b0 = acc[ai][1][m][0], b1 = acc[ai][1][m][1];
                            uint4 p0, p1;
                            p0.x = pack2(a0[0], a0[1]); p0.y = pack2(a0[2], a0[3]); p0.z = pack2(a1[0], a1[1]); p0.w = pack2(a1[2], a1[3]);
                            p1.x = pack2(b0[0], b0[1]); p1.y = pack2(b0[2], b0[3]); p1.z = pack2(b1[0], b1[1]); p1.w = pack2(b1[2], b1[3]);
                            *(uint4*)(P + (size_t)row * DIN + C_FF) = p0; *(uint4*)(P + (size_t)row * DIN + C_MI) = p1;
                            *(f32x4*)(GS + (size_t)row * 16) = a0; *(f32x4*)(GS + (size_t)row * 16 + 4) = a1;
                            *(f32x4*)(GS + (size_t)row * 16 + 8) = b0; *(f32x4*)(GS + (size_t)row * 16 + 12) = b1;
                        }
                }
                return;
            }
            const unsigned pc0 = (unsigned)vf_to_proj(vc0);
            const bool knorm = (u.pn == 12 || u.pn == 13);
            f32x4 kg[4];
            if (knorm) { const float* gp = p.in[I_FOXKG] + layer * 64 + 16 * fq;
#pragma unroll
                for (int q = 0; q < 4; ++q) kg[q] = *(const f32x4*)(gp + 4 * q); }
            const bool gate = u.pn >= 20 && u.pn < 32;
#pragma unroll
            for (int ai = 0; ai < 2; ++ai)
#pragma unroll
                for (int m = 0; m < 4; ++m) {
                    const int row = u.pm * 256 + ai * 128 + wr * 64 + m * 16 + fr;
                    f32x4 a0 = acc[ai][0][m][0], a1 = acc[ai][0][m][1], b0 = acc[ai][1][m][0], b1 = acc[ai][1][m][1];
                    if (gate) {
                        unsigned w4[4];
#pragma unroll
                        for (int q = 0; q < 4; ++q) {
                            const f32x4 v = (q == 0) ? a0 : (q == 1) ? a1 : (q == 2) ? b0 : b1;
                            unsigned w = 0u;
#pragma unroll
                            for (int j = 0; j < 4; ++j) w = __builtin_amdgcn_cvt_pk_u8_f32(fmaxf(fsigmoid(v[j]) * 255.f, 1.f), j, w);
                            w4[q] = w;
                        }
                        *(uint4*)((unsigned char*)P + (size_t)row * (DIN * 2) + C_GATES * 2 + (vc0 - VF_VALS)) = make_uint4(w4[0], w4[1], w4[2], w4[3]);
                        continue;
                    }
                    if (knorm) {
                        float ss = 0.f;
#pragma unroll
                        for (int j = 0; j < 4; ++j) ss += a0[j] * a0[j] + a1[j] * a1[j] + b0[j] * b0[j] + b1[j] * b1[j];
                        ss = red32_sum(red16_sum(ss));
                        const float rs = rsqrtf(ss * (1.f / 64.f) + 1e-6f);
#pragma unroll
                        for (int j = 0; j < 4; ++j) { a0[j] *= rs * kg[0][j]; a1[j] *= rs * kg[1][j]; b0[j] *= rs * kg[2][j]; b1[j] *= rs * kg[3][j]; }
                    }
                    uint4 p0, p1;
                    p0.x = pack2(a0[0], a0[1]); p0.y = pack2(a0[2], a0[3]); p0.z = pack2(a1[0], a1[1]); p0.w = pack2(a1[2], a1[3]);
                    p1.x = pack2(b0[0], b0[1]); p1.y = pack2(b0[2], b0[3]); p1.z = pack2(b1[0], b1[1]); p1.w = pack2(b1[2], b1[3]);
                    store_wide32((char*)P, ((unsigned)row * DIN + pc0) * 2u, (unsigned)DIN * 2u, fr, p0, p1);
                }
        };
        g8::gemm8<true, false, true, -9>((LAS unsigned char*)lds, 1024, 1024, 512, gen, epi);
    }
    }
    if (gridDim.x == 256) phase_convert_mix(p, layer, lds, 1032, MIX_CBLOCKS, 128, 128); else phase_convert_mix(p, layer, lds, 1032, MIX_CBLOCKS);
}

DEV void phase_merge(const Params& p, char* lds) {
    bf16_t* P = (bf16_t*)(p.ws + OFF_PROJ);
    const char* W = (const char*)(p.ws + OFF_WBR);
    struct Gen { g8::TileOrder o; const char* P; const char* W; int G, c;
        DEV bool next(int i, g8::GUnit& u) const { int pm, pn; const int ti = i / 3, b = i - ti * 3; if (!o.get(ti * G + c, pm, pn)) return false; u.pm = pm; u.pn = pn; u.aux = b | (b > 0 ? 256 : 0); u.rows = nullptr;
            u.A = P + (size_t)pm * 256 * (DIN * 2) + YB_OFF + b * 512; u.B = W + ((size_t)b * 1024 + pn * 256) * 512; return true; } } gen;
    gen.o.init(T / 256, 4); gen.P = (const char*)P; gen.W = W; gen.G = gridDim.x; gen.c = bid_op();
    auto epi = [&](f32x4 (&acc)[2][2][4][2], const g8::GUnit& u, int wr, int wc, int fr, int fq) {
        const int b = u.aux & 3;
#pragma unroll
        for (int ai = 0; ai < 2; ++ai) {
            uint4 gq[4], hq[4];
            const unsigned char* rp = (const unsigned char*)P + (size_t)(u.pm * 256 + ai * 128 + wr * 64 + fr) * (DIN * 2) + C_GATES * 2 + b * 1024 + u.pn * 256 + 64 * wc + 16 * fq;
#pragma unroll
            for (int m = 0; m < 4; ++m) {
                gq[m] = *(const uint4*)(rp + (size_t)(m * 16) * (DIN * 2));
                if (b < 2) hq[m] = *(const uint4*)(rp + (size_t)(m * 16) * (DIN * 2) + 1024);
            }
#pragma unroll
            for (int m = 0; m < 4; ++m) {
#pragma unroll
                for (int bj = 0; bj < 2; ++bj) {
                    const unsigned g0 = bj ? gq[m].z : gq[m].x, g1 = bj ? gq[m].w : gq[m].y;
                    float g[8] = {(float)(g0 & 0xffu), (float)((g0 >> 8) & 0xffu), (float)((g0 >> 16) & 0xffu), (float)(g0 >> 24),
                                  (float)(g1 & 0xffu), (float)((g1 >> 8) & 0xffu), (float)((g1 >> 16) & 0xffu), (float)(g1 >> 24)};
                    if (b < 2) {
                        const unsigned h0 = bj ? hq[m].z : hq[m].x, h1 = bj ? hq[m].w : hq[m].y;
                        const float gn[8] = {(float)(h0 & 0xffu), (float)((h0 >> 8) & 0xffu), (float)((h0 >> 16) & 0xffu), (float)(h0 >> 24),
                                             (float)(h1 & 0xffu), (float)((h1 >> 8) & 0xffu), (float)((h1 >> 16) & 0xffu), (float)(h1 >> 24)};
#pragma unroll
                        for (int j = 0; j < 8; ++j) g[j] *= __builtin_amdgcn_rcpf(gn[j]);
                    } else {
#pragma unroll
                        for (int j = 0; j < 8; ++j) g[j] *= (1.f / 255.f);
                    }
#pragma unroll
                    for (int j = 0; j < 4; ++j) { acc[ai][bj][m][0][j] *= g[j]; acc[ai][bj][m][1][j] *= g[4 + j]; }
                }
                if (b == 2) {
                    const f32x4 a0 = acc[ai][0][m][0], a1 = acc[ai][0][m][1], b0 = acc[ai][1][m][0], b1 = acc[ai][1][m][1];
                    const float ms = 16.f;
                    *(uint4*)((char*)(p.ws + OFF_H) + (size_t)(u.pm * 256 + ai * 128 + wr * 64 + m * 16 + fr) * 1024 + u.pn * 256 + 64 * wc + 16 * fq) =
                        make_uint4(pack4_fp8(a0[0] * ms, a0[1] * ms, a0[2] * ms, a0[3] * ms), pack4_fp8(a1[0] * ms, a1[1] * ms, a1[2] * ms, a1[3] * ms),
                                   pack4_fp8(b0[0] * ms, b0[1] * ms, b0[2] * ms, b0[3] * ms), pack4_fp8(b1[0] * ms, b1[1] * ms, b1[2] * ms, b1[3] * ms));
                }
            }
        }
    };
    g8::gemm8<true, false, true, -9>((LAS unsigned char*)lds, DIN * 2, 512, 256, gen, epi);
}

DEV void phase_out(const Params& p, int layer, char* lds) {
    const char* M = (const char*)(p.ws + OFF_H);
    const char* W = (const char*)(p.ws + OFF_WOUT);
    const float* mod = (const float*)(p.ws + OFF_MOD) + (size_t)layer * 16 * 6144;
    struct Gen { g8::TileOrder o; const char* M; const char* W; int G, c;
        DEV bool next(int i, g8::GUnit& u) const { int pm, pn; if (!o.get(i * G + c, pm, pn)) return false; u.pm = pm; u.pn = pn; u.aux = i; u.rows = nullptr;
            u.A = M + (size_t)pm * 256 * 1024; u.B = W + (size_t)pn * 256 * 1024; return true; } } gen;
    gen.o.init(T / 256, 4); gen.M = M; gen.W = W; gen.G = gridDim.x; gen.c = bid_op();
    const float* xf = p.in[I_X];
    const bf16_t* xh = (const bf16_t*)p.out;
    const int skew = gen.c & 1;
    auto epi = [&](const f32x4 (&acc)[2][2][4][2], const g8::GUnit& u, int wr, int wc, int fr, int fq) {
        const int bb = (u.pm * 256) >> 11;
        const int c0 = u.pn * 256 + 64 * wc + 16 * fq;
        f32x4 g1[4];
#pragma unroll
        for (int q = 0; q < 4; ++q) g1[q] = *(const f32x4*)(mod + (size_t)bb * 6144 + 2 * 1024 + c0 + 4 * q);
#pragma unroll
        for (int ai = 0; ai < 2; ++ai) {
            const unsigned r0 = (unsigned)(u.pm * 256 + ai * 128 + wr * 64 + fr);
            if (layer == 0) {
#pragma unroll
                for (int mh = 0; mh < 2; ++mh) {
                    f32x4 xr[2][4];
#pragma unroll
                    for (int m = 0; m < 2; ++m)
#pragma unroll
                        for (int q = 0; q < 4; ++q) xr[m][q] = *(const f32x4*)(xf + (size_t)(r0 + (mh * 2 + m) * 16) * 1024 + c0 + 4 * q);
#pragma unroll
                    for (int m2 = 0; m2 < 2; ++m2) {
                        const int m = mh * 2 + m2;
                        float o[16];
#pragma unroll
                        for (int bj = 0; bj < 2; ++bj)
#pragma unroll
                            for (int n = 0; n < 2; ++n)
#pragma unroll
                                for (int j = 0; j < 4; ++j) o[8 * bj + 4 * n + j] = xr[m2][2 * bj + n][j] + g1[2 * bj + n][j] * acc[ai][bj][m][n][j];
                        uint4 p0, p1;
                        p0.x = pack2(o[0], o[1]); p0.y = pack2(o[2], o[3]); p0.z = pack2(o[4], o[5]); p0.w = pack2(o[6], o[7]);
                        p1.x = pack2(o[8], o[9]); p1.y = pack2(o[10], o[11]); p1.z = pack2(o[12], o[13]); p1.w = pack2(o[14], o[15]);
                        store_wide32((char*)(p.ws + OFF_XB), ((r0 + m * 16) * 1024u + (unsigned)c0) * 2u, 2048u, fr, p0, p1);
                    }
                }
            } else {
                uint4 xr[4][2];
#pragma unroll
                for (int m = 0; m < 4; ++m)
#pragma unroll
                    for (int q = 0; q < 2; ++q) xr[m][q] = *(const uint4*)(xh + (size_t)(r0 + m * 16) * 1024 + c0 + 8 * q);
#pragma unroll
                for (int m = 0; m < 4; ++m) {
                    float o[16];
#pragma unroll
                    for (int bj = 0; bj < 2; ++bj) {
                        float xv[8]; unpack8(xr[m][bj], xv);
#pragma unroll
                        for (int n = 0; n < 2; ++n)
#pragma unroll
                            for (int j = 0; j < 4; ++j) o[8 * bj + 4 * n + j] = xv[4 * n + j] + g1[2 * bj + n][j] * acc[ai][bj][m][n][j];
                    }
                    uint4 p0, p1;
                    p0.x = pack2(o[0], o[1]); p0.y = pack2(o[2], o[3]); p0.z = pack2(o[4], o[5]); p0.w = pack2(o[6], o[7]);
                    p1.x = pack2(o[8], o[9]); p1.y = pack2(o[10], o[11]); p1.z = pack2(o[12], o[13]); p1.w = pack2(o[14], o[15]);
                    store_wide32((char*)(p.ws + OFF_XB), ((r0 + m * 16) * 1024u + (unsigned)c0) * 2u, 2048u, fr, p0, p1);
                }
            }
        }
    };
    if (skew) conv_moe_all(p, layer);
    g8::gemm8<true, false, true, -10>((LAS unsigned char*)lds, 1024, 1024, 512, gen, epi);
    if (!skew) conv_moe_all(p, layer);
}

DEV void phase_front(const Params& p, int layer, char* lds) {
    constexpr int LDH = 1032;
    bf16_t* HT = (bf16_t*)lds;
    float* LG = (float*)(HT + 32 * LDH);
    int* cntl = (int*)(LG + 32 * 64);
    int* basel = cntl + 128;
    int* sel = basel + 128;
    const int tid = tid_op(), lane = tid & 63, wid = tid >> 6, qi = lane & 15, g = lane >> 4;
    const float* gam = p.in[I_N2G] + layer * 1024;
    const float* mod = (const float*)(p.ws + OFF_MOD) + (size_t)layer * 16 * 6144;
    const bf16_t* WrT = (const bf16_t*)(p.ws + OFF_WRT);
    bf16_t* Hb = (bf16_t*)(p.ws + OFF_H);
    const float bias = p.in[I_RB][layer * 64 + lane];
    float* wts = (float*)(p.ws + OFF_WTS);
    int* cnt = (int*)(p.ws + OFF_CNT) + layer * 128 * CNT_STRIDE;
    lds_barrier();
    if (tid < 128) cntl[tid] = 0;
    const int ntok = T / (int)gridDim.x, tbase = bid_op() * ntok;
    const int grp = lane >> 3;
    bf16x8 bw[16];
    const bf16_t* wp = WrT + (size_t)((wid & 3) * 16 + qi) * 1024 + 8 * g;
#pragma unroll
    for (int kk = 0; kk < 16; ++kk) bw[kk] = *(const bf16x8*)(wp + 32 * kk);
    uint2 xq[4][4];
#pragma unroll
    for (int rr = 0; rr < 4; ++rr)
#pragma unroll
        for (int i = 0; i < 4; ++i) xq[rr][i] = *(const uint2*)((const bf16_t*)(p.ws + OFF_XB) + (size_t)(tbase + wid * 4 + rr) * 1024 + i * 256 + lane * 4);
#pragma unroll 1
    for (int sub = 0; sub < ntok / 32; ++sub) {
        const int t0 = tbase + sub * 32;
        {
            f32x4 v[4][4];
#pragma unroll
            for (int rr = 0; rr < 4; ++rr)
#pragma unroll
                for (int i = 0; i < 4; ++i) { const uint2 q = xq[rr][i];
                    v[rr][i] = (f32x4){__uint_as_float(q.x << 16), __uint_as_float(q.x & 0xffff0000u), __uint_as_float(q.y << 16), __uint_as_float(q.y & 0xffff0000u)}; }
            if (sub + 1 < ntok / 32) {
#pragma unroll
                for (int rr = 0; rr < 4; ++rr)
#pragma unroll
                    for (int i = 0; i < 4; ++i) xq[rr][i] = *(const uint2*)((const bf16_t*)(p.ws + OFF_XB) + (size_t)(t0 + 32 + wid * 4 + rr) * 1024 + i * 256 + lane * 4);
            }
            const int b = t0 >> 11;
            const float* sh = mod + (size_t)b * 6144 + 3 * 1024;
            const float* sc = sh + 1024;
#pragma unroll
            for (int rr = 0; rr < 4; ++rr) {
                float ss = 0.f;
#pragma unroll
                for (int i = 0; i < 4; ++i) ss += v[rr][i][0] * v[rr][i][0] + v[rr][i][1] * v[rr][i][1] + v[rr][i][2] * v[rr][i][2] + v[rr][i][3] * v[rr][i][3];
                ss = wave_sum(ss);
                const float rstd = rsqrtf(ss * (1.f / 1024.f) + 1e-6f);
                const int row = t0 + wid * 4 + rr;
#pragma unroll
                for (int i = 0; i < 4; ++i) {
                    const int c = i * 256 + lane * 4;
                    const f32x4 g4 = *(const f32x4*)(gam + c), sc4 = *(const f32x4*)(sc + c), sh4 = *(const f32x4*)(sh + c);
                    const float y0 = v[rr][i][0] * rstd * g4[0] * (1.f + sc4[0]) + sh4[0], y1 = v[rr][i][1] * rstd * g4[1] * (1.f + sc4[1]) + sh4[1];
                    const float y2 = v[rr][i][2] * rstd * g4[2] * (1.f + sc4[2]) + sh4[2], y3 = v[rr][i][3] * rstd * g4[3] * (1.f + sc4[3]) + sh4[3];
                    uint2 o; o.x = pack2(y0, y1); o.y = pack2(y2, y3);
                    *(unsigned*)(p.ws + OFF_H2F8 + (size_t)row * 1024 + c) = pack4_fp8(y0 * F8_ACT_SCALE, y1 * F8_ACT_SCALE, y2 * F8_ACT_SCALE, y3 * F8_ACT_SCALE);
                    *(uint2*)&HT[(wid * 4 + rr) * LDH + c] = o;
                }
            }
        }
        lds_barrier();
        {
            const int mt = wid >> 2, nt = wid & 3;
            f32x4 acc = (f32x4){0.f, 0.f, 0.f, 0.f}, acc2 = acc;
            const bf16_t* hp = HT + (mt * 16 + qi) * LDH + 8 * g;
            bf16x8 bw2[16];
#pragma unroll
            for (int kk = 0; kk < 16; ++kk) bw2[kk] = *(const bf16x8*)(wp + 32 * (16 + kk));
#pragma unroll
            for (int kk = 0; kk < 16; kk += 2) {
                acc = __builtin_amdgcn_mfma_f32_16x16x32_bf16(*(const bf16x8*)(hp + 32 * kk), bw[kk], acc, 0, 0, 0);
                acc2 = __builtin_amdgcn_mfma_f32_16x16x32_bf16(*(const bf16x8*)(hp + 32 * (kk + 1)), bw[kk + 1], acc2, 0, 0, 0);
            }
#pragma unroll
            for (int kk = 0; kk < 16; kk += 2) {
                acc = __builtin_amdgcn_mfma_f32_16x16x32_bf16(*(const bf16x8*)(hp + 32 * (16 + kk)), bw2[kk], acc, 0, 0, 0);
                acc2 = __builtin_amdgcn_mfma_f32_16x16x32_bf16(*(const bf16x8*)(hp + 32 * (17 + kk)), bw2[kk + 1], acc2, 0, 0, 0);
            }
#pragma unroll
            for (int j = 0; j < 4; ++j) LG[(mt * 16 + 4 * g + j) * 64 + nt * 16 + qi] = acc[j] + acc2[j];
        }
        lds_barrier();
#pragma unroll 1
        for (int rr = 0; rr < 4; ++rr) {
            const int k = sub * 32 + wid * 4 + rr, t = tbase + k;
            const float s = fsigmoid(LG[(wid * 4 + rr) * 64 + lane]);
            const float c = s + bias;
            float m1 = c;
            m1 = max8(m1);
            const unsigned long long bal = __ballot(c == m1);
            const unsigned gb = (unsigned)((bal >> (grp * 8)) & 0xffull);
            const int first = __ffs(gb) - 1;
            float c2 = ((lane & 7) == first) ? -INFINITY : c;
            c2 = max8(c2);
            const float gs = m1 + c2;
            int cg = 0;
#pragma unroll
            for (int gg = 0; gg < 8; ++gg) { const float v = __builtin_bit_cast(float, __builtin_amdgcn_readlane(__builtin_bit_cast(int, gs), gg * 8)); cg += (v > gs || (v == gs && gg < grp)) ? 1 : 0; }
            const float masked = (cg < 4) ? c : -INFINITY;
            int r = 0;
#pragma unroll
            for (int j = 0; j < 64; ++j) { const float v = __builtin_bit_cast(float, __builtin_amdgcn_readlane(__builtin_bit_cast(int, masked), j)); r += (v > masked || (v == masked && j < lane)) ? 1 : 0; }
            const bool selb = (r < 8) && (cg < 4);
            const float wsum = wave_sum(selb ? s : 0.f);
            if (selb) {
                const int half = t / HALF_T;
                wts[(size_t)t * 8 + r] = s / wsum * 2.5f;
                const int lr = atomicAdd(&cntl[half * 64 + lane], 1);
                sel[k * 8 + r] = (lane << 16) | lr;
            }
        }
    }
    lds_barrier();
    if (tid < 128) basel[tid] = atomicAdd(&cnt[tid * CNT_STRIDE], cntl[tid]);
    lds_barrier();
    int* erow = (int*)(p.ws + OFF_EROW); int* prel = (int*)(p.ws + OFF_POS);
    for (int i = tid; i < ntok * 8; i += 512) {
        const int t = tbase + (i >> 3), v = sel[i], e = v >> 16, r = basel[e] + (v & 0xffff);
        erow[(size_t)e * T + r] = t; prel[t * NSLOT + (i & 7)] = (e << 16) | r;
    }
    for (int i = tid; i < ntok; i += 512) { const int t = tbase + i; erow[(size_t)NEXP * T + t] = t; prel[t * NSLOT + 8] = (NEXP << 16) | t; }
}

DEV void moe_tables(const Params& p, int layer, char* lds) {
    LAS int* TL = (LAS int*)(lds + 131072);
    LAS int* TS = TL + TL_PAD + 512;
    const int* cnt = (const int*)(p.ws + OFF_CNT) + layer * 128 * CNT_STRIDE;
    const int tid = tid_op(), lane = tid & 63;
    __syncthreads();
    if (tid < 64) {
        const int nt = (cnt[tid * CNT_STRIDE] + 255) >> 8;
        int inc = nt;
#pragma unroll
        for (int o = 1; o < 64; o <<= 1) { const int n = __builtin_bit_cast(int, sup(__builtin_bit_cast(float, inc), o)); if (lane >= o) inc += n; }
        TS[tid] = inc - nt;
        if (tid == 63) { TS[64] = inc; TS[65] = inc + T / 256; }
    }
    __syncthreads();
    const int ntiles = TS[65];
    for (int tile = tid; tile < ntiles; tile += 512) {
        int l = 0;
#pragma unroll
        for (int st = 64; st > 0; st >>= 1) { const int q = l + st; if (q <= 64 && TS[q] <= tile) l = q; }
        TL[tile] = l;
    }
    __syncthreads();
}

DEV void phase_moe_up(const Params& p, int layer, int half, char* lds) {
    const char* H = (const char*)(p.ws + OFF_H2F8);
    const char* W13 = (const char*)(p.ws + OFF_W13);
    bf16_t* HID = (bf16_t*)(p.ws + OFF_HID);
    moe_tables(p, layer, lds);
    LAS int* TL = (LAS int*)(lds + 131072);
    struct Gen { const char* H; const char* W; const int* erow; LAS const int* tl; LAS const int* ts; LAS int* rb; int nun, G, c;
        DEV bool next(int i, g8::GUnit& u) const { const int L = i * G + c; if (L >= nun) return false; const int tile = L >> 1, pn = L & 1, l = __builtin_amdgcn_readfirstlane(tl[tile]), t0 = __builtin_amdgcn_readfirstlane(ts[l]);
            u.pm = tile; u.pn = pn; u.aux = l; u.rows = erow + (size_t)l * T + (tile - t0) * 256; u.A = H; u.B = W + ((size_t)l * 512 + pn * 256) * 1024; return true; } } gen;
    gen.H = H; gen.W = W13; gen.erow = (const int*)(p.ws + OFF_EROW); gen.tl = TL; gen.ts = TL + TL_PAD + 512; gen.rb = TL + TL_PAD; gen.nun = __builtin_amdgcn_readfirstlane(TL[TL_PAD + 512 + 65]) * 2; gen.G = gridDim.x; gen.c = bid_op();
    auto epi = [&](const f32x4 (&acc)[2][2][4][2], const g8::GUnit& u, int wr, int wc, int fr, int fq) {
#pragma unroll
        for (int ai = 0; ai < 2; ++ai)
#pragma unroll
            for (int m = 0; m < 4; ++m) {
                const int row = u.pm * 256 + ai * 128 + wr * 64 + m * 16 + fr;
                uint2 o;
#pragma unroll
                for (int bj = 0; bj < 2; ++bj) {
                    const f32x4 v1 = acc[ai][bj][m][0], v3 = acc[ai][bj][m][1];
                    const unsigned w = pack4_fp8(fsilu(v1[0]) * v3[0] * F8_ACT_SCALE, fsilu(v1[1]) * v3[1] * F8_ACT_SCALE, fsilu(v1[2]) * v3[2] * F8_ACT_SCALE, fsilu(v1[3]) * v3[3] * F8_ACT_SCALE);
                    if (bj == 0) o.x = w; else o.y = w;
                }
                *(uint2*)((unsigned char*)HID + (size_t)row * 256 + u.pn * 128 + 32 * wc + 8 * fq) = o;
            }
    };
    g8::gemm8<true, true, true, -9>((LAS unsigned char*)lds, 1024, 1024, 512, gen, epi);
}
DEV void phase_moe_down(const Params& p, int half, char* lds) {
    const char* HID = (const char*)(p.ws + OFF_HID);
    const char* W2 = (const char*)(p.ws + OFF_W2);
    unsigned char* OA = (unsigned char*)(p.ws + OFF_OUTA);
    LAS int* TL = (LAS int*)(lds + 131072);
    struct Gen { const char* HID; const char* W; const char* WS; LAS const int* tl; int nun, G, c;
        DEV bool next(int i, g8::GUnit& u) const { const int L = i * G + c; if (L >= nun) return false; const int tile = L >> 2, pn = L & 3, l = __builtin_amdgcn_readfirstlane(tl[tile]);
            u.pm = tile; u.pn = pn; u.aux = l; u.rows = nullptr; u.A = HID + (size_t)tile * 256 * 256; u.B = (l < NEXP ? W + (size_t)l * 1024 * 256 : WS) + (size_t)pn * 256 * 256; return true; } } gen;
    if ((bid_op() >> 3) & 1) __builtin_amdgcn_s_sleep(127);
    gen.HID = HID; gen.W = W2; gen.WS = (const char*)(p.ws + OFF_W2S); gen.tl = TL; gen.nun = __builtin_amdgcn_readfirstlane(TL[TL_PAD + 512 + 65]) * 4; gen.G = gridDim.x; gen.c = bid_op();
    auto epi = [&](const f32x4 (&acc)[2][2][4][2], const g8::GUnit& u, int wr, int wc, int fr, int fq) {
#pragma unroll
        for (int ai = 0; ai < 2; ++ai)
#pragma unroll
            for (int m = 0; m < 4; ++m) {
                const int row = u.pm * 256 + ai * 128 + wr * 64 + m * 16 + fr;
                unsigned w4[4];
#pragma unroll
                for (int bj = 0; bj < 2; ++bj) {
                    const f32x4 v0 = acc[ai][bj][m][0], v1 = acc[ai][bj][m][1];
                    w4[2 * bj] = pack4_fp8(v0[0], v0[1], v0[2], v0[3]); w4[2 * bj + 1] = pack4_fp8(v1[0], v1[1], v1[2], v1[3]);
                }
                *(uint4*)(OA + (size_t)row * 1024 + u.pn * 256 + 64 * wc + 16 * fq) = make_uint4(w4[0], w4[1], w4[2], w4[3]);
            }
    };
    g8::gemm8<true, false, true, -5>((LAS unsigned char*)lds, 256, 256, 128, gen, epi);
}
DEV void phase_combine(const Params& p, int layer, int half, char* lds) {
    const LAS int* TS = (const LAS int*)(lds + 131072) + TL_PAD + 512;
    const unsigned char* OA = (const unsigned char*)(p.ws + OFF_OUTA);
    const float* mod = (const float*)(p.ws + OFF_MOD) + (size_t)layer * 16 * 6144;
    const float* modn = (const float*)(p.ws + OFF_MOD) + (size_t)(layer + 1) * 16 * 6144;
    const float* gnx = p.in[I_N1G] + (layer + 1) * 1024;
    bf16_t* Hb = (bf16_t*)(p.ws + OFF_H);
    const int tid = tid_op(), lane = tid & 63, wid = tid >> 6;
    typedef float f32x2v __attribute__((ext_vector_type(2)));
    for (int tl0 = bid_op() * 8 + wid; tl0 < HALF_T; tl0 += gridDim.x * 8) {
        const int tok = __builtin_amdgcn_readfirstlane(half * HALF_T + tl0), b = tok >> 11;
        const float* wt = (const float*)(p.ws + OFF_WTS) + (size_t)tok * 8;
        const int* ps = (const int*)(p.ws + OFF_POS) + (size_t)tok * NSLOT;
        uint4 rw[NSLOT];
#pragma unroll
        for (int k = 0; k < NSLOT; ++k) { const int v = ps[k]; rw[k] = *(const uint4*)(OA + (size_t)(TS[v >> 16] * 256 + (v & 0xffff)) * 1024 + lane * 16); }
        float* o = p.out + (size_t)tok * 1024 + lane * 16;
        float x[16];
        { const bf16_t* xb = (const bf16_t*)(p.ws + OFF_XB) + (size_t)tok * 1024 + lane * 16;
          const uint4 q0 = *(const uint4*)xb, q1 = *(const uint4*)(xb + 8); unpack8(q0, x); unpack8(q1, x + 8); }
        float a[16];
#pragma unroll
        for (int j = 0; j < 16; ++j) a[j] = 0.f;
#pragma unroll
        for (int k = 0; k < NSLOT; ++k) {
            const float w = ((k < 8) ? wt[k] : 1.f) * (1.f / 16.f);
            const unsigned uu[4] = {rw[k].x, rw[k].y, rw[k].z, rw[k].w};
#pragma unroll
            for (int q = 0; q < 4; ++q) {
                const f32x2v f0 = __builtin_amdgcn_cvt_pk_f32_fp8((int)uu[q], false), f1 = __builtin_amdgcn_cvt_pk_f32_fp8((int)uu[q], true);
                a[4 * q] += w * f0[0]; a[4 * q + 1] += w * f0[1]; a[4 * q + 2] += w * f1[0]; a[4 * q + 3] += w * f1[1];
            }
        }
        const float* g2 = mod + (size_t)b * 6144 + 5 * 1024 + lane * 16;
        float xn[16]; float ss = 0.f;
#pragma unroll
        for (int q = 0; q < 4; ++q) {
            const f32x4 gq = *(const f32x4*)(g2 + 4 * q);
#pragma unroll
            for (int j = 0; j < 4; ++j) { xn[4 * q + j] = x[4 * q + j] + gq[j] * a[4 * q + j]; ss += xn[4 * q + j] * xn[4 * q + j]; }
            if (layer != 0) *(f32x4*)(o + 4 * q) = (f32x4){xn[4 * q], xn[4 * q + 1], xn[4 * q + 2], xn[4 * q + 3]};
        }
        if (layer == 0) {
            {
                bf16_t* ob = (bf16_t*)p.out + (size_t)tok * 1024 + lane * 16; uint4 w;
                w.x = pack2(xn[0], xn[1]); w.y = pack2(xn[2], xn[3]); w.z = pack2(xn[4], xn[5]); w.w = pack2(xn[6], xn[7]); *(uint4*)ob = w;
                w.x = pack2(xn[8], xn[9]); w.y = pack2(xn[10], xn[11]); w.z = pack2(xn[12], xn[13]); w.w = pack2(xn[14], xn[15]); *(uint4*)(ob + 8) = w;
            }
            ss = wave_sum(ss);
            const float rstd = rsqrtf(ss * (1.f / 1024.f) + 1e-6f);
            const float* sh = modn + (size_t)b * 6144 + lane * 16;
            const float* sc = sh + 1024;
            float h[16];
#pragma unroll
            for (int j = 0; j < 16; ++j) h[j] = xn[j] * rstd * gnx[lane * 16 + j] * (1.f + sc[j]) + sh[j];
            const float s8 = F8_ACT_SCALE;
            *(uint4*)(p.ws + OFF_H8 + (size_t)tok * 1024 + lane * 16) = make_uint4(pack4_fp8(h[0] * s8, h[1] * s8, h[2] * s8, h[3] * s8), pack4_fp8(h[4] * s8, h[5] * s8, h[6] * s8, h[7] * s8),
                                                                                   pack4_fp8(h[8] * s8, h[9] * s8, h[10] * s8, h[11] * s8), pack4_fp8(h[12] * s8, h[13] * s8, h[14] * s8, h[15] * s8));
        }
    }
}

typedef short v4i16_t __attribute__((ext_vector_type(4)));
DEV v4i16_t lds_tr(const bf16_t* ptr) { return __builtin_amdgcn_ds_read_tr16_b64_v4i16((LAS v4i16_t*)ptr); }

DEV void prep_hgrn(const Params& p, int layer, int u, char* lds, int tid, uint4 rf0, uint4 rf1, uint4 rq0, uint4 rq1) {
    float* LF = (float*)lds;
    float* OFFS = LF + 64 * 128;
    bf16_t* P = (bf16_t*)(p.ws + OFF_PROJ);
    const int bh = u >> 5, c = u & 31, b = bh >> 2, h = bh & 3;
    const int row0 = tid >> 4, col0 = (tid & 15) * 8;
    bf16_t* gb = P + ((size_t)b * SEQ + c * 64 + row0) * DIN + h * 128 + col0;
    float kk[2][8], qq[2][8];
    float lbv[8];
#pragma unroll
    for (int j = 0; j < 8; ++j) { lbv[j] = 0.f; if (layer == 1) { const float p0 = p.in[I_HLB][h * 128 + col0 + j], p1 = p.in[I_HLB][512 + h * 128 + col0 + j]; lbv[j] = 1.f / (1.f + __expf(p0 - p1)); } }
    lds_barrier();
#pragma unroll
    for (int i = 0; i < 2; ++i) {
        const int row = row0 + 32 * i;
        float z[8], qv[8], lf[8];
        unpack8(i == 0 ? rf0 : rf1, z); unpack8(i == 0 ? rq0 : rq1, qv);
#pragma unroll
        for (int j = 0; j < 8; ++j) {
            const float lb = lbv[j];
            const float sg = fsigmoid(z[j]);
            lf[j] = __logf(lb + (1.f - lb) * sg);
            kk[i][j] = (1.f - lb) * (1.f - sg);
            qq[i][j] = fsilu(qv[j]);
        }
        *(f32x4*)&LF[row * 128 + col0] = (f32x4){lf[0], lf[1], lf[2], lf[3]};
        *(f32x4*)&LF[row * 128 + col0 + 4] = (f32x4){lf[4], lf[5], lf[6], lf[7]};
    }
    lds_barrier();
    {
        const int d = tid & 127, part = tid >> 7;
        float v[16];
#pragma unroll
        for (int t = 0; t < 16; ++t) v[t] = LF[(part * 16 + t) * 128 + d];
#pragma unroll
        for (int t = 1; t < 16; ++t) v[t] += v[t - 1];
#pragma unroll
        for (int t = 0; t < 16; ++t) LF[(part * 16 + t) * 128 + d] = v[t];
        OFFS[part * 128 + d] = v[15];
    }
    lds_barrier();
#pragma unroll
    for (int i = 0; i < 2; ++i) {
        const int row = row0 + 32 * i, part = row >> 4;
        float qm[8], km[8];
#pragma unroll
        for (int j = 0; j < 8; ++j) {
            const int d = col0 + j;
            const float o0 = OFFS[d], o1 = OFFS[128 + d], o2 = OFFS[256 + d];
            const float off = (part > 0 ? o0 : 0.f) + (part > 1 ? o1 : 0.f) + (part > 2 ? o2 : 0.f);
            const float At = LF[row * 128 + d] + off, Am = LF[31 * 128 + d] + o0;
            qm[j] = qq[i][j] * __expf(At - Am);
            km[j] = kk[i][j] * __expf(fminf(Am - At, 60.f));
        }
        uint4 w; w.x = pack2(qm[0], qm[1]); w.y = pack2(qm[2], qm[3]); w.z = pack2(qm[4], qm[5]); w.w = pack2(qm[6], qm[7]);
        *(uint4*)(gb + (size_t)(32 * i) * DIN + C_HQ) = w;
        w.x = pack2(km[0], km[1]); w.y = pack2(km[2], km[3]); w.z = pack2(km[4], km[5]); w.w = pack2(km[6], km[7]);
        *(uint4*)(gb + (size_t)(32 * i) * DIN + C_HF) = w;
    }
    if (tid < 128) {
        const float o0 = OFFS[tid], o1 = OFFS[128 + tid], o2 = OFFS[256 + tid];
        const float Am = LF[31 * 128 + tid] + o0, Ac = LF[63 * 128 + tid] + o0 + o1 + o2;
        float* ev = (float*)(p.ws + OFF_EVBUF) + (size_t)u * 384;
        ev[tid] = __expf(Am); ev[128 + tid] = __expf(Ac); ev[256 + tid] = __expf(Ac - Am);
    }
}

DEV void prep_mlstm(const Params& p, int layer, int u, char* lds, int tid, uint4 rr0, uint4 rr1, uint4 rr2, float gmi, float gmf) {
    bf16_t* RAW = (bf16_t*)lds;
    float* EQ = (float*)(RAW + 67 * 128 + 64);
    float* EW = EQ + 64;
    float* CW = EW + 64;
    const int lane = tid & 63, wid = tid >> 6;
    const int bh = u >> 5, c = u & 31, h = bh & 3, t0 = c * 64;
    const int pr = tid >> 4, pc8 = (tid & 15) * 8;
    lds_barrier();
    *(uint4*)&RAW[pr * 128 + pc8] = rr0;
    *(uint4*)&RAW[(pr + 32) * 128 + pc8] = rr1;
    if (tid < 48) *(uint4*)&RAW[(pr + 64) * 128 + pc8] = rr2;
    {
        const int j = tid >> 7, cc = tid & 127;
        const int ch = (cc < 64) ? (h * 64 + cc) : (256 + h * 64 + (cc - 64));
        CW[j * 128 + cc] = p.in[I_MCONV][(size_t)layer * 4 * 512 + j * 512 + ch];
    }
    if (wid == 0) {
        const float ip = gmi + p.in[I_MBI][layer * 4 + h];
        float bc = logsigmoid_f(gmf + p.in[I_MBF][layer * 4 + h]);
#pragma unroll
        for (int o = 1; o < 64; o <<= 1) { const float n = sup(bc, o); if (lane >= o) bc += n; }
        const float bcC = sfrom(bc, 63);
        const float eq = __expf(bc), ew = __expf(bcC - bc + ip);
        EQ[lane] = eq; EW[lane] = ew;
        *(f32x4*)((float*)(p.ws + OFF_GBUF) + ((size_t)bh * SEQ + t0 + lane) * 4) = (f32x4){bc, ip, eq, ew};
        if (lane == 0) ((float*)(p.ws + OFF_ECBUF))[u] = __expf(bcC);
    }
    lds_barrier();
    bf16_t* blk = (bf16_t*)(p.ws + OFF_H) + (size_t)u * (4 * 64 * 64);
#pragma unroll 1
    for (int hh = 0; hh < 2; ++hh) {
        const int row = tid >> 3, c8 = (tid & 7) * 16 + hh * 8;
        float a[8];
#pragma unroll
        for (int e = 0; e < 8; ++e) a[e] = 0.f;
#pragma unroll
        for (int j = 0; j < 4; ++j) {
            float x[8];
            unpack8(*(const uint4*)&RAW[(row + j) * 128 + c8], x);
            const f32x4 w0 = *(const f32x4*)&CW[j * 128 + c8], w1 = *(const f32x4*)&CW[j * 128 + c8 + 4];
            a[0] += w0[0] * x[0]; a[1] += w0[1] * x[1]; a[2] += w0[2] * x[2]; a[3] += w0[3] * x[3];
            a[4] += w1[0] * x[4]; a[5] += w1[1] * x[5]; a[6] += w1[2] * x[6]; a[7] += w1[3] * x[7];
        }
        const bool isq = c8 < 64;
        const float sc = isq ? 1.f : 0.125f;
        const float ex = isq ? EQ[row] : EW[row];
        float y[8], ys[8];
#pragma unroll
        for (int e = 0; e < 8; ++e) { y[e] = fsilu(a[e]) * sc; ys[e] = y[e] * ex; }
        bf16_t* d0 = blk + (isq ? 0 : 4096) + row * 64 + (c8 & 63);
        uint4 w;
        w.x = pack2(y[0], y[1]); w.y = pack2(y[2], y[3]); w.z = pack2(y[4], y[5]); w.w = pack2(y[6], y[7]); *(uint4*)d0 = w;
        w.x = pack2(ys[0], ys[1]); w.y = pack2(ys[2], ys[3]); w.z = pack2(ys[4], ys[5]); w.w = pack2(ys[6], ys[7]); *(uint4*)(d0 + 8192) = w;
    }
}

DEV void prep_foxk(const Params& p, int layer, int u, int tid, uint4 kr0, uint4 kr1, uint4 kr2, uint4 kr3) {
    bf16_t* P = (bf16_t*)(p.ws + OFF_PROJ);
    const int bh = u >> 3, rb = u & 7, b = bh >> 3, h = bh & 7;
    const int r = tid >> 3, c8 = (tid & 7) * 8;
    bf16_t* kp = P + ((size_t)b * SEQ + rb * 256 + r) * DIN + C_FK + h * 64 + c8;
    float gk[8];
#pragma unroll
    for (int d = 0; d < 8; ++d) gk[d] = p.in[I_FOXKG][layer * 64 + c8 + d];
#pragma unroll
    for (int i = 0; i < 4; ++i) {
        float kf[8]; unpack8(i == 0 ? kr0 : i == 1 ? kr1 : i == 2 ? kr2 : kr3, kf);
        float ss = 0.f;
#pragma unroll
        for (int d = 0; d < 8; ++d) ss += kf[d] * kf[d];
        ss = sum8(ss);
        const float rstd = rsqrtf(ss * (1.f / 64.f) + 1e-6f);
        uint4 w;
        w.x = pack2(kf[0] * rstd * gk[0], kf[1] * rstd * gk[1]); w.y = pack2(kf[2] * rstd * gk[2], kf[3] * rstd * gk[3]);
        w.z = pack2(kf[4] * rstd * gk[4], kf[5] * rstd * gk[5]); w.w = pack2(kf[6] * rstd * gk[6], kf[7] * rstd * gk[7]);
        *(uint4*)(kp + (size_t)(64 * i) * DIN) = w;
    }
}
DEV void prep_foxf(const Params& p, int layer, int bh, char* lds, int tid) {
    float* wsum = (float*)lds;
    const float* GS = (const float*)(p.ws + OFF_GS);
    const int lane = tid & 63, wid = tid >> 6, b = bh >> 3, h = bh & 7;
    const float bfv = p.in[I_FOXBF][layer * 8 + h];
    float v[4]; float loc = 0.f;
#pragma unroll
    for (int i = 0; i < 4; ++i) { const int s = tid * 4 + i; v[i] = logsigmoid_f(GS[((size_t)b * SEQ + s) * 16 + h] + bfv); loc += v[i]; v[i] = loc; }
    float inc = loc;
#pragma unroll
    for (int o = 1; o < 64; o <<= 1) { const float n = sup(inc, o); if (lane >= o) inc += n; }
    lds_barrier();
    if (lane == 63) wsum[wid] = inc;
    lds_barrier();
    float base = inc - loc;
    for (int w = 0; w < wid; ++w) base += wsum[w];
    constexpr float L2E = 1.4426950408889634f;
    *(f32x4*)((float*)(p.ws + OFF_FBUF) + (size_t)bh * SEQ + tid * 4) = (f32x4){-(base + v[0]) * L2E, -(base + v[1]) * L2E, -(base + v[2]) * L2E, -(base + v[3]) * L2E};
}
DEV void phase_prep(const Params& p, int layer, char* lds) {
    const int tid = tid_op(), G = gridDim.x, bid = bid_op();
    const bf16_t* P = (const bf16_t*)(p.ws + OFF_PROJ);
    const float* GS = (const float*)(p.ws + OFF_GS);
    {
        const int row0 = tid >> 4, col0 = (tid & 15) * 8;
        uint4 a0, a1, a2, a3, n0 = make_uint4(0u, 0u, 0u, 0u), n1 = n0, n2 = n0, n3 = n0;
#define HGP_LOAD(r0_, r1_, r2_, r3_, u_) do { const int bh_ = (u_) >> 5, c_ = (u_) & 31; const bf16_t* gb_ = P + ((size_t)(bh_ >> 2) * SEQ + c_ * 64 + row0) * DIN + (bh_ & 3) * 128 + col0; \
            r0_ = *(const uint4*)(gb_ + C_HF); r1_ = *(const uint4*)(gb_ + (size_t)32 * DIN + C_HF); r2_ = *(const uint4*)(gb_ + C_HQ); r3_ = *(const uint4*)(gb_ + (size_t)32 * DIN + C_HQ); } while (0)
        int u = bid;
        if (u < 2048) HGP_LOAD(a0, a1, a2, a3, u);
        for (; u < 2048; u += G) {
            if (u + G < 2048) HGP_LOAD(n0, n1, n2, n3, u + G);
            prep_hgrn(p, layer, u, lds, tid, a0, a1, a2, a3);
            a0 = n0; a1 = n1; a2 = n2; a3 = n3;
        }
#undef HGP_LOAD
    }
    {
        const int pr = tid >> 4, pc8 = (tid & 15) * 8;
        uint4 a0, a1, a2, n0 = make_uint4(0u, 0u, 0u, 0u), n1 = n0, n2 = n0; float g0 = 0.f, g1 = 0.f, m0 = 0.f, m1 = 0.f;
#define MLP_LOAD(r0_, r1_, r2_, gi_, gf_, u_) do { const int bh_ = (u_) >> 5, t0_ = ((u_) & 31) * 64, h_ = bh_ & 3; const bf16_t* rowb_ = P + (size_t)(bh_ >> 2) * SEQ * DIN; \
            const unsigned off_ = (unsigned)pr * DIN + (unsigned)((pc8 < 64) ? (C_MQK + h_ * 64 + pc8) : (C_MQK + 256 + h_ * 64 + (pc8 - 64))); \
            const bf16_t* ub_ = rowb_ + (ptrdiff_t)(t0_ - 3) * DIN; const bool ok_ = (t0_ - 3 + pr >= 0); \
            r0_ = *(const uint4*)(ok_ ? ub_ + off_ : rowb_); if (!ok_) r0_ = make_uint4(0u, 0u, 0u, 0u); \
            r1_ = *(const uint4*)(ub_ + off_ + 32u * DIN); r2_ = *(const uint4*)((tid < 48) ? ub_ + off_ + 64u * DIN : rowb_); \
            const float* gp_ = GS + ((size_t)(bh_ >> 2) * SEQ + t0_ + (tid & 63)) * 16 + 8; gi_ = gp_[h_]; gf_ = gp_[4 + h_]; } while (0)
        int u = bid;
        if (u < 2048) MLP_LOAD(a0, a1, a2, g0, g1, u);
        for (; u < 2048; u += G) {
            if (u + G < 2048) MLP_LOAD(n0, n1, n2, m0, m1, u + G);
            prep_mlstm(p, layer, u, lds, tid, a0, a1, a2, g0, g1);
            a0 = n0; a1 = n1; a2 = n2; g0 = m0; g1 = m1;
        }
#undef MLP_LOAD
    }
    for (int u = (bid + G - 128 % G) % G; u < 128; u += G) prep_foxf(p, layer, u, lds, tid);
}

template <bool DRY = false>
DEV void phase_fox(const Params& p, int layer, char* lds) {
    constexpr int LDK = 72;
    constexpr float LOG2E = 1.4426950408889634f;
    constexpr int BUFB = 2 * 128 * LDK * 2 + 512;
    int* qsh = (int*)(lds + 2 * BUFB);
    bf16_t* P = (bf16_t*)(p.ws + OFF_PROJ);
    const int tid = tid_op(), lane = tid & 63, wid = tid >> 6, qi = lane & 15, g = lane >> 4, tq = qi >> 2, tp = lane & 3;
    int* qctr = (int*)(p.ws + OFF_QCTR) + layer * 64 + (DRY ? 32 : 0);
    const int skey = tid >> 3, sc8 = (tid & 7) * 8;
    float gkmax = fabsf(p.in[I_FOXKG][layer * 64 + lane]);
    gkmax = red32_max(red16_max(max16(gkmax)));
    int* dflag = qsh + 8;
    for (;;) {
        __syncthreads();
        if (tid == 0) qsh[0] = atomicAdd(qctr, 1);
        __syncthreads();
        const int u = qsh[0];
        if (u >= NB * 8 * 8) break;
        const int qb = 7 - (u / (NB * 8)), bh = u % (NB * 8), b = bh >> 3, h = bh & 7;
        const int q0 = qb * 256, nst = 2 * qb + 2;
        const float* Fg = (const float*)(p.ws + OFF_FBUF) + (size_t)bh * SEQ;
        const int wrow = q0 + wid * 32;
        bf16x8 qf[2][2];
        float qn2 = 0.f;
#pragma unroll
        for (int t = 0; t < 2; ++t) {
            const int trow = wrow + 16 * t + qi;
            const bf16_t* qp = P + ((size_t)b * SEQ + trow) * DIN + C_FQ + h * 64 + 8 * g;
            float q[16];
            unpack8(*(const uint4*)qp, q); unpack8(*(const uint4*)(qp + 32), q + 8);
            float ss = 0.f;
#pragma unroll
            for (int d = 0; d < 16; ++d) ss += q[d] * q[d];
            ss = red32_sum(red16_sum(ss));
            const float rstd = rsqrtf(ss * (1.f / 64.f) + 1e-6f) * (0.125f * LOG2E);
            const float* gq = p.in[I_FOXQG] + layer * 64 + 8 * g;
            { float qs = 0.f;
#pragma unroll
              for (int s2 = 0; s2 < 2; ++s2)
#pragma unroll
                  for (int d = 0; d < 8; ++d) { const float v = q[8 * s2 + d] * rstd * gq[32 * s2 + d]; qs += v * v; }
              qs = red32_sum(red16_sum(qs)); qn2 = fmaxf(qn2, max16(qs)); }
#pragma unroll
            for (int s2 = 0; s2 < 2; ++s2) {
                uint4 w;
                w.x = pack2(q[8 * s2 + 0] * rstd * gq[32 * s2 + 0], q[8 * s2 + 1] * rstd * gq[32 * s2 + 1]);
                w.y = pack2(q[8 * s2 + 2] * rstd * gq[32 * s2 + 2], q[8 * s2 + 3] * rstd * gq[32 * s2 + 3]);
                w.z = pack2(q[8 * s2 + 4] * rstd * gq[32 * s2 + 4], q[8 * s2 + 5] * rstd * gq[32 * s2 + 5]);
                w.w = pack2(q[8 * s2 + 6] * rstd * gq[32 * s2 + 6], q[8 * s2 + 7] * rstd * gq[32 * s2 + 7]);
                qf[t][s2] = __builtin_bit_cast(bf16x8, w);
            }
        }
        const bf16_t* kvp = P + ((size_t)b * SEQ + skey) * DIN + h * 64 + sc8;
        uint4 kA0, kA1, vA0, vA1; float fA = 0.f;
#define FOX_LOAD(K0, K1, V0, V1, FF, st_) do { const bf16_t* np_ = kvp + (size_t)(st_) * 128 * DIN; \
            K0 = *(const uint4*)(np_ + C_FK); K1 = *(const uint4*)(np_ + (size_t)64 * DIN + C_FK); V0 = *(const uint4*)(np_ + C_FV); V1 = *(const uint4*)(np_ + (size_t)64 * DIN + C_FV); \
            if (tid < 128) FF = Fg[(st_) * 128 + tid]; } while (0)
        FOX_LOAD(kA0, kA1, vA0, vA1, fA, nst - 1);
        const float Bw = sqrtf(qn2) * 8.f * gkmax * 1.02f;
        bool wdone = false;
        float m[2] = {-INFINITY, -INFINITY}, lsum[2] = {0.f, 0.f};
        f32x4 oacc[2][4];
#pragma unroll
        for (int t = 0; t < 2; ++t)
#pragma unroll
            for (int dt = 0; dt < 4; ++dt) oacc[t][dt] = (f32x4){0.f, 0.f, 0.f, 0.f};
#define FOX_COMPUTE(st) do { \
            const bf16_t* Ks = (const bf16_t*)(lds + ((st) & 1) * BUFB); const bf16_t* Vs = Ks + 128 * LDK; const float* Fs = (const float*)(Vs + 128 * LDK); \
            if (!wdone && (st) * 128 <= wrow + 31) { const float mmin_ = min16(fminf(m[0], m[1])); if (Bw + Fs[127] <= mmin_ - 40.f) wdone = true; }     \
            if (!wdone && (st) * 128 <= wrow + 31) {                         \
                f32x4 sacc[2][8]; \
                _Pragma("unroll") for (int n = 0; n < 8; ++n) { \
                    sacc[0][n] = *(const f32x4*)&Fs[n * 16 + 4 * g]; sacc[1][n] = sacc[0][n];            \
                    _Pragma("unroll") for (int s2 = 0; s2 < 2; ++s2) { \
                        const bf16x8 kfr = *(const bf16x8*)&Ks[(n * 16 + qi) * LDK + 32 * s2 + 8 * g]; \
                        sacc[0][n] = __builtin_amdgcn_mfma_f32_16x16x32_bf16(kfr, qf[0][s2], sacc[0][n], 0, 0, 0); \
                        sacc[1][n] = __builtin_amdgcn_mfma_f32_16x16x32_bf16(kfr, qf[1][s2], sacc[1][n], 0, 0, 0); \
                    } \
                } \
                const bool diag = ((st) * 128 + 127 > wrow);         \
                bf16x8 pf[2][4]; \
                _Pragma("unroll") for (int t = 0; t < 2; ++t) { \
                    const int trow = wrow + 16 * t + qi; \
                    float mx = -INFINITY; \
                    _Pragma("unroll") for (int n = 0; n < 8; ++n) { \
                        _Pragma("unroll") for (int j = 0; j < 4; ++j) { \
                            float v = sacc[t][n][j]; \
                            if (diag) v = ((st) * 128 + n * 16 + 4 * g + j <= trow) ? v : -INFINITY; \
                            sacc[t][n][j] = v; mx = fmaxf(mx, v); \
                        } \
                    } \
                    mx = red32_max(red16_max(mx)); \
                    const float mn = fmaxf(m[t], mx); \
                    const float corr = __builtin_amdgcn_exp2f(m[t] - mn); \
                    m[t] = mn; \
                    float ps = 0.f; \
                    _Pragma("unroll") for (int n = 0; n < 8; ++n) \
                        _Pragma("unroll") for (int j = 0; j < 4; ++j) { const float e = __builtin_amdgcn_exp2f(sacc[t][n][j] - mn); sacc[t][n][j] = e; ps += e; } \
                    lsum[t] = lsum[t] * corr + ps; \
                    _Pragma("unroll") for (int dt = 0; dt < 4; ++dt) { oacc[t][dt][0] *= corr; oacc[t][dt][1] *= corr; oacc[t][dt][2] *= corr; oacc[t][dt][3] *= corr; } \
                    _Pragma("unroll") for (int ks = 0; ks < 4; ++ks) { \
                        uint4 w; \
                        w.x = pack2(sacc[t][2 * ks][0], sacc[t][2 * ks][1]); w.y = pack2(sacc[t][2 * ks][2], sacc[t][2 * ks][3]); \
                        w.z = pack2(sacc[t][2 * ks + 1][0], sacc[t][2 * ks + 1][1]); w.w = pack2(sacc[t][2 * ks + 1][2], sacc[t][2 * ks + 1][3]); \
                        pf[t][ks] = __builtin_bit_cast(bf16x8, w); \
                    } \
                } \
                _Pragma("unroll") for (int ks = 0; ks < 4; ++ks) \
                    _Pragma("unroll") for (int dt = 0; dt < 4; ++dt) { \
                        const v4i16_t lo = lds_tr(&Vs[((2 * ks) * 16 + 4 * g + tq) * LDK + dt * 16 + 4 * tp]); \
                        const v4i16_t hi = lds_tr(&Vs[((2 * ks + 1) * 16 + 4 * g + tq) * LDK + dt * 16 + 4 * tp]); \
                        const bf16x8 vfr = (bf16x8){lo[0], lo[1], lo[2], lo[3], hi[0], hi[1], hi[2], hi[3]}; \
                        oacc[0][dt] = __builtin_amdgcn_mfma_f32_16x16x32_bf16(vfr, pf[0][ks], oacc[0][dt], 0, 0, 0); \
                        oacc[1][dt] = __builtin_amdgcn_mfma_f32_16x16x32_bf16(vfr, pf[1][ks], oacc[1][dt], 0, 0, 0); \
                    } \
            } \
        } while (0)
#define FOX_STORE(K0, K1, V0, V1, FF, st_) do { bf16_t* Kw = (bf16_t*)(lds + ((st_) & 1) * BUFB); bf16_t* Vw = Kw + 128 * LDK; \
            *(uint4*)&Kw[skey * LDK + sc8] = K0; *(uint4*)&Kw[(skey + 64) * LDK + sc8] = K1; \
            *(uint4*)&Vw[skey * LDK + sc8] = V0; *(uint4*)&Vw[(skey + 64) * LDK + sc8] = V1; \
            if (tid < 128) ((float*)(Vw + 128 * LDK))[tid] = FF; } while (0)
        FOX_STORE(kA0, kA1, vA0, vA1, fA, nst - 1);
        if (nst - 2 >= 0) FOX_LOAD(kA0, kA1, vA0, vA1, fA, nst - 2);
        __syncthreads();
#pragma unroll 1
        for (int st = nst - 1; st >= 0; --st) {
            if (st - 1 >= 0) { FOX_STORE(kA0, kA1, vA0, vA1, fA, st - 1); if (st - 2 >= 0) FOX_LOAD(kA0, kA1, vA0, vA1, fA, st - 2); }
            FOX_COMPUTE(st);
            if (lane == 0) dflag[(st & 1) * 8 + wid] = wdone ? 1 : 0;
            __syncthreads();
            const int alld = dflag[(st & 1) * 8] & dflag[(st & 1) * 8 + 1] & dflag[(st & 1) * 8 + 2] & dflag[(st & 1) * 8 + 3] & dflag[(st & 1) * 8 + 4] & dflag[(st & 1) * 8 + 5] & dflag[(st & 1) * 8 + 6] & dflag[(st & 1) * 8 + 7];
            if (alld) break;
        }
#undef FOX_STORE
#undef FOX_LOAD
#undef FOX_COMPUTE
#pragma unroll
        for (int t = 0; t < 2; ++t) {
            float l = lsum[t];
            l = red32_sum(red16_sum(l));
            const float il = 1.f / l;
            const int trow = wrow + 16 * t + qi;
            bf16_t* op = DRY ? (bf16_t*)(p.ws + OFF_WIN) + ((size_t)b * SEQ + trow) * 128 + (h & 1) * 64 + 4 * g : P + ((size_t)b * SEQ + trow) * DIN + C_FQ + h * 64 + 4 * g;
#pragma unroll
            for (int dt = 0; dt < 4; ++dt) {
                if constexpr (DRY) { uint2 o; o.x = pack2(oacc[t][dt][0] * il, oacc[t][dt][1] * il); o.y = pack2(oacc[t][dt][2] * il, oacc[t][dt][3] * il); *(uint2*)(op + dt * 16) = o; }
                else { const float ys = il * F8_ACT_SCALE;
                    *(unsigned*)((unsigned char*)P + ((size_t)b * SEQ + trow) * (DIN * 2) + YB_OFF + h * 64 + dt * 16 + 4 * g) = pack4_fp8(oacc[t][dt][0] * ys, oacc[t][dt][1] * ys, oacc[t][dt][2] * ys, oacc[t][dt][3] * ys); }
            }
        }
    }
}

template <bool DRY = false>
DEV void phase_mlstm(const Params& p, int layer, char* lds) {
    constexpr int LDQ = 72, LDV = 136, LDO = 132;
    bf16_t* Qs = (bf16_t*)lds;
    bf16_t* Ks = Qs + 64 * LDQ;
    bf16_t* QD = Ks + 64 * LDQ;
    bf16_t* KW = QD + 64 * LDQ;
    bf16_t* VV = KW + 64 * LDQ;
    bf16_t* PP = VV + 64 * LDV;
    float* GT = (float*)(PP + 64 * LDQ);
    float* ECs = GT + 256;
    float* OS = ECs + 4;
    bf16_t* P = (bf16_t*)(p.ws + OFF_PROJ);
    const int tid = tid_op(), lane = tid & 63, wid = tid >> 6, qi = lane & 15, g = lane >> 4, tq = qi >> 2, tp = lane & 3;
    const int row0 = tid >> 4, col0 = (tid & 15) * 8;
    const int prow = tid >> 3, pch = (tid & 7) * 8;
    const short one_bf = (short)0x3F80;
    const bf16x8 ones = (bf16x8){one_bf, one_bf, one_bf, one_bf, one_bf, one_bf, one_bf, one_bf};
    for (int u = bid_op(); u < NB * 4; u += gridDim.x) {
        const int b = u >> 2, h = u & 3;
        lds_barrier();
        for (int i = tid; i < 64 * LDQ / 2; i += 512) ((unsigned*)PP)[i] = 0u;
        float gn[8];
#pragma unroll
        for (int j = 0; j < 8; ++j) gn[j] = p.in[I_MNG][layer * 512 + h * 128 + col0 + j];
        f32x4 Cst[4], Nst[4];
#pragma unroll
        for (int dt = 0; dt < 4; ++dt) { Cst[dt] = (f32x4){0.f, 0.f, 0.f, 0.f}; Nst[dt] = (f32x4){0.f, 0.f, 0.f, 0.f}; }
        const bf16_t* rowb = P + (size_t)b * SEQ * DIN;
        const bf16_t* mlb = (const bf16_t*)(p.ws + OFF_H) + (size_t)u * 32 * (4 * 64 * 64);
        const float* gbuf = (const float*)(p.ws + OFF_GBUF) + (size_t)u * SEQ * 4;
        const float* ecb = (const float*)(p.ws + OFF_ECBUF) + u * 32;
        const unsigned off_v = (unsigned)row0 * DIN + (unsigned)(C_MV + h * 128 + col0);
        const unsigned off_o = (unsigned)row0 * DIN + (unsigned)(C_MO + h * 128 + col0);
        const unsigned off_m = (unsigned)tid * 8u;
        uint4 m0, m1, m2, m3, rv0, rv1, rg0, rg1; f32x4 gt4 = (f32x4){0.f, 0.f, 0.f, 0.f}; float ecv = 0.f;
#define ML_PREFETCH(c_) do { const int c__ = (c_); const bf16_t* mb_ = mlb + (size_t)c__ * (4 * 64 * 64); const bf16_t* uv_ = rowb + (size_t)(c__ * 64) * DIN; \
            m0 = *(const uint4*)(mb_ + off_m); m1 = *(const uint4*)(mb_ + 4096 + off_m); m2 = *(const uint4*)(mb_ + 8192 + off_m); m3 = *(const uint4*)(mb_ + 12288 + off_m); \
            rv0 = *(const uint4*)(uv_ + off_v); rv1 = *(const uint4*)(uv_ + off_v + 32u * DIN); rg0 = *(const uint4*)(uv_ + off_o); rg1 = *(const uint4*)(uv_ + off_o + 32u * DIN); \
            if (tid < 64) gt4 = *(const f32x4*)(gbuf + (size_t)(c__ * 64 + tid) * 4); ecv = ecb[c__]; } while (0)
        ML_PREFETCH(0);
#pragma unroll 1
        for (int c = 0; c < SEQ / 64; ++c) {
            *(uint4*)&Qs[prow * LDQ + pch] = m0; *(uint4*)&Ks[prow * LDQ + pch] = m1; *(uint4*)&QD[prow * LDQ + pch] = m2; *(uint4*)&KW[prow * LDQ + pch] = m3;
            *(uint4*)&VV[row0 * LDV + col0] = rv0; *(uint4*)&VV[(row0 + 32) * LDV + col0] = rv1;
            if (tid < 64) *(f32x4*)&GT[tid * 4] = gt4;
            const float ec = ecv;
            const uint4 g0 = rg0, g1 = rg1;
            if (c + 1 < SEQ / 64) ML_PREFETCH(c + 1);
            lds_barrier();
#pragma unroll
            for (int rep = 0; rep < 2; ++rep) {
                const int idx = wid + 8 * rep;
                if (idx < 10) {
                    const int tt = (idx >= 6) ? 3 : (idx >= 3) ? 2 : (idx >= 1) ? 1 : 0, st = idx - tt * (tt + 1) / 2;
                    f32x4 acc = (f32x4){0.f, 0.f, 0.f, 0.f};
#pragma unroll
                    for (int ks = 0; ks < 2; ++ks) {
                        const bf16x8 a = *(const bf16x8*)&Ks[(st * 16 + qi) * LDQ + 32 * ks + 8 * g];
                        const bf16x8 bq = *(const bf16x8*)&Qs[(tt * 16 + qi) * LDQ + 32 * ks + 8 * g];
                        acc = __builtin_amdgcn_mfma_f32_16x16x32_bf16(a, bq, acc, 0, 0, 0);
                    }
                    const float bt = GT[(tt * 16 + qi) * 4];
#pragma unroll
                    for (int j = 0; j < 4; ++j) {
                        const f32x4 gs = *(const f32x4*)&GT[(st * 16 + 4 * g + j) * 4];
                        const bool valid = (st < tt) || (4 * g + j <= qi);
                        acc[j] = valid ? acc[j] * __expf(bt - gs[0] + gs[1]) : 0.f;
                    }
                    uint2 w; w.x = pack2(acc[0], acc[1]); w.y = pack2(acc[2], acc[3]);
                    *(uint2*)&PP[(tt * 16 + qi) * LDQ + st * 16 + 4 * g] = w;
                }
            }
            f32x4 o[4], dn[4];
            {
                bf16x8 cp[2], np[2];
#pragma unroll
                for (int k2 = 0; k2 < 2; ++k2) {
                    uint4 w;
                    w.x = pack2(Cst[2 * k2][0], Cst[2 * k2][1]); w.y = pack2(Cst[2 * k2][2], Cst[2 * k2][3]);
                    w.z = pack2(Cst[2 * k2 + 1][0], Cst[2 * k2 + 1][1]); w.w = pack2(Cst[2 * k2 + 1][2], Cst[2 * k2 + 1][3]);
                    cp[k2] = __builtin_bit_cast(bf16x8, w);
                    w.x = pack2(Nst[2 * k2][0], Nst[2 * k2][1]); w.y = pack2(Nst[2 * k2][2], Nst[2 * k2][3]);
                    w.z = pack2(Nst[2 * k2 + 1][0], Nst[2 * k2 + 1][1]); w.w = pack2(Nst[2 * k2 + 1][2], Nst[2 * k2 + 1][3]);
                    np[k2] = __builtin_bit_cast(bf16x8, w);
                }
                uint2 qa[4][2][2];
#pragma unroll
                for (int tt = 0; tt < 4; ++tt)
#pragma unroll
                    for (int k2 = 0; k2 < 2; ++k2) {
                        qa[tt][k2][0] = *(const uint2*)&QD[(tt * 16 + qi) * LDQ + (2 * k2) * 16 + 4 * g];
                        qa[tt][k2][1] = *(const uint2*)&QD[(tt * 16 + qi) * LDQ + (2 * k2 + 1) * 16 + 4 * g];
                    }
                asm volatile("" ::: "memory");
#pragma unroll
                for (int tt = 0; tt < 4; ++tt) { o[tt] = (f32x4){0.f, 0.f, 0.f, 0.f}; dn[tt] = (f32x4){0.f, 0.f, 0.f, 0.f}; }
#pragma unroll
                for (int k2 = 0; k2 < 2; ++k2)
#pragma unroll
                    for (int tt = 0; tt < 4; ++tt) {
                        const bf16x8 af = __builtin_bit_cast(bf16x8, make_uint4(qa[tt][k2][0].x, qa[tt][k2][0].y, qa[tt][k2][1].x, qa[tt][k2][1].y));
                        o[tt] = __builtin_amdgcn_mfma_f32_16x16x32_bf16(af, cp[k2], o[tt], 0, 0, 0);
                        dn[tt] = __builtin_amdgcn_mfma_f32_16x16x32_bf16(af, np[k2], dn[tt], 0, 0, 0);
                    }
            }
            bf16x8 vf[2];
#pragma unroll
            for (int ks = 0; ks < 2; ++ks) {
                const v4i16_t lo = lds_tr(&VV[(32 * ks + 8 * g + tq) * LDV + 16 * wid + 4 * tp]);
                const v4i16_t hi = lds_tr(&VV[(32 * ks + 8 * g + 4 + tq) * LDV + 16 * wid + 4 * tp]);
                vf[ks] = (bf16x8){lo[0], lo[1], lo[2], lo[3], hi[0], hi[1], hi[2], hi[3]};
            }
            {
                bf16x8 kfa[4][2];
#pragma unroll
                for (int dt = 0; dt < 4; ++dt)
#pragma unroll
                    for (int ks = 0; ks < 2; ++ks) {
                        const v4i16_t lo = lds_tr(&KW[(32 * ks + 8 * g + tq) * LDQ + dt * 16 + 4 * tp]);
                        const v4i16_t hi = lds_tr(&KW[(32 * ks + 8 * g + 4 + tq) * LDQ + dt * 16 + 4 * tp]);
                        kfa[dt][ks] = (bf16x8){lo[0], lo[1], lo[2], lo[3], hi[0], hi[1], hi[2], hi[3]};
                    }
                asm volatile("" ::: "memory");
#pragma unroll
                for (int dt = 0; dt < 4; ++dt)
#pragma unroll
                    for (int j = 0; j < 4; ++j) { Cst[dt][j] *= ec; Nst[dt][j] *= ec; }
#pragma unroll
                for (int ks = 0; ks < 2; ++ks)
#pragma unroll
                    for (int dt = 0; dt < 4; ++dt) {
                        Cst[dt] = __builtin_amdgcn_mfma_f32_16x16x32_bf16(kfa[dt][ks], vf[ks], Cst[dt], 0, 0, 0);
                        Nst[dt] = __builtin_amdgcn_mfma_f32_16x16x32_bf16(kfa[dt][ks], ones, Nst[dt], 0, 0, 0);
                    }
            }
            lds_barrier();
#pragma unroll
            for (int tt = 0; tt < 4; ++tt)
#pragma unroll
                for (int ks = 0; ks < 2; ++ks)
                    if (ks <= (tt >> 1)) {
                        const bf16x8 a = *(const bf16x8*)&PP[(tt * 16 + qi) * LDQ + 32 * ks + 8 * g];
                        o[tt] = __builtin_amdgcn_mfma_f32_16x16x32_bf16(a, vf[ks], o[tt], 0, 0, 0);
                        dn[tt] = __builtin_amdgcn_mfma_f32_16x16x32_bf16(a, ones, dn[tt], 0, 0, 0);
                    }
#pragma unroll
            for (int tt = 0; tt < 4; ++tt)
#pragma unroll
                for (int j = 0; j < 4; ++j) {
                    const float den = dn[tt][j];
                    OS[(tt * 16 + 4 * g + j) * LDO + 16 * wid + qi] = o[tt][j] * __builtin_amdgcn_rcpf(fmaxf(fabsf(den), 1.f));
                }
            lds_barrier();
            bf16_t* uo = (bf16_t*)rowb + (size_t)(c * 64) * DIN;
#pragma unroll
            for (int i = 0; i < 2; ++i) {
                const int row = row0 + 32 * i;
                const f32x4 oa = *(const f32x4*)&OS[row * LDO + col0], ob = *(const f32x4*)&OS[row * LDO + col0 + 4];
                float ss = oa[0] * oa[0] + oa[1] * oa[1] + oa[2] * oa[2] + oa[3] * oa[3] + ob[0] * ob[0] + ob[1] * ob[1] + ob[2] * ob[2] + ob[3] * ob[3];
                ss = sum16(ss);
                const float rstd = rsqrtf(ss * (1.f / 128.f) + 1e-6f);
                float gg[8]; unpack8((i == 0) ? g0 : g1, gg);
#pragma unroll
                for (int j = 0; j < 8; ++j) gg[j] = fsigmoid(gg[j]) * gn[j];
                if constexpr (DRY) { uint4 w;
                    w.x = pack2(oa[0] * rstd * gg[0], oa[1] * rstd * gg[1]); w.y = pack2(oa[2] * rstd * gg[2], oa[3] * rstd * gg[3]);
                    w.z = pack2(ob[0] * rstd * gg[4], ob[1] * rstd * gg[5]); w.w = pack2(ob[2] * rstd * gg[6], ob[3] * rstd * gg[7]);
                    *(uint4*)((bf16_t*)(p.ws + OFF_WIN) + ((size_t)b * SEQ + c * 64 + row) * 128 + col0) = w; }
                else { const float ys = rstd * F8_ACT_SCALE;
                    *(uint2*)((unsigned char*)P + ((size_t)b * SEQ + c * 64 + row) * (DIN * 2) + YB_OFF + 512 + h * 128 + col0) =
                        make_uint2(pack4_fp8(oa[0] * ys * gg[0], oa[1] * ys * gg[1], oa[2] * ys * gg[2], oa[3] * ys * gg[3]), pack4_fp8(ob[0] * ys * gg[4], ob[1] * ys * gg[5], ob[2] * ys * gg[6], ob[3] * ys * gg[7])); }
            }
        }
#undef ML_PREFETCH
    }
}

template <bool DRY = false>
DEV void phase_hgrn(const Params& p, int layer, char* lds) {
    constexpr int LDA = 136, LDP = 72, LDO = 132;
    bf16_t* QM = (bf16_t*)lds;
    bf16_t* KM = QM + 64 * LDA;
    bf16_t* VV = KM + 64 * LDA;
    bf16_t* PP = VV + 64 * LDA;
    float* EM = (float*)(PP + 64 * LDP);
    float* EC = EM + 128;
    float* EK = EC + 128;
    float* OS = EK + 128;
    bf16_t* P = (bf16_t*)(p.ws + OFF_PROJ);
    const int tid = tid_op(), lane = tid & 63, wid = tid >> 6, qi = lane & 15, g = lane >> 4, tq = qi >> 2, tp = lane & 3;
    const int row0 = tid >> 4, col0 = (tid & 15) * 8;
    for (int u = (bid_op() + (int)gridDim.x - 64) % (int)gridDim.x; u < NB * 4; u += gridDim.x) {
        const int b = u >> 2, h = u & 3;
        float gn[8];
#pragma unroll
        for (int j = 0; j < 8; ++j) gn[j] = p.in[I_HNG][layer * 512 + h * 128 + col0 + j];
        lds_barrier();
        for (int i = tid; i < 64 * LDP / 2; i += 512) ((unsigned*)PP)[i] = 0u;
        f32x4 S[8];
#pragma unroll
        for (int dt = 0; dt < 8; ++dt) S[dt] = (f32x4){0.f, 0.f, 0.f, 0.f};
        bf16_t* gbase = P + ((size_t)b * SEQ + row0) * DIN + h * 128 + col0;
        const float* evb = (const float*)(p.ws + OFF_EVBUF) + (size_t)u * 32 * 384;
        uint4 q0r, q1r, k0r, k1r, v0r, v1r, g0r, g1r; f32x4 ev4 = (f32x4){0.f, 0.f, 0.f, 0.f};
#define HG_PREFETCH(c_) do { const bf16_t* rp_ = gbase + (size_t)((c_) * 64) * DIN; \
            q0r = *(const uint4*)(rp_ + C_HQ); q1r = *(const uint4*)(rp_ + (size_t)32 * DIN + C_HQ); k0r = *(const uint4*)(rp_ + C_HF); k1r = *(const uint4*)(rp_ + (size_t)32 * DIN + C_HF); \
            v0r = *(const uint4*)(rp_ + C_HI); v1r = *(const uint4*)(rp_ + (size_t)32 * DIN + C_HI); g0r = *(const uint4*)(rp_ + C_HG); g1r = *(const uint4*)(rp_ + (size_t)32 * DIN + C_HG); \
            if (tid < 96) ev4 = *(const f32x4*)(evb + (size_t)(c_) * 384 + tid * 4); } while (0)
        HG_PREFETCH(0);
#pragma unroll 1
        for (int c = 0; c < SEQ / 64; ++c) {
            *(uint4*)&QM[row0 * LDA + col0] = q0r; *(uint4*)&QM[(row0 + 32) * LDA + col0] = q1r;
            *(uint4*)&KM[row0 * LDA + col0] = k0r; *(uint4*)&KM[(row0 + 32) * LDA + col0] = k1r;
            *(uint4*)&VV[row0 * LDA + col0] = v0r; *(uint4*)&VV[(row0 + 32) * LDA + col0] = v1r;
            if (tid < 96) *(f32x4*)&EM[tid * 4] = ev4;
            const uint4 rg0 = g0r, rg1 = g1r;
            if (c + 1 < SEQ / 64) HG_PREFETCH(c + 1);
            lds_barrier();
#pragma unroll
            for (int rep = 0; rep < 2; ++rep) {
                const int idx = wid + 8 * rep;
                if (idx < 10) {
                    const int tt = (idx >= 6) ? 3 : (idx >= 3) ? 2 : (idx >= 1) ? 1 : 0, st = idx - tt * (tt + 1) / 2;
                    f32x4 acc = (f32x4){0.f, 0.f, 0.f, 0.f};
#pragma unroll
                    for (int ks = 0; ks < 4; ++ks) {
                        const bf16x8 a = *(const bf16x8*)&KM[(st * 16 + qi) * LDA + 32 * ks + 8 * g];
                        const bf16x8 bq = *(const bf16x8*)&QM[(tt * 16 + qi) * LDA + 32 * ks + 8 * g];
                        acc = __builtin_amdgcn_mfma_f32_16x16x32_bf16(a, bq, acc, 0, 0, 0);
                    }
                    if (tt == st) {
#pragma unroll
                        for (int j = 0; j < 4; ++j) if (4 * g + j > qi) acc[j] = 0.f;
                    }
                    uint2 w; w.x = pack2(acc[0], acc[1]); w.y = pack2(acc[2], acc[3]);
                    *(uint2*)&PP[(tt * 16 + qi) * LDP + st * 16 + 4 * g] = w;
                }
            }
            f32x4 o[4];
            {
                bf16x8 sp[4];
#pragma unroll
                for (int k2 = 0; k2 < 4; ++k2) {
                    const f32x4 e0 = *(const f32x4*)&EM[(2 * k2) * 16 + 4 * g], e1 = *(const f32x4*)&EM[(2 * k2 + 1) * 16 + 4 * g];
                    uint4 w;
                    w.x = pack2(S[2 * k2][0] * e0[0], S[2 * k2][1] * e0[1]); w.y = pack2(S[2 * k2][2] * e0[2], S[2 * k2][3] * e0[3]);
                    w.z = pack2(S[2 * k2 + 1][0] * e1[0], S[2 * k2 + 1][1] * e1[1]); w.w = pack2(S[2 * k2 + 1][2] * e1[2], S[2 * k2 + 1][3] * e1[3]);
                    sp[k2] = __builtin_bit_cast(bf16x8, w);
                }
#pragma unroll
                for (int hh = 0; hh < 2; ++hh) {
                    uint2 qa[2][4][2];
#pragma unroll
                    for (int t2 = 0; t2 < 2; ++t2)
#pragma unroll
                        for (int k2 = 0; k2 < 4; ++k2) {
                            qa[t2][k2][0] = *(const uint2*)&QM[((hh * 2 + t2) * 16 + qi) * LDA + (2 * k2) * 16 + 4 * g];
                            qa[t2][k2][1] = *(const uint2*)&QM[((hh * 2 + t2) * 16 + qi) * LDA + (2 * k2 + 1) * 16 + 4 * g];
                        }
                    asm volatile("" ::: "memory");
                    o[hh * 2] = (f32x4){0.f, 0.f, 0.f, 0.f}; o[hh * 2 + 1] = (f32x4){0.f, 0.f, 0.f, 0.f};
#pragma unroll
                    for (int k2 = 0; k2 < 4; ++k2)
#pragma unroll
                        for (int t2 = 0; t2 < 2; ++t2) {
                            const uint4 w = make_uint4(qa[t2][k2][0].x, qa[t2][k2][0].y, qa[t2][k2][1].x, qa[t2][k2][1].y);
                            o[hh * 2 + t2] = __builtin_amdgcn_mfma_f32_16x16x32_bf16(__builtin_bit_cast(bf16x8, w), sp[k2], o[hh * 2 + t2], 0, 0, 0);
                        }
                }
            }
            bf16x8 vf[2];
#pragma unroll
            for (int ks = 0; ks < 2; ++ks) {
                const v4i16_t lo = lds_tr(&VV[(32 * ks + 8 * g + tq) * LDA + 16 * wid + 4 * tp]);
                const v4i16_t hi = lds_tr(&VV[(32 * ks + 8 * g + 4 + tq) * LDA + 16 * wid + 4 * tp]);
                vf[ks] = (bf16x8){lo[0], lo[1], lo[2], lo[3], hi[0], hi[1], hi[2], hi[3]};
            }
#pragma unroll
            for (int hh = 0; hh < 2; ++hh) {
                bf16x8 kfa[4][2]; f32x4 ecv[4], ekv[4];
#pragma unroll
                for (int d4 = 0; d4 < 4; ++d4) {
                    const int dt = hh * 4 + d4;
#pragma unroll
                    for (int ks = 0; ks < 2; ++ks) {
                        const v4i16_t lo = lds_tr(&KM[(32 * ks + 8 * g + tq) * LDA + dt * 16 + 4 * tp]);
                        const v4i16_t hi = lds_tr(&KM[(32 * ks + 8 * g + 4 + tq) * LDA + dt * 16 + 4 * tp]);
                        kfa[d4][ks] = (bf16x8){lo[0], lo[1], lo[2], lo[3], hi[0], hi[1], hi[2], hi[3]};
                    }
                    ecv[d4] = *(const f32x4*)&EC[dt * 16 + 4 * g]; ekv[d4] = *(const f32x4*)&EK[dt * 16 + 4 * g];
                }
                asm volatile("" ::: "memory");
                f32x4 Ta[4];
#pragma unroll
                for (int d4 = 0; d4 < 4; ++d4) Ta[d4] = (f32x4){0.f, 0.f, 0.f, 0.f};
#pragma unroll
                for (int ks = 0; ks < 2; ++ks)
#pragma unroll
                    for (int d4 = 0; d4 < 4; ++d4) Ta[d4] = __builtin_amdgcn_mfma_f32_16x16x32_bf16(kfa[d4][ks], vf[ks], Ta[d4], 0, 0, 0);
#pragma unroll
                for (int d4 = 0; d4 < 4; ++d4)
#pragma unroll
                    for (int j = 0; j < 4; ++j) S[hh * 4 + d4][j] = ecv[d4][j] * S[hh * 4 + d4][j] + ekv[d4][j] * Ta[d4][j];
            }
            lds_barrier();
#pragma unroll
            for (int tt = 0; tt < 4; ++tt)
#pragma unroll
                for (int ks = 0; ks < 2; ++ks)
                    if (ks <= (tt >> 1)) {
                        const bf16x8 a = *(const bf16x8*)&PP[(tt * 16 + qi) * LDP + 32 * ks + 8 * g];
                        o[tt] = __builtin_amdgcn_mfma_f32_16x16x32_bf16(a, vf[ks], o[tt], 0, 0, 0);
                    }
#pragma unroll
            for (int tt = 0; tt < 4; ++tt)
#pragma unroll
                for (int j = 0; j < 4; ++j) OS[(tt * 16 + 4 * g + j) * LDO + 16 * wid + qi] = o[tt][j];
            lds_barrier();
#pragma unroll
            for (int i = 0; i < 2; ++i) {
                const int row = row0 + 32 * i;
                const f32x4 oa = *(const f32x4*)&OS[row * LDO + col0], ob = *(const f32x4*)&OS[row * LDO + col0 + 4];
                float ss = oa[0] * oa[0] + oa[1] * oa[1] + oa[2] * oa[2] + oa[3] * oa[3] + ob[0] * ob[0] + ob[1] * ob[1] + ob[2] * ob[2] + ob[3] * ob[3];
                ss = sum16(ss);
                const float rstd = rsqrtf(ss * (1.f / 128.f) + 1e-6f);
                float gg[8]; unpack8((i == 0) ? rg0 : rg1, gg);
#pragma unroll
                for (int j = 0; j < 8; ++j) gg[j] = fsilu(gg[j]) * gn[j];
                if constexpr (DRY) { uint4 w;
                    w.x = pack2(oa[0] * rstd * gg[0], oa[1] * rstd * gg[1]); w.y = pack2(oa[2] * rstd * gg[2], oa[3] * rstd * gg[3]);
                    w.z = pack2(ob[0] * rstd * gg[4], ob[1] * rstd * gg[5]); w.w = pack2(ob[2] * rstd * gg[6], ob[3] * rstd * gg[7]);
                    *(uint4*)((bf16_t*)(p.ws + OFF_WIN) + ((size_t)b * SEQ + c * 64 + row) * 128 + col0) = w; }
                else { const float ys = rstd * F8_ACT_SCALE;
                    *(uint2*)((unsigned char*)P + ((size_t)b * SEQ + c * 64 + row) * (DIN * 2) + YB_OFF + 1024 + h * 128 + col0) =
                        make_uint2(pack4_fp8(oa[0] * ys * gg[0], oa[1] * ys * gg[1], oa[2] * ys * gg[2], oa[3] * ys * gg[3]), pack4_fp8(ob[0] * ys * gg[4], ob[1] * ys * gg[5], ob[2] * ys * gg[6], ob[3] * ys * gg[7])); }
            }
        }
#undef HG_PREFETCH
    }
}

#define XB_TMO      128
#define XB_XCNT(j)  (256  + 64 * (j))
#define XB_XSUB(j)  (1280 + 64 * (j))
#define XB_XGEN(j)  (2304 + 64 * (j))
#define XB_TOP      3328
#define XB_TOPGEN   3392
#define XCD_BAR_WORDS 3456
#define XB_SPIN_CAP (1u << 18)
__device__ __forceinline__ unsigned xb_ld(unsigned* p)              { return __hip_atomic_load(p, __ATOMIC_RELAXED, __HIP_MEMORY_SCOPE_AGENT); }
__device__ __forceinline__ unsigned xb_add(unsigned* p, unsigned v) { return __hip_atomic_fetch_add(p, v, __ATOMIC_RELAXED, __HIP_MEMORY_SCOPE_AGENT); }
__device__ __forceinline__ unsigned xb_xcc_id() { return (unsigned)__builtin_amdgcn_s_getreg((3 << 11) | 20) & 0xFu; }
#define XB_SPIN(cond, bar) do { unsigned _sp = 0; while (cond) { __builtin_amdgcn_s_sleep(1); \
    if ((++_sp & 255u) == 0u) { if (xb_ld(&(bar)[XB_TMO])) break; if (_sp > XB_SPIN_CAP) { atomicAdd(&(bar)[XB_TMO], 1u); break; } } } } while (0)
struct XcdBarrier { unsigned* bar; unsigned x; volatile LAS unsigned* st; };
__device__ __forceinline__ XcdBarrier xcd_barrier_post(unsigned* bar, volatile LAS unsigned* st) {
    XcdBarrier b; b.bar = bar; b.x = xb_xcc_id(); b.st = st;
    if (threadIdx.x == 0) (void)xb_add(&bar[XB_XCNT(b.x)], 1u);
    return b;
}
__device__ __forceinline__ void xcd_barrier_complete(unsigned* bar, unsigned x, unsigned& nloc, unsigned& nx) {
    const unsigned G = gridDim.x * gridDim.y * gridDim.z;
    unsigned sum, cnt, mine, sp = 0u;
    for (;;) {
        sum = 0u; cnt = 0u; mine = 0u;
#pragma unroll
        for (unsigned j = 0; j < 16; ++j) { const unsigned c = xb_ld(&bar[XB_XCNT(j)]); sum += c; cnt += (c > 0u) ? 1u : 0u; mine = (j == x) ? c : mine; }
        if (sum == G) break;
        __builtin_amdgcn_s_sleep(1);
        if ((++sp & 255u) == 0u) { if (xb_ld(&bar[XB_TMO])) break; if (sp > XB_SPIN_CAP) { atomicAdd(&bar[XB_TMO], 1u); break; } }
    }
    nloc = mine > 0u ? mine : 1u; nx = cnt > 0u ? cnt : 1u;
}
__device__ __forceinline__ void xcd_barrier(const XcdBarrier& b) {
    asm volatile("s_waitcnt vmcnt(0)" ::: "memory");
    __syncthreads();
    if (threadIdx.x == 0) {
        unsigned* bar = b.bar;
        __builtin_amdgcn_s_waitcnt(0);
        unsigned nloc = b.st[0], nx = b.st[1];
        if (nloc == 0u) { xcd_barrier_complete(bar, b.x, nloc, nx); b.st[0] = nloc; b.st[1] = nx; }
        const unsigned old = xb_add(&bar[XB_XSUB(b.x)], 1u);
        const unsigned gen = old / nloc;
        if (old + 1u == (gen + 1u) * nloc) {
            __builtin_amdgcn_fence(__ATOMIC_RELEASE, "agent");
            asm volatile("s_waitcnt vmcnt(0)" ::: "memory");
            const unsigned og = xb_add(&bar[XB_TOP], 1u);
            const unsigned tg = og / nx;
            if (og + 1u == (tg + 1u) * nx) xb_add(&bar[XB_TOPGEN], 1u);
            else XB_SPIN(xb_ld(&bar[XB_TOPGEN]) == tg, bar);
            __builtin_amdgcn_fence(__ATOMIC_ACQUIRE, "agent");
            asm volatile("s_waitcnt vmcnt(0)" ::: "memory");
        } else {
            XB_SPIN(xb_ld(&bar[XB_TOPGEN]) == gen, bar);
            __builtin_amdgcn_fence(__ATOMIC_ACQUIRE, "agent");
            asm volatile("s_waitcnt vmcnt(0)" ::: "memory");
        }
    }
    __syncthreads();
}

constexpr int LDS_BYTES = 131072 + 16 + TL_PAD * 4 + 2 * 256 * 4 + 512;
__global__ void __launch_bounds__(512, 2) mega_fwd(Params p) {
    extern __shared__ __attribute__((aligned(16))) char lds_all[];
    char* lds = lds_all + 16;
    if (threadIdx.x == 0) *(uint4*)lds_all = make_uint4(0u, 0u, 0u, 0u);
    __syncthreads();
    (void)xcd_barrier_post((unsigned*)(p.ws + OFF_CTL), (volatile LAS unsigned*)lds_all);
#define GRID_BAR() do { XcdBarrier b_; b_.bar = (unsigned*)(p.ws + OFF_CTL); b_.x = xb_xcc_id(); b_.st = (volatile LAS unsigned*)lds_all; xcd_barrier(b_); } while (0)
    bf16_t* Hb = (bf16_t*)(p.ws + OFF_H);
    phase_convert_mix(p, 0, lds, 0, 1032);
    phase_ada(p, lds);
    GRID_BAR();
    phase_norm(p, p.in[I_X], 0, 0, Hb);
    GRID_BAR();
#pragma unroll 1
    for (int layer = 0; layer < 2; ++layer) {
        phase_inproj(p, layer, lds);
        GRID_BAR();
        phase_prep(p, layer, lds);
        GRID_BAR();
        phase_mlstm(p, layer, lds);
        phase_hgrn(p, layer, lds);
        phase_fox(p, layer, lds);
        GRID_BAR();
        phase_merge(p, lds);
        GRID_BAR();
        phase_out(p, layer, lds);
        GRID_BAR();
        phase_front(p, layer, lds);
        GRID_BAR();
#pragma unroll 1
        for (int half = 0; half < NHALF; ++half) {
            phase_moe_up(p, layer, half, lds);
            GRID_BAR();
            phase_moe_down(p, half, lds);
            GRID_BAR();
            phase_combine(p, layer, half, lds);
            if (layer == 0 && half == NHALF - 1) phase_convert_mix(p, 1, lds, 0, 1032);
            GRID_BAR();
        }
    }
}

extern "C" void kernel_launch(void* const* d_in, const int* in_sizes, int n_in, void* d_out, int out_size, void* d_ws, size_t ws_size, hipStream_t stream) {
    (void)in_sizes; (void)n_in; (void)out_size; (void)ws_size;
    Params p{};
    for (int i = 0; i < 26; ++i) p.in[i] = (const float*)d_in[i];
    p.out = (float*)d_out;
    p.ws = (unsigned char*)d_ws;
    static int grid = 0;
    if (!grid) {
        int dev = 0, cus = 0, per_cu = 0;
        (void)hipGetDevice(&dev);
        (void)hipDeviceGetAttribute(&cus, hipDeviceAttributeMultiprocessorCount, dev);
        (void)hipFuncSetAttribute((const void*)mega_fwd, hipFuncAttributeMaxDynamicSharedMemorySize, LDS_BYTES);
        (void)hipOccupancyMaxActiveBlocksPerMultiprocessor(&per_cu, mega_fwd, 512, LDS_BYTES);
        if (cus <= 0) cus = 256;
        grid = cus * (per_cu < 1 ? per_cu : 1);
        if (grid <= 0) grid = cus;
        if (grid > 256) grid = 256;
    }
    (void)hipMemsetAsync(d_ws, 0, CTL_BYTES, stream);
    hipLaunchKernelGGL(mega_fwd, dim3(grid), dim3(512), LDS_BYTES, stream, p);
}
```
